# Optimizing an MI355X kernel written in HIP

```python
import jax, jax.numpy as jnp
from jax import lax
import numpy as np

D_MODEL = 1024
BATCH = 8
SEQ = 4096
DEPTH = 4

N_MIXERS = 2
N_MEM = 256
GRID_W = 64
TOKEN_W = 3 * D_MODEL // 4
MEM_W = D_MODEL // 4
MIX_W = TOKEN_W + MEM_W
HEAD_DIM = 64
NA_HEADS = TOKEN_W // HEAD_DIM
WIN_H = 8
WIN_W = 16
ML_HEADS = 4
ML_DH = TOKEN_W // ML_HEADS
ML_CHUNK = 64
CONV_K = 5
ML_PROJ = 4 * TOKEN_W + 4 * ML_HEADS
MEM_HEADS = 4
MEM_DH = MEM_W // MEM_HEADS
N_GROUPS = 4
EXPERTS_PER_GROUP = 8
N_EXPERTS = N_GROUPS * EXPERTS_PER_GROUP
TOP_K = 2
D_EXPERT = D_MODEL // 2
MOE_BLOCK = 128
LN_EPS = 1e-5
ALPHA = (2 * DEPTH) ** 0.25
BETA = (8 * DEPTH) ** -0.25
N_NA_LAYERS = (DEPTH + 1) // 2
N_ML_LAYERS = DEPTH // 2
NA_IN = 3 * TOKEN_W + MEM_W
ML_IN = ML_PROJ + MEM_W

kernel_name = "hybrid_natten_mlstm_hmoe_encoder"


def layer_norm(x, g, b):
    xf = x.astype(jnp.float32)
    mu = xf.mean(-1, keepdims=True)
    var = jnp.square(xf - mu).mean(-1, keepdims=True)
    y = (xf - mu) * lax.rsqrt(var + LN_EPS)
    return (y * g + b).astype(x.dtype)


def neighbourhood_attention(q, k, v, rpb):
    B, T, H, Dh = q.shape
    rows = T // GRID_W
    kh = min(WIN_H, rows)
    to_grid = lambda a: a.reshape(B, rows, GRID_W, H, Dh).transpose(1, 0, 3, 2, 4)
    qg, kg, vg = to_grid(q), to_grid(k), to_grid(v)
    cols = jnp.arange(GRID_W)
    col_start = jnp.clip(cols - WIN_W // 2, 0, GRID_W - WIN_W)
    col_idx = col_start[:, None] + jnp.arange(WIN_W)
    col_bias_idx = col_idx - cols[:, None] + (WIN_W - 1)
    scale = Dh ** -0.5

    def row_block(r):
        row_start = jnp.clip(r - kh // 2, 0, rows - kh)
        k_band = lax.dynamic_slice_in_dim(kg, row_start, kh, axis=0)
        v_band = lax.dynamic_slice_in_dim(vg, row_start, kh, axis=0)
        k_win = k_band[:, :, :, col_idx]
        v_win = v_band[:, :, :, col_idx]
        q_row = lax.dynamic_index_in_dim(qg, r, axis=0, keepdims=False)
        row_bias_idx = row_start + jnp.arange(kh) - r + (WIN_H - 1)
        bias = rpb[:, row_bias_idx[None, :, None], col_bias_idx[:, None, :]]
        s = jnp.einsum('bhqd,rbhqkd->bhqrk', q_row, k_win).astype(jnp.float32) * scale + bias
        p = jax.nn.softmax(s.reshape(B, H, GRID_W, kh * WIN_W), axis=-1)
        p = p.reshape(B, H, GRID_W, kh, WIN_W).astype(v.dtype)
        return jnp.einsum('bhqrk,rbhqkd->bhqd', p, v_win)

    out = lax.map(row_block, jnp.arange(rows))
    return out.transpose(1, 0, 3, 2, 4).reshape(B, T, H * Dh)


def mlstm_scan(q, k, v, log_i, log_f):
    B, H, T, Dh = q.shape
    L = min(ML_CHUNK, T)
    nc = T // L
    to_chunks = lambda a: jnp.moveaxis(a.reshape(B, H, nc, L, *a.shape[3:]), 2, 0)
    tril = jnp.tril(jnp.ones((L, L), dtype=bool))

    def step(carry, inp):
        C, n, m = carry
        qc, kc, vc, lic, lfc = inp
        b = jnp.cumsum(lfc, axis=-1)
        D = b[..., :, None] - b[..., None, :] + lic[..., None, :]
        D = jnp.where(tril, D, -jnp.inf)
        inter = b + m[..., None]
        m_t = jnp.maximum(inter, D.max(-1))
        w_inter = jnp.exp(inter - m_t)
        S = jnp.einsum('bhld,bhsd->bhls', qc, kc) * jnp.exp(D - m_t[..., None])
        num = w_inter[..., None] * jnp.einsum('bhld,bhde->bhle', qc, C) + jnp.einsum('bhls,bhse->bhle', S, vc)
        den = w_inter * jnp.einsum('bhld,bhd->bhl', qc, n) + S.sum(-1)
        h = num / jnp.maximum(jnp.abs(den), jnp.exp(-m_t))[..., None]
        b_last = b[..., -1]
        m_new = m_t[..., -1]
        decay = jnp.exp(b_last + m - m_new)
        w_src = jnp.exp(b_last[..., None] - b + lic - m_new[..., None])
        C_new = decay[..., None, None] * C + jnp.einsum('bhs,bhsd,bhse->bhde', w_src, kc, vc)
        n_new = decay[..., None] * n + jnp.einsum('bhs,bhsd->bhd', w_src, kc)
        return (C_new, n_new, m_new), h

    init = (jnp.zeros((B, H, Dh, Dh), jnp.float32), jnp.zeros((B, H, Dh), jnp.float32),
            jnp.zeros((B, H), jnp.float32))
    _, hs = lax.scan(step, init, (to_chunks(q), to_chunks(k), to_chunks(v), to_chunks(log_i), to_chunks(log_f)))
    return jnp.moveaxis(hs, 0, 2).reshape(B, H, T, Dh)


def centred_dwconv(x, w, b):
    C = x.shape[-1]
    y = lax.conv_general_dilated(x, w[:, None, :], window_strides=(1,),
                                 padding=[(CONV_K // 2, CONV_K // 2)],
                                 dimension_numbers=('NWC', 'WIO', 'NWC'),
                                 feature_group_count=C)
    return y + b


def mlstm_mixer(proj, conv_w, conv_b, gate_b, norm_g):
    B, T, _ = proj.shape
    qk_pre = proj[..., :2 * TOKEN_W]
    v = proj[..., 2 * TOKEN_W:3 * TOKEN_W]
    o_pre = proj[..., 3 * TOKEN_W:4 * TOKEN_W]
    gates = proj[..., 4 * TOKEN_W:]
    qk = jax.nn.silu(centred_dwconv(qk_pre, conv_w, conv_b))
    q, k = qk[..., :TOKEN_W], qk[..., TOKEN_W:]
    heads = lambda a: a.reshape(B, T, ML_HEADS, ML_DH).transpose(0, 2, 1, 3).astype(jnp.float32)
    qh, kh, vh = heads(q) * (ML_DH ** -0.5), heads(k), heads(v)
    g = (gates.reshape(B, T, 4, ML_HEADS).astype(jnp.float32) + gate_b).transpose(2, 0, 3, 1)
    log_i = g[:2]
    log_f = jax.nn.log_sigmoid(g[2:])
    flip = lambda a: jnp.flip(a, axis=2)
    h_fwd = mlstm_scan(qh, kh, vh, log_i[0], log_f[0])
    h_bwd = flip(mlstm_scan(flip(qh), flip(kh), flip(vh), flip(log_i[1]), flip(log_f[1])))
    h = (h_fwd + h_bwd).transpose(0, 2, 1, 3)
    mu = h.mean(-1, keepdims=True)
    var = jnp.square(h - mu).mean(-1, keepdims=True)
    h = ((h - mu) * lax.rsqrt(var + LN_EPS)).reshape(B, T, TOKEN_W) * norm_g
    return (jax.nn.sigmoid(o_pre.astype(jnp.float32)) * h).astype(proj.dtype)


def memory_attention(q, mem_k, mem_v):
    B, T, _ = q.shape
    qh = q.reshape(B, T, MEM_HEADS, MEM_DH)
    s = jnp.einsum('bthd,bmhd->bhtm', qh, mem_k).astype(jnp.float32) * (MEM_DH ** -0.5)
    p = jax.nn.softmax(s, axis=-1).astype(mem_v.dtype)
    return jnp.einsum('bhtm,bmhd->bthd', p, mem_v).reshape(B, T, MEM_W)


def hierarchical_moe(x, wg, bg, we, be, w1, w3, w2):
    B, T, D = x.shape
    xt = x.reshape(-1, D)
    N = xt.shape[0]
    g_logits = (xt @ wg).astype(jnp.float32) + bg
    g_prob = jax.nn.softmax(g_logits, axis=-1)
    g_idx = jnp.argmax(g_logits, axis=-1)
    g_gate = jnp.take_along_axis(g_prob, g_idx[:, None], axis=-1)
    e_logits = ((xt @ we).astype(jnp.float32) + be).reshape(N, N_GROUPS, EXPERTS_PER_GROUP)
    e_logits = jnp.take_along_axis(e_logits, g_idx[:, None, None], axis=1)[:, 0]
    top_p, top_i = lax.top_k(jax.nn.softmax(e_logits, axis=-1), TOP_K)
    gate = (g_gate * top_p / top_p.sum(-1, keepdims=True)).reshape(-1)
    eid = (g_idx[:, None] * EXPERTS_PER_GROUP + top_i).reshape(-1)
    tok = jnp.repeat(jnp.arange(N), TOP_K)
    A = N * TOP_K
    order = jnp.argsort(eid)
    s_eid, s_tok, s_gate = eid[order], tok[order], gate[order]
    counts = jnp.bincount(eid, length=N_EXPERTS)
    start = jnp.cumsum(counts) - counts
    padded = (counts + MOE_BLOCK - 1) // MOE_BLOCK * MOE_BLOCK
    pad_end = jnp.cumsum(padded)
    pad_start = pad_end - padded
    dest = pad_start[s_eid] + jnp.arange(A) - start[s_eid]
    n_blocks = -(-(A + N_EXPERTS * (MOE_BLOCK - 1)) // MOE_BLOCK)
    P = n_blocks * MOE_BLOCK
    row_tok = jnp.zeros((P,), jnp.int32).at[dest].set(s_tok.astype(jnp.int32))
    row_gate = jnp.zeros((P,), jnp.float32).at[dest].set(s_gate)
    block_eid = jnp.minimum(jnp.searchsorted(pad_end, jnp.arange(n_blocks) * MOE_BLOCK, side='right'),
                            N_EXPERTS - 1)
    xb = xt[row_tok].reshape(n_blocks, MOE_BLOCK, D)

    def expert_block(args):
        xblk, e = args
        h = jax.nn.silu(xblk @ w1[e]) * (xblk @ w3[e])
        return h @ w2[e]

    yb = lax.map(expert_block, (xb, block_eid)).reshape(P, D)
    y = jax.ops.segment_sum(yb * row_gate[:, None].astype(yb.dtype), row_tok, num_segments=N)
    return y.reshape(B, T, D)


def setup_inputs(seed: int = 0) -> dict:
    key = jax.random.key(seed)
    ks = jax.random.split(key, 24)
    nrm = lambda k, shape, s: jax.random.normal(k, shape, jnp.float32) * s
    D = D_MODEL
    f_init = jnp.linspace(3.0, 6.0, ML_HEADS)
    ml_gate_b = jnp.concatenate([nrm(ks[7], (N_ML_LAYERS, 2, ML_HEADS), 0.1),
                                 f_init + nrm(ks[8], (N_ML_LAYERS, 2, ML_HEADS), 0.1)], axis=1)
    return {
        "x": nrm(ks[0], (BATCH, SEQ, D), 1.0),
        "mem": nrm(ks[1], (BATCH, N_MEM, D), 1.0),
        "w_mem_kv": nrm(ks[2], (D, 2 * MEM_W), D ** -0.5),
        "na_w_in": nrm(ks[3], (N_NA_LAYERS, D, NA_IN), D ** -0.5),
        "na_rpb": nrm(ks[4], (N_NA_LAYERS, NA_HEADS, 2 * WIN_H - 1, 2 * WIN_W - 1), 0.02),
        "ml_w_in": nrm(ks[5], (N_ML_LAYERS, D, ML_IN), D ** -0.5),
        "ml_conv_w": nrm(ks[6], (N_ML_LAYERS, CONV_K, 2 * TOKEN_W), CONV_K ** -0.5),
        "ml_conv_b": nrm(ks[9], (N_ML_LAYERS, 2 * TOKEN_W), 0.01),
        "ml_gate_b": ml_gate_b,
        "ml_norm_g": 1.0 + nrm(ks[10], (N_ML_LAYERS, TOKEN_W), 0.02),
        "w_out": nrm(ks[11], (DEPTH, MIX_W, D), MIX_W ** -0.5 * BETA),
        "ln1_g": 1.0 + nrm(ks[12], (DEPTH, D), 0.02),
        "ln1_b": nrm(ks[13], (DEPTH, D), 0.02),
        "ln2_g": 1.0 + nrm(ks[14], (DEPTH, D), 0.02),
        "ln2_b": nrm(ks[15], (DEPTH, D), 0.02),
        "moe_wg": nrm(ks[16], (DEPTH, D, N_GROUPS), D ** -0.5),
        "moe_bg": nrm(ks[17], (DEPTH, N_GROUPS), 0.01),
        "moe_we": nrm(ks[18], (DEPTH, D, N_EXPERTS), D ** -0.5),
        "moe_be": nrm(ks[19], (DEPTH, N_EXPERTS), 0.01),
        "moe_w1": nrm(ks[20], (DEPTH, N_EXPERTS, D, D_EXPERT), D ** -0.5),
        "moe_w3": nrm(ks[21], (DEPTH, N_EXPERTS, D, D_EXPERT), D ** -0.5),
        "moe_w2": nrm(ks[22], (DEPTH, N_EXPERTS, D_EXPERT, D), D_EXPERT ** -0.5 * BETA),
    }


def reference(x, mem, w_mem_kv, na_w_in, na_rpb, ml_w_in, ml_conv_w, ml_conv_b, ml_gate_b,
              ml_norm_g, w_out, ln1_g, ln1_b, ln2_g, ln2_b, moe_wg, moe_bg, moe_we, moe_be,
              moe_w1, moe_w3, moe_w2):
    B, T, D = x.shape
    mem_kv = (mem @ w_mem_kv).reshape(B, N_MEM, 2, MEM_HEADS, MEM_DH)
    mem_k, mem_v = mem_kv[:, :, 0], mem_kv[:, :, 1]
    for layer in range(DEPTH):
        j = layer // N_MIXERS
        if layer % N_MIXERS == 0:
            proj = x @ na_w_in[j]
            qkv = proj[..., :3 * TOKEN_W].reshape(B, T, 3, NA_HEADS, HEAD_DIM)
            tok = neighbourhood_attention(qkv[:, :, 0], qkv[:, :, 1], qkv[:, :, 2], na_rpb[j])
            q_mem = proj[..., 3 * TOKEN_W:]
        else:
            proj = x @ ml_w_in[j]
            tok = mlstm_mixer(proj[..., :ML_PROJ], ml_conv_w[j], ml_conv_b[j], ml_gate_b[j], ml_norm_g[j])
            q_mem = proj[..., ML_PROJ:]
        mixed = jnp.concatenate([tok, memory_attention(q_mem, mem_k, mem_v)], axis=-1)
        x = layer_norm(ALPHA * x + mixed @ w_out[layer], ln1_g[layer], ln1_b[layer])
        ffn = hierarchical_moe(x, moe_wg[layer], moe_bg[layer], moe_we[layer], moe_be[layer],
                               moe_w1[layer], moe_w3[layer], moe_w2[layer])
        x = layer_norm(ALPHA * x + ffn, ln2_g[layer], ln2_b[layer])
    return x
```

```cpp
#include <hip/hip_runtime.h>
#include <cstdio>
#include <cstdint>
namespace pg8 {
#define PG8_LAS __attribute__((address_space(3)))
typedef unsigned short bf16_t;
typedef short bf16x8 __attribute__((ext_vector_type(8)));
typedef float f32x4 __attribute__((ext_vector_type(4)));
typedef unsigned u32x4 __attribute__((ext_vector_type(4)));
typedef unsigned u32x2 __attribute__((ext_vector_type(2)));
constexpr int BM = 256, BK = 64, HALF = 128, HTB = HALF * BK * 2  , STAGE_BYTES = 8 * HTB, NXCD = 8, WGM = 8;

__host__ __device__ __forceinline__ int lds_byte(int r, int c) { const int st = (r >> 4) * 2 + (c >> 5), rr = r & 15, cc = c & 31, ob = rr * 64 + cc * 2; return st * 1024 + (ob ^ (((ob >> 9) & 1) << 5)); }
__host__ __device__ __forceinline__ void stage_rc(int b, int& R, int& C) { const int st = b / 1024, sb = b % 1024, swz = sb ^ (((sb >> 9) & 1) << 5); R = (st >> 1) * 16 + swz / 64; C = (st & 1) * 32 + (swz % 64) / 2; }
__host__ __device__ __forceinline__ int perm32(int rho) { const int n = rho >> 4, i = rho & 15; return 8 * (i >> 2) + 4 * n + (i & 3); }

struct Unit { int pm, pn, brow; };
struct Gemm { const bf16_t* A; const bf16_t* Bt; int M, N, K; };

struct StaticOrder {
    int nM, nN, nwg, G, c;
    __host__ __device__ void init(int M, int N, int G_, int c_) { nM = M / BM; nN = N / BM; nwg = nM * nN; G = G_; c = c_; }
    __host__ __device__ bool next(int i, Unit& u) const {
        const long L = (long)i * G + c; if (L >= nwg) return false;
        int wgid = (int)L; { const int q = nwg / NXCD, r = nwg % NXCD, xcd = wgid % NXCD, off = wgid / NXCD; wgid = (xcd < r ? xcd * (q + 1) : r * (q + 1) + (xcd - r) * q) + off; }
        const int nig = WGM * nN, gid = wgid / nig, fm = gid * WGM, gsz = (nM - fm) < WGM ? (nM - fm) : WGM;
        u.pm = fm + ((wgid % nig) % gsz); u.pn = (wgid % nig) / gsz; u.brow = u.pn * BM; return true;
    }
    __device__ __forceinline__ void a_ready(const Unit&) const {}
    __device__ __forceinline__ void done(const Unit&) const {}
};
struct GroupedOrder {
    int nM, nN, nwg, G, c; const int* tile_exp;
    __device__ void init(int nT, int N, int G_, int c_, const int* te) { nM = nT; nN = N / BM; nwg = nM * nN; G = G_; c = c_; tile_exp = te; }
    __device__ bool next(int i, Unit& u) const {
        const long L = (long)i * G + c; if (L >= nwg) return false;
        int wgid = (int)L; { const int q = nwg / NXCD, r = nwg % NXCD, xcd = wgid % NXCD, off = wgid / NXCD; wgid = (xcd < r ? xcd * (q + 1) : r * (q + 1) + (xcd - r) * q) + off; }
        const int nig = WGM * nN, gid = wgid / nig, fm = gid * WGM, gsz = (nM - fm) < WGM ? (nM - fm) : WGM;
        u.pm = fm + ((wgid % nig) % gsz); u.pn = (wgid % nig) / gsz;
        const int e = __builtin_amdgcn_readfirstlane((int)__hip_atomic_load((const unsigned*)tile_exp + u.pm, __ATOMIC_RELAXED, __HIP_MEMORY_SCOPE_AGENT));
        u.brow = e * (nN * BM) + u.pn * BM; return true;
    }
    __device__ __forceinline__ void a_ready(const Unit&) const {}
    __device__ __forceinline__ void done(const Unit&) const {}
};

__device__ __forceinline__ unsigned cvt_pk_bf16(float lo, float hi) { unsigned r; asm volatile("v_cvt_pk_bf16_f32 %0, %1, %2" : "=v"(r) : "v"(lo), "v"(hi)); return r; }

struct EpiProj {
    static constexpr bool PERM = true, AFTER_DRAIN = false;
    bf16_t* O; int ldc; float* gates; int gate_pn;
    __device__ __forceinline__ void operator()(const f32x4 (&acc)[2][2][4][2], const Unit& u, int wr, int wc, int fr, int fq) const {
        const int row0 = u.pm * BM + wr * 64 + fr, col0 = u.pn * BM + wc * 32 + 8 * fq;
#pragma unroll
        for (int ai = 0; ai < 2; ++ai)
#pragma unroll
            for (int m = 0; m < 4; ++m) { bf16_t* rowp = O + (size_t)(row0 + ai * HALF + m * 16) * ldc + col0;
#pragma unroll
                for (int bj = 0; bj < 2; ++bj) { const f32x4 v0 = acc[ai][bj][m][0], v1 = acc[ai][bj][m][1];
                    u32x4 w; w.x = cvt_pk_bf16(v0[0], v0[1]); w.y = cvt_pk_bf16(v0[2], v0[3]); w.z = cvt_pk_bf16(v1[0], v1[1]); w.w = cvt_pk_bf16(v1[2], v1[3]);
                    *(u32x4*)(rowp + bj * HALF) = w; } }
        if (gates != nullptr && u.pn == gate_pn && wc == 0 && fq < 2) {
#pragma unroll
            for (int ai = 0; ai < 2; ++ai)
#pragma unroll
                for (int m = 0; m < 4; ++m) { float* gp = gates + (size_t)(row0 + ai * HALF + m * 16) * 16 + 8 * fq;
                    *(f32x4*)gp = acc[ai][0][m][0]; *(f32x4*)(gp + 4) = acc[ai][0][m][1]; }
        }
    }
};
struct EpiF32 {
    static constexpr bool PERM = false, AFTER_DRAIN = false;
    float* C; int ldc;
    __device__ __forceinline__ void operator()(const f32x4 (&acc)[2][2][4][2], const Unit& u, int wr, int wc, int fr, int fq) const {
        const int row0 = u.pm * BM + wr * 64 + fr, col0 = u.pn * BM + wc * 32 + 4 * fq;
#pragma unroll
        for (int ai = 0; ai < 2; ++ai)
#pragma unroll
            for (int m = 0; m < 4; ++m) { float* rowp = C + (size_t)(row0 + ai * HALF + m * 16) * ldc + col0;
#pragma unroll
                for (int bj = 0; bj < 2; ++bj)
#pragma unroll
                    for (int n = 0; n < 2; ++n) *(f32x4*)(rowp + bj * HALF + n * 16) = acc[ai][bj][m][n]; }
    }
};
struct EpiResF32 {
    static constexpr bool PERM = false, AFTER_DRAIN = false;
    const float* base; float* out; int ldc; float alpha;
    __device__ __forceinline__ void operator()(const f32x4 (&acc)[2][2][4][2], const Unit& u, int wr, int wc, int fr, int fq) const {
        const int row0 = u.pm * BM + wr * 64 + fr, col0 = u.pn * BM + wc * 32 + 4 * fq;
#pragma unroll
        for (int ai = 0; ai < 2; ++ai)
#pragma unroll
            for (int m = 0; m < 4; ++m) { const size_t off = (size_t)(row0 + ai * HALF + m * 16) * ldc + col0;
#pragma unroll
                for (int bj = 0; bj < 2; ++bj)
#pragma unroll
                    for (int n = 0; n < 2; ++n) { const f32x4 bs = *(const f32x4*)(base + off + bj * HALF + n * 16);
                        *(f32x4*)(out + off + bj * HALF + n * 16) = bs * alpha + acc[ai][bj][m][n]; } }
    }
};
struct EpiSwiGLU {
    static constexpr bool PERM = false, AFTER_DRAIN = false;
    bf16_t* H; int ldh;
    __device__ __forceinline__ void operator()(const f32x4 (&acc)[2][2][4][2], const Unit& u, int wr, int wc, int fr, int fq) const {
        const int row0 = u.pm * BM + wr * 64 + fr, col0 = u.pn * HALF + wc * 16 + 4 * fq;
#pragma unroll
        for (int ai = 0; ai < 2; ++ai)
#pragma unroll
            for (int m = 0; m < 4; ++m) { bf16_t* rowp = H + (size_t)(row0 + ai * HALF + m * 16) * ldh + col0;
#pragma unroll
                for (int bj = 0; bj < 2; ++bj) { const f32x4 a = acc[ai][bj][m][0], b = acc[ai][bj][m][1]; float h[4];
#pragma unroll
                    for (int j = 0; j < 4; ++j) h[j] = a[j] / (1.0f + __expf(-a[j])) * b[j];
                    u32x2 w; w.x = cvt_pk_bf16(h[0], h[1]); w.y = cvt_pk_bf16(h[2], h[3]);
                    *(u32x2*)(rowp + bj * 64) = w; } }
    }
};
struct EpiMoeDown {
    static constexpr bool PERM = true, AFTER_DRAIN = false;
    bf16_t* Y; int ldc; const int* row_slot; const float* row_gate;
    __device__ __forceinline__ void operator()(const f32x4 (&acc)[2][2][4][2], const Unit& u, int wr, int wc, int fr, int fq) const {
        const int row0 = u.pm * BM + wr * 64 + fr, col0 = u.pn * BM + wc * 32 + 8 * fq;
#pragma unroll
        for (int ai = 0; ai < 2; ++ai)
#pragma unroll
            for (int m = 0; m < 4; ++m) { const int row = row0 + ai * HALF + m * 16;
                const int slot = (int)__hip_atomic_load((const unsigned*)row_slot + row, __ATOMIC_RELAXED, __HIP_MEMORY_SCOPE_AGENT);
                const float gt = __uint_as_float(__hip_atomic_load((const unsigned*)row_gate + row, __ATOMIC_RELAXED, __HIP_MEMORY_SCOPE_AGENT));
                if (slot >= 0) { bf16_t* rowp = Y + (size_t)slot * ldc + col0;
#pragma unroll
                    for (int bj = 0; bj < 2; ++bj) { const f32x4 v0 = acc[ai][bj][m][0] * gt, v1 = acc[ai][bj][m][1] * gt;
                        u32x4 w; w.x = cvt_pk_bf16(v0[0], v0[1]); w.y = cvt_pk_bf16(v0[2], v0[3]); w.z = cvt_pk_bf16(v1[0], v1[1]); w.w = cvt_pk_bf16(v1[2], v1[3]);
                        *(u32x4*)(rowp + bj * HALF) = w; } } }
    }
};

template <class Epi, class Sched, bool ALIGN_EPI = false, bool SP2 = false>
__device__ __forceinline__ void gemm_phase(PG8_LAS unsigned char* lds, const Gemm g, const Sched& S, const Epi& E) {
    int tid_l = threadIdx.x; asm volatile("" : "+v"(tid_l));
    const int tid = tid_l, wid = __builtin_amdgcn_readfirstlane(tid >> 6), lane = tid & 63, wr = wid >> 2, wc = wid & 3, fr = lane & 15, fq = lane >> 4;
    const int K = g.K, nt = K / BK;
    unsigned voffA[2], voffB[2];
#pragma unroll
    for (int i = 0; i < 2; ++i) { int R, C; stage_rc(tid * 16 + i * 8192, R, C); const int Rb = Epi::PERM ? ((R & ~31) + perm32(R & 31)) : R;
        voffA[i] = (unsigned)(R * K + C) * 2u; voffB[i] = (unsigned)(Rb * K + C) * 2u; }
    const size_t kstep = (size_t)(BK * 2);
    const size_t hstep = (size_t)HALF * K * 2;
    const size_t tstep = 2 * hstep;
    const unsigned ldsw = (unsigned)wid * 1024u;
    const int aoff = lds_byte(wr * 64 + fr, fq * 8), boff = lds_byte(wc * 32 + fr, fq * 8);
#define PG8_SA(b, h) (((b) * 2 + (h)) * HTB)
#define PG8_SB(b, h) ((4 + (b) * 2 + (h)) * HTB)
#define PG8_STAGE(bufoff, gbase, voff) do { _Pragma("unroll") for (int _i = 0; _i < 2; ++_i) \
        __builtin_amdgcn_global_load_lds((const unsigned*)((const char*)(gbase) + (voff)[_i]), (PG8_LAS unsigned*)(lds + (bufoff) + ldsw + _i * 8192), 16, 0, 0); } while (0)
#define PG8_LDA(dst, b, h) do { _Pragma("unroll") for (int m = 0; m < 4; ++m) _Pragma("unroll") for (int k = 0; k < 2; ++k) dst[m][k] = *(const PG8_LAS bf16x8*)(lds + PG8_SA(b, h) + aoff + m * 2048 + k * 1024); } while (0)
#define PG8_LDB(dst, b, h) do { _Pragma("unroll") for (int n = 0; n < 2; ++n) _Pragma("unroll") for (int k = 0; k < 2; ++k) dst[n][k] = *(const PG8_LAS bf16x8*)(lds + PG8_SB(b, h) + boff + n * 2048 + k * 1024); } while (0)
#define PG8_MMA(ai, bj, At, Bt) do { __builtin_amdgcn_s_setprio(1); _Pragma("unroll") for (int m = 0; m < 4; ++m) _Pragma("unroll") for (int n = 0; n < 2; ++n) _Pragma("unroll") for (int k = 0; k < 2; ++k) \
        acc[ai][bj][m][n] = __builtin_amdgcn_mfma_f32_16x16x32_bf16(Bt[n][k], At[m][k], acc[ai][bj][m][n], 0, 0, 0); __builtin_amdgcn_s_setprio(0); } while (0)
#define PG8_WAIT_V(n) asm volatile("s_waitcnt vmcnt(" #n ")" ::: "memory")
#define PG8_WAIT_L(n) asm volatile("s_waitcnt lgkmcnt(" #n ")" ::: "memory")
#define PG8_BAR __builtin_amdgcn_s_barrier()
#define PG8_SCHED __builtin_amdgcn_sched_barrier(0)
    Unit cur, nxt; int ui = 0;
    if (!S.next(0, cur)) return;
    f32x4 acc[2][2][4][2];
#pragma unroll
    for (int a = 0; a < 2; ++a)
#pragma unroll
        for (int b = 0; b < 2; ++b)
#pragma unroll
            for (int m = 0; m < 4; ++m)
#pragma unroll
                for (int n = 0; n < 2; ++n) acc[a][b][m][n] = (f32x4){0.f, 0.f, 0.f, 0.f};
    bf16x8 At[4][2], B0[2][2], B1[2][2];
    const char* cA = (const char*)g.A + (size_t)cur.pm * tstep; const char* cB = (const char*)g.Bt + (size_t)cur.brow * (size_t)K * 2;
    S.a_ready(cur);
    if constexpr (SP2) {
        PG8_STAGE(PG8_SB(0, 0), cB, voffB); PG8_STAGE(PG8_SB(0, 1), cB + hstep, voffB); PG8_STAGE(PG8_SA(0, 0), cA, voffA); PG8_STAGE(PG8_SA(0, 1), cA + hstep, voffA);
        if (wr == 1) PG8_BAR;
        PG8_WAIT_V(2); PG8_BAR;
        PG8_STAGE(PG8_SB(1, 0), cB + kstep, voffB); PG8_STAGE(PG8_SA(1, 0), cA + kstep, voffA); PG8_STAGE(PG8_SB(1, 1), cB + hstep + kstep, voffB);
        PG8_WAIT_V(6); PG8_BAR;
    } else {
        PG8_STAGE(PG8_SB(0, 0), cB, voffB); PG8_STAGE(PG8_SA(0, 0), cA, voffA); PG8_STAGE(PG8_SB(0, 1), cB + hstep, voffB); PG8_STAGE(PG8_SA(0, 1), cA + hstep, voffA);
        if (wr == 1) PG8_BAR;
        PG8_WAIT_V(4); PG8_BAR;
        PG8_STAGE(PG8_SB(1, 0), cB + kstep, voffB); PG8_STAGE(PG8_SA(1, 0), cA + kstep, voffA); PG8_STAGE(PG8_SB(1, 1), cB + hstep + kstep, voffB);
        PG8_WAIT_V(6); PG8_BAR;
    }
    for (;;) {
        const bool has_next = S.next(ui + 1, nxt);
        const char* nA = has_next ? (const char*)g.A + (size_t)nxt.pm * tstep : cA; const char* nB = has_next ? (const char*)g.Bt + (size_t)nxt.brow * (size_t)K * 2 : cB;
        for (int t = 0; t < nt; t += 2) {
            const bool last = (t == nt - 2);
            const char* a1 = cA + (size_t)(t + 1) * kstep;
            const char* a2 = last ? nA : cA + (size_t)(t + 2) * kstep; const char* b2 = last ? nB : cB + (size_t)(t + 2) * kstep;
            const char* a3 = a2 + kstep; const char* b3 = b2 + kstep;
            if (last && has_next) S.a_ready(nxt);
            if constexpr (SP2) {
            PG8_LDB(B0, 0, 0); PG8_LDB(B1, 0, 1); PG8_SCHED; PG8_LDA(At, 0, 0); PG8_STAGE(PG8_SA(1, 1), a1 + hstep, voffA);
            PG8_WAIT_V(8); PG8_WAIT_L(0); PG8_BAR; PG8_MMA(0, 0, At, B0); PG8_MMA(0, 1, At, B1); PG8_BAR; PG8_SCHED;
            PG8_LDA(At, 0, 1); PG8_STAGE(PG8_SB(0, 0), b2, voffB); PG8_STAGE(PG8_SB(0, 1), b2 + hstep, voffB); PG8_STAGE(PG8_SA(0, 0), a2, voffA);
            PG8_WAIT_V(8); PG8_WAIT_L(0); PG8_BAR; PG8_MMA(1, 0, At, B0); PG8_MMA(1, 1, At, B1); PG8_BAR; PG8_SCHED;
            PG8_LDB(B0, 1, 0); PG8_LDB(B1, 1, 1); PG8_SCHED; PG8_LDA(At, 1, 0); PG8_STAGE(PG8_SA(0, 1), a2 + hstep, voffA);
            PG8_WAIT_V(8); PG8_WAIT_L(0); PG8_BAR; PG8_MMA(0, 0, At, B0); PG8_MMA(0, 1, At, B1); PG8_BAR; PG8_SCHED;
            PG8_LDA(At, 1, 1); PG8_STAGE(PG8_SB(1, 0), b3, voffB); PG8_STAGE(PG8_SB(1, 1), b3 + hstep, voffB); PG8_STAGE(PG8_SA(1, 0), a3, voffA);
            PG8_WAIT_V(8); PG8_WAIT_L(0); PG8_BAR; PG8_MMA(1, 0, At, B0); PG8_MMA(1, 1, At, B1); PG8_BAR; PG8_SCHED;
            } else {
            PG8_LDB(B0, 0, 0); PG8_SCHED; PG8_LDA(At, 0, 0); PG8_STAGE(PG8_SA(1, 1), a1 + hstep, voffA);
            PG8_WAIT_L(8); PG8_BAR; PG8_WAIT_L(0); PG8_MMA(0, 0, At, B0); PG8_BAR; PG8_SCHED;
            PG8_LDB(B1, 0, 1); PG8_STAGE(PG8_SB(0, 0), b2, voffB);
            PG8_BAR; PG8_WAIT_L(0); PG8_MMA(0, 1, At, B1); PG8_BAR;
            PG8_LDA(At, 0, 1); PG8_STAGE(PG8_SA(0, 0), a2, voffA);
            PG8_BAR; PG8_WAIT_L(0); PG8_MMA(1, 0, At, B0); PG8_BAR; PG8_SCHED;
            PG8_STAGE(PG8_SB(0, 1), b2 + hstep, voffB);
            PG8_WAIT_V(6); PG8_BAR; PG8_MMA(1, 1, At, B1); PG8_BAR;
            PG8_LDB(B0, 1, 0); PG8_SCHED; PG8_LDA(At, 1, 0); PG8_STAGE(PG8_SA(0, 1), a2 + hstep, voffA);
            PG8_WAIT_L(8); PG8_BAR; PG8_WAIT_L(0); PG8_MMA(0, 0, At, B0); PG8_BAR; PG8_SCHED;
            PG8_LDB(B1, 1, 1); PG8_STAGE(PG8_SB(1, 0), b3, voffB);
            PG8_BAR; PG8_WAIT_L(0); PG8_MMA(0, 1, At, B1); PG8_BAR;
            PG8_LDA(At, 1, 1); PG8_STAGE(PG8_SA(1, 0), a3, voffA);
            PG8_BAR; PG8_WAIT_L(0); PG8_MMA(1, 0, At, B0); PG8_BAR; PG8_SCHED;
            PG8_STAGE(PG8_SB(1, 1), b3 + hstep, voffB);
            PG8_WAIT_V(6); PG8_BAR; PG8_MMA(1, 1, At, B1); PG8_BAR;
            }
        }
        if constexpr (ALIGN_EPI) { if (wr == 0) PG8_BAR; }
        if constexpr (!Epi::AFTER_DRAIN) { E(acc, cur, wr, wc, fr, fq); S.done(cur); }
        if (!has_next) break;
#pragma unroll
        for (int a = 0; a < 2; ++a)
#pragma unroll
            for (int b = 0; b < 2; ++b)
#pragma unroll
                for (int m = 0; m < 4; ++m)
#pragma unroll
                    for (int n = 0; n < 2; ++n) acc[a][b][m][n] = (f32x4){0.f, 0.f, 0.f, 0.f};
        cur = nxt; cA = nA; cB = nB; ++ui;
        if constexpr (ALIGN_EPI) { if (wr == 1) PG8_BAR; }
    }
    PG8_WAIT_V(0);
    if constexpr (!ALIGN_EPI) { if (wr == 0) PG8_BAR; }
    PG8_BAR;
    if constexpr (Epi::AFTER_DRAIN) { E.fused(acc, cur, wr, wc, fr, fq, lds, wid, lane); S.done(cur); }
#undef PG8_SA
#undef PG8_SB
#undef PG8_STAGE
#undef PG8_LDA
#undef PG8_LDB
#undef PG8_MMA
#undef PG8_WAIT_V
#undef PG8_WAIT_L
#undef PG8_BAR
#undef PG8_SCHED
}
}
#ifndef PG8_SP2
#define PG8_SP2 true
#endif
#ifndef PG8_ALIGN
#define PG8_ALIGN true
#endif

constexpr int NWAVES = 8, NTHREADS = NWAVES * 64;
constexpr int BATCH = 8, SEQ = 4096, D = 1024, M = BATCH * SEQ, DEPTH = 4;
constexpr int NMEM = 256, TOKW = 768, MEMW = 256, MEMH = 4, NAH = 12, MLH = 4, MLDH = 192;
constexpr int NA_IN = 2560, ML_IN = 3344, ML_INP = 3584, ML_GATE_PN = 13;
constexpr int NEXP = 32, EPG = 8, NGRP = 4, DEXP = 512;
constexpr int P_MAX = 288 * 256;
constexpr float LN_EPS = 1e-5f;
constexpr float ALPHA = 1.6817928305074290f;

constexpr size_t MiB = 1u << 20;
constexpr size_t WS_CTL = 0, CTL_ZERO_BYTES = 1 * MiB;
constexpr size_t WS_MISC = 1 * MiB;
constexpr size_t WS_WINNA = 2 * MiB, WS_WINML = 12 * MiB, WS_WOUT = 26 * MiB, WS_WMEMKV = 34 * MiB, WS_MEMB = 35 * MiB, WS_MEMKV = 39 * MiB, WS_GATES = 43 * MiB;
constexpr size_t WS_TOKE = 45 * MiB, WS_TOKG = WS_TOKE + 262144, WS_TOKP = WS_TOKG + 262144, WS_ROWSLOT = WS_TOKP + 262144, WS_ROWGATE = WS_ROWSLOT + 294912;
static_assert(WS_ROWGATE + 294912 <= 48 * MiB, "ws map");
constexpr size_t WS_W13 = 48 * MiB, WS_W2 = 304 * MiB, WS_PRE = 432 * MiB, WS_XB = 560 * MiB, WS_PROJ = 624 * MiB, WS_MIXED = 848 * MiB, WS_H = 912 * MiB, WS_END = 1008 * MiB;
constexpr size_t WS_QKC = WS_PRE;
constexpr size_t WS_Y = WS_PROJ, WS_HID = WS_PROJ + 128 * MiB;
constexpr size_t WS_XS = WS_MIXED;
static_assert(WS_HID + (size_t)P_MAX * DEXP * 2 <= WS_MIXED && WS_XS + (size_t)P_MAX * D * 2 <= WS_END && WS_PROJ + (size_t)M * ML_INP * 2 <= WS_MIXED, "ws map");
static_assert(WS_H + (size_t)2 * M * TOKW * 2 <= WS_END && WS_QKC + (size_t)M * 1536 * 2 <= WS_XB, "ws map");
constexpr int CW_BAR = 4096;
constexpr int CW_CNT = 16384;
constexpr int RING_BYTES = 131072, LDSCTL_OFF = RING_BYTES, LDSCTL_BYTES = 16384, LDS_BYTES = RING_BYTES + LDSCTL_BYTES;
constexpr int L_MISC = LDSCTL_OFF + 320, L_HIST = LDSCTL_OFF + 512, L_WGBASE = LDSCTL_OFF + 768, L_PADSTART = LDSCTL_OFF + 1024, L_CNT = LDSCTL_OFF + 1280;

#define GAS __attribute__((address_space(1)))
#define LAS __attribute__((address_space(3)))
typedef unsigned short bf16;
typedef unsigned v4u __attribute__((ext_vector_type(4)));
typedef float f32x4 __attribute__((ext_vector_type(4)));
typedef short bf16x8 __attribute__((ext_vector_type(8)));
typedef GAS unsigned gu32;
typedef GAS unsigned long long gu64;
#define RLX_AGENT __ATOMIC_RELAXED, __HIP_MEMORY_SCOPE_AGENT
#define LDS_WAIT() asm volatile("s_waitcnt lgkmcnt(0)" ::: "memory")
#define VM_WAIT() asm volatile("s_waitcnt vmcnt(0)" ::: "memory")
__device__ __forceinline__ unsigned long long rt() { return __builtin_amdgcn_s_memrealtime(); }
__device__ __forceinline__ unsigned f2bf(float f) { unsigned u = __builtin_bit_cast(unsigned, f); return (u + 0x7fffu + ((u >> 16) & 1u)) >> 16; }
__device__ __forceinline__ unsigned pk2(float lo, float hi) { return f2bf(lo) | (f2bf(hi) << 16); }

#define XB_TMO      128
#define XB_XCNT(j)  (256  + 64 * (j))
#define XB_XSUB(j)  (1280 + 64 * (j))
#define XB_XGEN(j)  (2304 + 64 * (j))
#define XB_TOP      3328
#define XB_TOPGEN   3392
#define XCD_BAR_WORDS 3456
#define XB_SPIN_CAP (1u << 24)

__device__ __forceinline__ unsigned xb_ld(unsigned* p)              { return __hip_atomic_load(p, __ATOMIC_RELAXED, __HIP_MEMORY_SCOPE_AGENT); }
__device__ __forceinline__ unsigned xb_add(unsigned* p, unsigned v) { return __hip_atomic_fetch_add(p, v, __ATOMIC_RELAXED, __HIP_MEMORY_SCOPE_AGENT); }
__device__ __forceinline__ unsigned xb_xcc_id() { return (unsigned)__builtin_amdgcn_s_getreg((3 << 11) | 20) & 0xFu; }
#define XB_SPIN(cond, bar) do { unsigned _sp = 0; while (cond) { __builtin_amdgcn_s_sleep(1); \
    if ((++_sp & 255u) == 0u) { if (xb_ld(&(bar)[XB_TMO])) break; if (_sp > XB_SPIN_CAP) { atomicAdd(&(bar)[XB_TMO], 1u); break; } } } } while (0)

struct XcdBarrier {
    unsigned* bar; unsigned x;
    volatile LAS unsigned* st;
};

__device__ __forceinline__ XcdBarrier xcd_barrier_post(unsigned* bar, volatile LAS unsigned* st) {
    XcdBarrier b; b.bar = bar; b.x = xb_xcc_id(); b.st = st;
    if (threadIdx.x == 0) (void)xb_add(&bar[XB_XCNT(b.x)], 1u);
    return b;
}
__device__ __forceinline__ void xcd_barrier_complete(unsigned* bar, unsigned x, unsigned& nloc, unsigned& nx) {
    const unsigned G = gridDim.x * gridDim.y * gridDim.z;
    unsigned sum, cnt, mine, sp = 0u;
    for (;;) {
        sum = 0u; cnt = 0u; mine = 0u;
#pragma unroll
        for (unsigned j = 0; j < 16; ++j) { const unsigned c = xb_ld(&bar[XB_XCNT(j)]); sum += c; cnt += (c > 0u) ? 1u : 0u; mine = (j == x) ? c : mine; }
        if (sum == G) break;
        __builtin_amdgcn_s_sleep(1);
        if ((++sp & 255u) == 0u) { if (xb_ld(&bar[XB_TMO])) break; if (sp > XB_SPIN_CAP) { atomicAdd(&bar[XB_TMO], 1u); break; } }
    }
    nloc = mine > 0u ? mine : 1u; nx = cnt > 0u ? cnt : 1u;
}

__device__ __forceinline__ void xcd_barrier(const XcdBarrier& b) {
    asm volatile("s_waitcnt vmcnt(0)" ::: "memory");
    __syncthreads();
    if (threadIdx.x == 0) {
        unsigned* bar = b.bar;
        __builtin_amdgcn_s_waitcnt(0);
        unsigned nloc = b.st[0], nx = b.st[1];
        if (nloc == 0u) { xcd_barrier_complete(bar, b.x, nloc, nx); b.st[0] = nloc; b.st[1] = nx; }
        const unsigned old = xb_add(&bar[XB_XSUB(b.x)], 1u);
        const unsigned gen = old / nloc;
        if (old + 1u == (gen + 1u) * nloc) {
            __builtin_amdgcn_fence(__ATOMIC_RELEASE, "agent");
            asm volatile("s_waitcnt vmcnt(0)" ::: "memory");
            const unsigned og = xb_add(&bar[XB_TOP], 1u);
            const unsigned tg = og / nx;
            if (og + 1u == (tg + 1u) * nx) xb_add(&bar[XB_TOPGEN], 1u);
            else XB_SPIN(xb_ld(&bar[XB_TOPGEN]) == tg, bar);
            __builtin_amdgcn_fence(__ATOMIC_ACQUIRE, "agent");
            xb_add(&bar[XB_XGEN(b.x)], 1u);
            asm volatile("s_waitcnt vmcnt(0)" ::: "memory");
        } else {
            XB_SPIN(xb_ld(&bar[XB_XGEN(b.x)]) == gen, bar);
            __builtin_amdgcn_fence(__ATOMIC_ACQUIRE, "agent");
            asm volatile("s_waitcnt vmcnt(0)" ::: "memory");
        }
    }
    __syncthreads();
}


struct Frame {
    LAS unsigned char* lds;
    gu32* ctl;
    int tid, lane, wave, vcu, G, bx;
};
__device__ __forceinline__ float wave_sum(float v) {
#pragma unroll
    for (int o = 1; o < 64; o <<= 1) v += __shfl_xor(v, o);
    return v;
}
__device__ __forceinline__ float bf2f(unsigned short h) { return __uint_as_float((unsigned)h << 16); }
__device__ __forceinline__ float bflo(unsigned w) { return __uint_as_float(w << 16); }
__device__ __forceinline__ float bfhi(unsigned w) { return __uint_as_float(w & 0xffff0000u); }
__device__ __forceinline__ unsigned ld_agent(const void* p) { return __hip_atomic_load((const unsigned*)p, __ATOMIC_RELAXED, __HIP_MEMORY_SCOPE_AGENT); }

__device__ __forceinline__ int rowmap(int kind, int n) {
    if (kind == 0) return n;
    if (kind == 1) return n < 3072 ? n : (n < 3088 ? 3328 + (n - 3072) : 3072 + (n - 3088));
    return 32 * (n >> 4) + (n & 15) + (kind == 3 ? 16 : 0);
}
__device__ __forceinline__ void transpose_item(const float* W, int K, int N, bf16* WT, int kind, LAS float* scr, int item, int lane) {
    const int nblk = (N + 31) / 32, kb = item / nblk, nb = item % nblk, k0 = 64 * kb, n0 = 32 * nb;
    const int nn = n0 + (lane & 31); const bool ok = nn < N;
#pragma unroll 8
    for (int i = 0; i < 32; ++i) { const int kk = 2 * i + (lane >> 5); scr[kk * 33 + (lane & 31)] = ok ? W[(size_t)(k0 + kk) * N + nn] : 0.f; }
    LDS_WAIT(); asm volatile("" ::: "memory");
    const int c = lane & 7;
#pragma unroll
    for (int j = 0; j < 4; ++j) { const int n = (lane >> 3) + 8 * j; const LAS float* s = scr + (8 * c) * 33 + n;
        v4u o; o.x = pk2(s[0 * 33], s[1 * 33]); o.y = pk2(s[2 * 33], s[3 * 33]); o.z = pk2(s[4 * 33], s[5 * 33]); o.w = pk2(s[6 * 33], s[7 * 33]);
        if (n0 + n < N) *(GAS v4u*)(WT + (size_t)rowmap(kind, n0 + n) * K + k0 + 8 * c) = o; }
    LDS_WAIT(); asm volatile("" ::: "memory");
}
struct P0Args { const float *x, *mem, *wmemkv, *nawin, *mlwin, *wout, *w1, *w3, *w2; unsigned char* ws; };
__device__ __forceinline__ void p0_prologue(const Frame& F, const P0Args& a) {
    LAS float* scr = (LAS float*)(F.lds + F.wave * 16384);
    const int gw = F.vcu * NWAVES + F.wave, NGW = F.G * NWAVES;
    bf16* const W13 = (bf16*)(a.ws + WS_W13); bf16* const W2 = (bf16*)(a.ws + WS_W2);
    constexpr int I_MOE = DEPTH * NEXP * 3 * 256;
    constexpr int I_MKV = 16 * 16, I_NA = 16 * 80, I_ML = 16 * 105, I_WO = 16 * 32;
    constexpr int NITEMS = I_MOE + I_MKV + 2 * I_NA + 2 * I_ML + DEPTH * I_WO;
    for (int it = gw; it < NITEMS; it += NGW) {
        int r = it;
        if (r < I_MOE) { const int mat = r >> 8, sub = r & 255, le = mat / 3, which = mat - 3 * le;
            if (which == 0)      transpose_item(a.w1 + (size_t)le * D * DEXP, D, DEXP, W13 + (size_t)le * 1024 * 1024, 2, scr, sub, F.lane);
            else if (which == 1) transpose_item(a.w3 + (size_t)le * D * DEXP, D, DEXP, W13 + (size_t)le * 1024 * 1024, 3, scr, sub, F.lane);
            else                 transpose_item(a.w2 + (size_t)le * DEXP * D, DEXP, D, W2 + (size_t)le * 1024 * 512, 0, scr, sub, F.lane);
            continue; }
        r -= I_MOE;
        if (r < I_MKV) { transpose_item(a.wmemkv, D, 512, (bf16*)(a.ws + WS_WMEMKV), 0, scr, r, F.lane); continue; } r -= I_MKV;
        if (r < 2 * I_NA) { const int j = r / I_NA; transpose_item(a.nawin + (size_t)j * D * NA_IN, D, NA_IN, (bf16*)(a.ws + WS_WINNA) + (size_t)j * NA_IN * D, 0, scr, r - j * I_NA, F.lane); continue; } r -= 2 * I_NA;
        if (r < 2 * I_ML) { const int j = r / I_ML; transpose_item(a.mlwin + (size_t)j * D * ML_IN, D, ML_IN, (bf16*)(a.ws + WS_WINML) + (size_t)j * ML_INP * D, 1, scr, r - j * I_ML, F.lane); continue; } r -= 2 * I_ML;
        { const int l = r / I_WO; transpose_item(a.wout + (size_t)l * D * D, D, D, (bf16*)(a.ws + WS_WOUT) + (size_t)l * D * D, 0, scr, r - l * I_WO, F.lane); }
    }
    const int gt = F.vcu * NTHREADS + F.tid, NT = F.G * NTHREADS;
    for (int i = gt; i < 2 * 240 * (D / 8); i += NT) { const int j = i / (240 * (D / 8)), rr = i - j * 240 * (D / 8);
        *(GAS v4u*)((bf16*)(a.ws + WS_WINML) + (size_t)j * ML_INP * D + (size_t)ML_IN * D + (size_t)rr * 8) = (v4u){0u, 0u, 0u, 0u}; }
    for (int i = gt; i < M * D / 8; i += NT) { const f32x4 v0 = *(const GAS f32x4*)(a.x + (size_t)i * 8), v1 = *(const GAS f32x4*)(a.x + (size_t)i * 8 + 4);
        *(GAS v4u*)((bf16*)(a.ws + WS_XB) + (size_t)i * 8) = (v4u){pk2(v0.x, v0.y), pk2(v0.z, v0.w), pk2(v1.x, v1.y), pk2(v1.z, v1.w)}; }
    for (int i = gt; i < BATCH * NMEM * D / 8; i += NT) { const f32x4 v0 = *(const GAS f32x4*)(a.mem + (size_t)i * 8), v1 = *(const GAS f32x4*)(a.mem + (size_t)i * 8 + 4);
        *(GAS v4u*)((bf16*)(a.ws + WS_MEMB) + (size_t)i * 8) = (v4u){pk2(v0.x, v0.y), pk2(v0.z, v0.w), pk2(v1.x, v1.y), pk2(v1.z, v1.w)}; }
}

__device__ __forceinline__ void load8(const bf16* p, float* f) { const v4u w = *(const GAS v4u*)p;
    f[0] = bflo(w.x); f[1] = bfhi(w.x); f[2] = bflo(w.y); f[3] = bfhi(w.y); f[4] = bflo(w.z); f[5] = bfhi(w.z); f[6] = bflo(w.w); f[7] = bfhi(w.w); }
template <bool NA_LAYER>
__device__ __forceinline__ void attn_naive(const Frame& F, const bf16* PROJ, const float* MEMKV, const float* rpb  , bf16* MIXED) {
    const int gt = F.vcu * NTHREADS + F.tid, NT = F.G * NTHREADS;
    constexpr int ld = NA_LAYER ? NA_IN : ML_INP;
    constexpr int nheads = NA_LAYER ? 16 : 4;
    for (int it = gt; it < nheads * M; it += NT) {
        const int head = NA_LAYER ? (it >> 15) : 12 + (it >> 15), tok = it & (M - 1);
        const int b = tok >> 12, t = tok & 4095, r = t >> 6, c = t & 63;
        const int qcol = head < 12 ? head * 64 : (NA_LAYER ? 2304 : 3072) + (head - 12) * 64;
        float q[64], o[64];
#pragma unroll
        for (int i = 0; i < 8; ++i) load8(PROJ + (size_t)tok * ld + qcol + 8 * i, q + 8 * i);
#pragma unroll
        for (int i = 0; i < 64; ++i) o[i] = 0.f;
        float mx = -INFINITY, l = 0.f;
        if (NA_LAYER && head < 12) {
            const int rs = min(max(r - 4, 0), 56), cs = min(max(c - 8, 0), 48);
            for (int rr = 0; rr < 8; ++rr)
                for (int kk = 0; kk < 16; ++kk) {
                    const int kt = b * 4096 + (rs + rr) * 64 + cs + kk;
                    const bf16* kp = PROJ + (size_t)kt * ld + 768 + head * 64; const bf16* vp = kp + 768;
                    float s = 0.f;
#pragma unroll
                    for (int i = 0; i < 8; ++i) { float kf[8]; load8(kp + 8 * i, kf);
#pragma unroll
                        for (int j = 0; j < 8; ++j) s += q[8 * i + j] * kf[j]; }
                    s = s * 0.125f + rpb[(head * 15 + (rs + rr - r + 7)) * 31 + (cs + kk - c + 15)];
                    const float mn = fmaxf(mx, s), al = __expf(mx - mn), p = __expf(s - mn);
                    l = l * al + p; mx = mn;
#pragma unroll
                    for (int i = 0; i < 8; ++i) { float vf[8]; load8(vp + 8 * i, vf);
#pragma unroll
                        for (int j = 0; j < 8; ++j) o[8 * i + j] = o[8 * i + j] * al + p * vf[j]; }
                }
        } else {
            const int hm = head - 12;
            for (int key = 0; key < NMEM; ++key) {
                const float* kp = MEMKV + (size_t)(b * NMEM + key) * 512 + hm * 64; const float* vp = kp + 256;
                float s = 0.f;
#pragma unroll
                for (int i = 0; i < 16; ++i) { const f32x4 kf = *(const GAS f32x4*)(kp + 4 * i); s += q[4 * i] * kf.x + q[4 * i + 1] * kf.y + q[4 * i + 2] * kf.z + q[4 * i + 3] * kf.w; }
                s *= 0.125f;
                const float mn = fmaxf(mx, s), al = __expf(mx - mn), p = __expf(s - mn);
                l = l * al + p; mx = mn;
#pragma unroll
                for (int i = 0; i < 16; ++i) { const f32x4 vf = *(const GAS f32x4*)(vp + 4 * i);
                    o[4 * i] = o[4 * i] * al + p * vf.x; o[4 * i + 1] = o[4 * i + 1] * al + p * vf.y; o[4 * i + 2] = o[4 * i + 2] * al + p * vf.z; o[4 * i + 3] = o[4 * i + 3] * al + p * vf.w; }
            }
        }
        const float inv = 1.0f / l;
        bf16* op = MIXED + (size_t)tok * D + head * 64;
#pragma unroll
        for (int i = 0; i < 8; ++i) *(GAS v4u*)(op + 8 * i) = (v4u){pk2(o[8 * i] * inv, o[8 * i + 1] * inv), pk2(o[8 * i + 2] * inv, o[8 * i + 3] * inv), pk2(o[8 * i + 4] * inv, o[8 * i + 5] * inv), pk2(o[8 * i + 6] * inv, o[8 * i + 7] * inv)};
    }
}

__device__ __forceinline__ void ml_conv(const Frame& F, const bf16* PROJ, const float* cw  , const float* cb  , bf16* QKC) {
    const int gt = F.vcu * NTHREADS + F.tid, NT = F.G * NTHREADS;
    for (int it = gt; it < M * 192; it += NT) {
        const int tok = it / 192, c0 = (it - tok * 192) * 8, t = tok & 4095;
        float acc[8];
#pragma unroll
        for (int j = 0; j < 8; ++j) acc[j] = cb[c0 + j];
#pragma unroll
        for (int jj = 0; jj < 5; ++jj) { const int tt = t + jj - 2;
            if (tt >= 0 && tt < SEQ) { float xf[8]; load8(PROJ + (size_t)(tok + jj - 2) * ML_INP + c0, xf);
#pragma unroll
                for (int j = 0; j < 8; ++j) acc[j] += xf[j] * cw[jj * 1536 + c0 + j]; } }
#pragma unroll
        for (int j = 0; j < 8; ++j) acc[j] = acc[j] / (1.0f + __expf(-acc[j]));
        *(GAS v4u*)(QKC + (size_t)tok * 1536 + c0) = (v4u){pk2(acc[0], acc[1]), pk2(acc[2], acc[3]), pk2(acc[4], acc[5]), pk2(acc[6], acc[7])};
    }
}
__device__ __forceinline__ void ml_scan_naive(const Frame& F, const bf16* PROJ, const bf16* QKC, const float* GATES, const float* gate_b  , bf16* HOUT  ) {
    const int sid = F.bx;
    if (sid >= 64) return;
    const int b = sid >> 3, h = (sid >> 1) & 3, dir = sid & 1, tid = F.tid;
    LAS float* qs = (LAS float*)F.lds;
    LAS float* ks = qs + 32 * 192;
    LAS float* vs = ks + 32 * 192;
    LAS float* lis = vs + 32 * 192;
    LAS float* lfs = lis + 32;
    LAS float* psum = lfs + 32;
    const int e = tid % 193, half = tid / 193;
    const bool act = tid < 386;
    float C[96];
#pragma unroll
    for (int i = 0; i < 96; ++i) C[i] = 0.f;
    float m = 0.f;
    const float gbi = gate_b[dir * 4 + h], gbf = gate_b[(2 + dir) * 4 + h];
    const float qscale = 0.07216878364870322f;
    for (int ck = 0; ck < SEQ / 32; ++ck) {
        __syncthreads();
        for (int idx = tid; idx < 32 * 192; idx += NTHREADS) { const int tl = idx / 192, d = idx - tl * 192;
            const int tt = dir ? (SEQ - 1 - (ck * 32 + tl)) : (ck * 32 + tl); const size_t tok = (size_t)b * SEQ + tt;
            qs[idx] = bf2f(QKC[tok * 1536 + h * 192 + d]) * qscale; ks[idx] = bf2f(QKC[tok * 1536 + 768 + h * 192 + d]); vs[idx] = bf2f(PROJ[tok * ML_INP + 1536 + h * 192 + d]); }
        if (tid < 32) { const int tt = dir ? (SEQ - 1 - (ck * 32 + tid)) : (ck * 32 + tid); const size_t tok = (size_t)b * SEQ + tt;
            const float gi = GATES[tok * 16 + dir * 4 + h] + gbi, gf = GATES[tok * 16 + (2 + dir) * 4 + h] + gbf;
            lis[tid] = gi; lfs[tid] = fminf(gf, 0.f) - log1pf(__expf(-fabsf(gf))); }
        __syncthreads();
        for (int tl = 0; tl < 32; ++tl) {
            const float lf = lfs[tl], li = lis[tl];
            const float mn = fmaxf(lf + m, li), fd = __expf(lf + m - mn), iw = __expf(li - mn); m = mn;
            LAS float* ps = psum + (tl & 1) * 400;
            if (act) {
                const float kv = iw * (e < 192 ? vs[tl * 192 + e] : 1.0f);
                const LAS float* kr = ks + tl * 192 + half * 96; const LAS float* qr = qs + tl * 192 + half * 96;
                float part = 0.f;
#pragma unroll
                for (int i = 0; i < 24; ++i) { const f32x4 k4 = *(const LAS f32x4*)(kr + 4 * i), q4 = *(const LAS f32x4*)(qr + 4 * i);
                    C[4 * i] = fd * C[4 * i] + k4.x * kv; part += q4.x * C[4 * i];
                    C[4 * i + 1] = fd * C[4 * i + 1] + k4.y * kv; part += q4.y * C[4 * i + 1];
                    C[4 * i + 2] = fd * C[4 * i + 2] + k4.z * kv; part += q4.z * C[4 * i + 2];
                    C[4 * i + 3] = fd * C[4 * i + 3] + k4.w * kv; part += q4.w * C[4 * i + 3]; }
                ps[half * 200 + e] = part;
            }
            __syncthreads();
            if (tid < 192) { const float num = ps[tid] + ps[200 + tid], den = ps[192] + ps[200 + 192];
                const float hv = num / fmaxf(fabsf(den), __expf(-m));
                const int tt = dir ? (SEQ - 1 - (ck * 32 + tl)) : (ck * 32 + tl);
                HOUT[(size_t)dir * M * TOKW + ((size_t)b * SEQ + tt) * TOKW + h * 192 + tid] = (bf16)f2bf(hv); }
        }
    }
}
__device__ __forceinline__ void ml_norm_gate(const Frame& F, const bf16* PROJ, const bf16* HOUT, const float* norm_g  , bf16* MIXED) {
    const int gw = F.vcu * NWAVES + F.wave, NGW = F.G * NWAVES, lane = F.lane;
    for (int tok = gw; tok < M; tok += NGW) {
        const int c0 = lane * 12;
        float v[12]; float s = 0.f;
#pragma unroll
        for (int i = 0; i < 12; ++i) { v[i] = bf2f(HOUT[(size_t)tok * TOKW + c0 + i]) + bf2f(HOUT[(size_t)M * TOKW + (size_t)tok * TOKW + c0 + i]); s += v[i]; }
        s += __shfl_xor(s, 1); s += __shfl_xor(s, 2); s += __shfl_xor(s, 4); s += __shfl_xor(s, 8);
        const float mu = s * (1.0f / 192.0f); float q = 0.f;
#pragma unroll
        for (int i = 0; i < 12; ++i) { v[i] -= mu; q += v[i] * v[i]; }
        q += __shfl_xor(q, 1); q += __shfl_xor(q, 2); q += __shfl_xor(q, 4); q += __shfl_xor(q, 8);
        const float rstd = 1.0f / sqrtf(q * (1.0f / 192.0f) + LN_EPS);
#pragma unroll
        for (int i = 0; i < 12; ++i) { const float op = bf2f(PROJ[(size_t)tok * ML_INP + 2304 + c0 + i]);
            const float r = v[i] * rstd * norm_g[c0 + i] / (1.0f + __expf(-op));
            MIXED[(size_t)tok * D + c0 + i] = (bf16)f2bf(r); }
    }
}

__device__ __forceinline__ void ln1_route(const Frame& F, float* PRE, const float* g1, const float* b1, const float* wg, const float* bg, const float* we, const float* be,
                                           int* TOKE, float* TOKG, int* TOKP, int* ROWSLOT, gu32* cnt, int* WGBASE) {
    const int gw = F.vcu * NWAVES + F.wave, NGW = F.G * NWAVES, lane = F.lane;
    LAS int* HIST = (LAS int*)(F.lds + L_HIST);
    if (F.tid < 32) HIST[F.tid] = 0;
    { const int gt = F.vcu * NTHREADS + F.tid, NT = F.G * NTHREADS; for (int i = gt; i < P_MAX; i += NT) ROWSLOT[i] = -1; }
    __syncthreads();
    for (int row = gw; row < M; row += NGW) {
        GAS f32x4* xr = (GAS f32x4*)(PRE + (size_t)row * D) + lane;
        f32x4 v[4]; float s = 0.f;
#pragma unroll
        for (int j = 0; j < 4; ++j) { v[j] = xr[64 * j]; s += (v[j].x + v[j].y) + (v[j].z + v[j].w); }
        const float mean = wave_sum(s) * (1.f / D); float s2 = 0.f;
#pragma unroll
        for (int j = 0; j < 4; ++j) { v[j] = v[j] - mean; s2 += (v[j].x * v[j].x + v[j].y * v[j].y) + (v[j].z * v[j].z + v[j].w * v[j].w); }
        const float rstd = 1.f / sqrtf(wave_sum(s2) * (1.f / D) + LN_EPS);
        float gl[4] = {0.f, 0.f, 0.f, 0.f};
#pragma unroll
        for (int j = 0; j < 4; ++j) { const int col = 4 * lane + 256 * j; const f32x4 gg = *(const GAS f32x4*)(g1 + col), bb = *(const GAS f32x4*)(b1 + col);
            v[j] = v[j] * rstd * gg + bb; xr[64 * j] = v[j];
#pragma unroll
            for (int i = 0; i < 4; ++i) { const f32x4 w = *(const GAS f32x4*)(wg + (size_t)(col + i) * 4); const float xv = v[j][i];
                gl[0] += xv * w.x; gl[1] += xv * w.y; gl[2] += xv * w.z; gl[3] += xv * w.w; } }
#pragma unroll
        for (int g = 0; g < 4; ++g) gl[g] = wave_sum(gl[g]) + bg[g];
        int gi = 0; float gm = gl[0];
#pragma unroll
        for (int g = 1; g < 4; ++g) if (gl[g] > gm) { gm = gl[g]; gi = g; }
        float gs = 0.f;
#pragma unroll
        for (int g = 0; g < 4; ++g) gs += __expf(gl[g] - gm);
        const float ggate = 1.0f / gs;
        float el[8] = {0.f, 0.f, 0.f, 0.f, 0.f, 0.f, 0.f, 0.f};
#pragma unroll
        for (int j = 0; j < 4; ++j) { const int col = 4 * lane + 256 * j;
#pragma unroll
            for (int i = 0; i < 4; ++i) { const float* wp = we + (size_t)(col + i) * 32 + gi * 8; const f32x4 w0 = *(const GAS f32x4*)wp, w1 = *(const GAS f32x4*)(wp + 4); const float xv = v[j][i];
                el[0] += xv * w0.x; el[1] += xv * w0.y; el[2] += xv * w0.z; el[3] += xv * w0.w; el[4] += xv * w1.x; el[5] += xv * w1.y; el[6] += xv * w1.z; el[7] += xv * w1.w; } }
#pragma unroll
        for (int i = 0; i < 8; ++i) el[i] = wave_sum(el[i]) + be[gi * 8 + i];
        int i0 = 0; float l0 = el[0];
#pragma unroll
        for (int i = 1; i < 8; ++i) if (el[i] > l0) { l0 = el[i]; i0 = i; }
        int i1 = -1; float l1 = -INFINITY;
#pragma unroll
        for (int i = 0; i < 8; ++i) if (i != i0 && el[i] > l1) { l1 = el[i]; i1 = i; }
        const float p0 = 1.0f / (1.0f + __expf(l1 - l0)), p1 = 1.0f - p0;
        if (lane == 0) { const int e0 = gi * 8 + i0, e1 = gi * 8 + i1;
            const int q0 = atomicAdd((int*)(HIST + e0), 1), q1 = atomicAdd((int*)(HIST + e1), 1);
            TOKE[2 * row] = e0; TOKE[2 * row + 1] = e1; TOKG[2 * row] = ggate * p0; TOKG[2 * row + 1] = ggate * p1; TOKP[2 * row] = q0; TOKP[2 * row + 1] = q1; }
    }
    __syncthreads();
    if (F.tid < 32) WGBASE[F.tid] = (int)__hip_atomic_fetch_add(cnt + F.tid, (unsigned)HIST[F.tid], __ATOMIC_RELAXED, __HIP_MEMORY_SCOPE_AGENT);
    __syncthreads();
}
__device__ __forceinline__ void moe_gather(const Frame& F, const float* X1, const int* TOKE, const float* TOKG, const int* TOKP, int* ROWSLOT, float* ROWGATE, bf16* XS, gu32* cnt, int* TILETAB, const int* WGBASE) {
    const int gw = F.vcu * NWAVES + F.wave, NGW = F.G * NWAVES, lane = F.lane;
    LAS int* PADSTART = (LAS int*)(F.lds + L_PADSTART); LAS int* CNT = (LAS int*)(F.lds + L_CNT);
    if (F.tid < 32) CNT[F.tid] = (int)__hip_atomic_load(cnt + F.tid, __ATOMIC_RELAXED, __HIP_MEMORY_SCOPE_AGENT);
    __syncthreads();
    if (F.tid == 0) { int t = 0;
        for (int e = 0; e < NEXP; ++e) { PADSTART[e] = t * 256; const int nt = (CNT[e] + 255) >> 8;
            if (F.bx == 0) for (int k = 0; k < nt; ++k) TILETAB[1 + t + k] = e;
            t += nt; }
        if (F.bx == 0) TILETAB[0] = t; }
    __syncthreads();
    for (int row = gw; row < M; row += NGW) {
        const GAS f32x4* xr = (const GAS f32x4*)(X1 + (size_t)row * D) + lane;
        f32x4 v[4];
#pragma unroll
        for (int j = 0; j < 4; ++j) v[j] = xr[64 * j];
#pragma unroll
        for (int k = 0; k < 2; ++k) { const int e = TOKE[2 * row + k], q = TOKP[2 * row + k]; const int dest = PADSTART[e] + WGBASE[e] + q;
            if (lane == 0) { ROWSLOT[dest] = 2 * row + k; ROWGATE[dest] = TOKG[2 * row + k]; }
            GAS unsigned long long* o8 = (GAS unsigned long long*)(XS + (size_t)dest * D) + lane;
#pragma unroll
            for (int j = 0; j < 4; ++j) o8[64 * j] = (unsigned long long)pk2(v[j].x, v[j].y) | ((unsigned long long)pk2(v[j].z, v[j].w) << 32); }
    }
}
__device__ __forceinline__ void ln2_pass(const Frame& F, const float* X1, const bf16* Y, const float* g2, const float* b2, float* XOUT, bf16* XB) {
    const int gw = F.vcu * NWAVES + F.wave, NGW = F.G * NWAVES, lane = F.lane;
    for (int row = gw; row < M; row += NGW) {
        const GAS f32x4* xr = (const GAS f32x4*)(X1 + (size_t)row * D) + lane;
        const GAS unsigned long long* y0 = (const GAS unsigned long long*)(Y + (size_t)(2 * row) * D) + lane;
        const GAS unsigned long long* y1 = (const GAS unsigned long long*)(Y + (size_t)(2 * row + 1) * D) + lane;
        f32x4 v[4]; float s = 0.f;
#pragma unroll
        for (int j = 0; j < 4; ++j) { const f32x4 x = xr[64 * j]; const unsigned long long a = y0[64 * j], c = y1[64 * j];
            const unsigned a0 = (unsigned)a, a1 = (unsigned)(a >> 32), c0 = (unsigned)c, c1 = (unsigned)(c >> 32);
            v[j].x = ALPHA * x.x + (bflo(a0) + bflo(c0)); v[j].y = ALPHA * x.y + (bfhi(a0) + bfhi(c0)); v[j].z = ALPHA * x.z + (bflo(a1) + bflo(c1)); v[j].w = ALPHA * x.w + (bfhi(a1) + bfhi(c1));
            s += (v[j].x + v[j].y) + (v[j].z + v[j].w); }
        const float mean = wave_sum(s) * (1.f / D); float s2 = 0.f;
#pragma unroll
        for (int j = 0; j < 4; ++j) { v[j] = v[j] - mean; s2 += (v[j].x * v[j].x + v[j].y * v[j].y) + (v[j].z * v[j].z + v[j].w * v[j].w); }
        const float rstd = 1.f / sqrtf(wave_sum(s2) * (1.f / D) + LN_EPS);
        GAS f32x4* orow = (GAS f32x4*)(XOUT + (size_t)row * D) + lane; GAS unsigned long long* ob = (GAS unsigned long long*)(XB + (size_t)row * D) + lane;
#pragma unroll
        for (int j = 0; j < 4; ++j) { const int col = 4 * lane + 256 * j; const f32x4 gg = *(const GAS f32x4*)(g2 + col), bb = *(const GAS f32x4*)(b2 + col);
            const f32x4 y = v[j] * rstd * gg + bb; orow[64 * j] = y;
            ob[64 * j] = (unsigned long long)pk2(y.x, y.y) | ((unsigned long long)pk2(y.z, y.w) << 32); }
    }
}

struct Args { const float* in[22]; float* out; unsigned char* ws; int ph_lo, ph_hi; };
static_assert(sizeof(Args) == 22 * 8 + 8 + 8 + 8, "Args has no padding");
enum PhaseKind { K_P0 = 0, K_P1, K_PA, K_PB, K_PB2, K_PB3, K_PC, K_PD, K_PE, K_PF, K_PG, K_PH };
constexpr int N_PHASES = 2 + 2 * 8 + 2 * 10;
__device__ __forceinline__ void decode_phase(int ph, int& layer, int& kind) {
    if (ph < 2) { layer = 0; kind = ph; return; }
    int r = ph - 2; const int pair = r / 18; r -= pair * 18;
    if (r < 8) { layer = 2 * pair; kind = r == 0 ? K_PA : (r == 1 ? K_PB : K_PC + (r - 2)); }
    else { r -= 8; layer = 2 * pair + 1; kind = K_PA + r; }
}
__host__ __device__ constexpr int phase_layer(int ph) { if (ph < 2) return 0; int r = ph - 2; const int pair = r / 18; r -= pair * 18; return r < 8 ? 2 * pair : 2 * pair + 1; }
__host__ __device__ constexpr int phase_kind(int ph) { if (ph < 2) return ph; int r = ph - 2; const int pair = r / 18; r -= pair * 18;
    if (r < 8) return r == 0 ? K_PA : (r == 1 ? K_PB : K_PC + (r - 2)); return K_PA + (r - 8); }
template <int PH>
__device__ __forceinline__ void run_phase(const Args& args, LAS unsigned char* lds) {
    constexpr int layer = phase_layer(PH), kind = phase_kind(PH), jj = layer >> 1; constexpr bool is_na = (layer & 1) == 0;
    int tid_ = threadIdx.x; asm volatile("" : "+v"(tid_));
    int bx_ = blockIdx.x; asm volatile("" : "+s"(bx_));
    Frame F;
    F.lds = lds;
    F.tid = tid_; F.lane = F.tid & 63; F.wave = __builtin_amdgcn_readfirstlane(F.tid >> 6);
    F.G = gridDim.x; F.bx = bx_; F.vcu = (F.G % 8 == 0) ? (bx_ % 8) * (F.G / 8) + bx_ / 8 : bx_;
    unsigned char* ws = args.ws; asm volatile("" : "+s"(ws)); F.ctl = (gu32*)(ws + WS_CTL);
    float* const outp = args.out;
#define IN_(k) (args.in[k])
        if constexpr (kind == K_P0) {
        P0Args a{IN_(0), IN_(1), IN_(2), IN_(3), IN_(5), IN_(10), IN_(19), IN_(20), IN_(21), ws};
        p0_prologue(F, a);
    }
    if constexpr (kind == K_P1) {
        pg8::Gemm g{(const bf16*)(ws + WS_MEMB), (const bf16*)(ws + WS_WMEMKV), BATCH * NMEM, 512, D}; pg8::StaticOrder S; S.init(BATCH * NMEM, 512, F.G, F.bx);
        pg8::EpiF32 E{(float*)(ws + WS_MEMKV), 512};
        pg8::gemm_phase<pg8::EpiF32, pg8::StaticOrder, PG8_ALIGN, PG8_SP2>(F.lds, g, S, E);
    }
    if constexpr (kind == K_PA) {
        const int N = is_na ? NA_IN : ML_INP;
        const bf16* Bt = is_na ? (const bf16*)(ws + WS_WINNA) + (size_t)jj * NA_IN * D : (const bf16*)(ws + WS_WINML) + (size_t)jj * ML_INP * D;
        pg8::Gemm g{(const bf16*)(ws + WS_XB), Bt, M, N, D}; pg8::StaticOrder S; S.init(M, N, F.G, F.bx);
        pg8::EpiProj E{(bf16*)(ws + WS_PROJ), N, is_na ? nullptr : (float*)(ws + WS_GATES), ML_GATE_PN};
        pg8::gemm_phase<pg8::EpiProj, pg8::StaticOrder, PG8_ALIGN, PG8_SP2>(F.lds, g, S, E);
    }
    if constexpr (kind == K_PB) {
        if (is_na) attn_naive<true>(F, (const bf16*)(ws + WS_PROJ), (const float*)(ws + WS_MEMKV), IN_(4) + (size_t)jj * NAH * 15 * 31, (bf16*)(ws + WS_MIXED));
        else { attn_naive<false>(F, (const bf16*)(ws + WS_PROJ), (const float*)(ws + WS_MEMKV), nullptr, (bf16*)(ws + WS_MIXED));
               ml_conv(F, (const bf16*)(ws + WS_PROJ), IN_(6) + (size_t)jj * 5 * 1536, IN_(7) + (size_t)jj * 1536, (bf16*)(ws + WS_QKC)); }
    }
    if constexpr (kind == K_PB2) {
        ml_scan_naive(F, (const bf16*)(ws + WS_PROJ), (const bf16*)(ws + WS_QKC), (const float*)(ws + WS_GATES), IN_(8) + (size_t)jj * 16, (bf16*)(ws + WS_H));
    }
    if constexpr (kind == K_PB3) {
        ml_norm_gate(F, (const bf16*)(ws + WS_PROJ), (const bf16*)(ws + WS_H), IN_(9) + (size_t)jj * TOKW, (bf16*)(ws + WS_MIXED));
    }
    if constexpr (kind == K_PC) {
        const float* xres = layer == 0 ? IN_(0) : outp;
        pg8::Gemm g{(const bf16*)(ws + WS_MIXED), (const bf16*)(ws + WS_WOUT) + (size_t)layer * D * D, M, D, D}; pg8::StaticOrder S; S.init(M, D, F.G, F.bx);
        pg8::EpiResF32 E{xres, (float*)(ws + WS_PRE), D, ALPHA};
        pg8::gemm_phase<pg8::EpiResF32, pg8::StaticOrder, PG8_ALIGN, PG8_SP2>(F.lds, g, S, E);
    }
    if constexpr (kind == K_PD) {
        ln1_route(F, (float*)(ws + WS_PRE), IN_(11) + (size_t)layer * D, IN_(12) + (size_t)layer * D, IN_(15) + (size_t)layer * D * NGRP, IN_(16) + (size_t)layer * NGRP,
                  IN_(17) + (size_t)layer * D * NEXP, IN_(18) + (size_t)layer * NEXP, (int*)(ws + WS_TOKE), (float*)(ws + WS_TOKG), (int*)(ws + WS_TOKP), (int*)(ws + WS_ROWSLOT),
                  F.ctl + CW_CNT + 64 * layer, (int*)(ws + WS_MISC) + 1024 + 32 * F.bx);
    }
    if constexpr (kind == K_PE) {
        moe_gather(F, (const float*)(ws + WS_PRE), (const int*)(ws + WS_TOKE), (const float*)(ws + WS_TOKG), (const int*)(ws + WS_TOKP), (int*)(ws + WS_ROWSLOT), (float*)(ws + WS_ROWGATE),
                   (bf16*)(ws + WS_XS), F.ctl + CW_CNT + 64 * layer, (int*)(ws + WS_MISC), (const int*)(ws + WS_MISC) + 1024 + 32 * F.bx);
    }
    if constexpr (kind == K_PF) {
        const int* TILETAB = (const int*)(ws + WS_MISC);
        const int nT = __builtin_amdgcn_readfirstlane((int)ld_agent(TILETAB));
        pg8::Gemm g{(const bf16*)(ws + WS_XS), (const bf16*)(ws + WS_W13) + (size_t)layer * NEXP * 1024 * 1024, nT * 256, 1024, D}; pg8::GroupedOrder S; S.init(nT, 1024, F.G, F.bx, TILETAB + 1);
        pg8::EpiSwiGLU E{(bf16*)(ws + WS_HID), DEXP};
        pg8::gemm_phase<pg8::EpiSwiGLU, pg8::GroupedOrder, PG8_ALIGN, PG8_SP2>(F.lds, g, S, E);
    }
    if constexpr (kind == K_PG) {
        const int* TILETAB = (const int*)(ws + WS_MISC);
        const int nT = __builtin_amdgcn_readfirstlane((int)ld_agent(TILETAB));
        pg8::Gemm g{(const bf16*)(ws + WS_HID), (const bf16*)(ws + WS_W2) + (size_t)layer * NEXP * 1024 * 512, nT * 256, 1024, DEXP}; pg8::GroupedOrder S; S.init(nT, 1024, F.G, F.bx, TILETAB + 1);
        pg8::EpiMoeDown E{(bf16*)(ws + WS_Y), D, (const int*)(ws + WS_ROWSLOT), (const float*)(ws + WS_ROWGATE)};
        pg8::gemm_phase<pg8::EpiMoeDown, pg8::GroupedOrder, PG8_ALIGN, PG8_SP2>(F.lds, g, S, E);
    }
    if constexpr (kind == K_PH) {
        ln2_pass(F, (const float*)(ws + WS_PRE), (const bf16*)(ws + WS_Y), IN_(13) + (size_t)layer * D, IN_(14) + (size_t)layer * D, outp, (bf16*)(ws + WS_XB));
    }
}
template <int PH>
__device__ __forceinline__ void run_all(const Args& args, LAS unsigned char* lds, int lo, int hi, const XcdBarrier& bar) {
    if constexpr (PH < N_PHASES) {
        if (lo <= PH && PH < hi) { run_phase<PH>(args, lds); if (PH + 1 < hi) xcd_barrier(bar); }
        run_all<PH + 1>(args, lds, lo, hi, bar);
    }
}
__global__ void __launch_bounds__(NTHREADS, 2) mk_fwd(Args args) {
    extern __shared__ __attribute__((aligned(16))) unsigned char lds[];
    for (int u = threadIdx.x; u < LDSCTL_BYTES / 4; u += NTHREADS) ((LAS unsigned*)((LAS unsigned char*)lds + LDSCTL_OFF))[u] = 0u;
    __syncthreads();
    const int lo = args.ph_lo, hi = args.ph_hi;
    XcdBarrier bar; bar.bar = (unsigned*)((gu32*)(args.ws + WS_CTL) + CW_BAR); bar.x = 0; bar.st = nullptr;
    if (hi - lo > 1) bar = xcd_barrier_post((unsigned*)((gu32*)(args.ws + WS_CTL) + CW_BAR), (volatile LAS unsigned*)((LAS unsigned char*)lds + L_MISC) + 8);
    run_all<0>(args, (LAS unsigned char*)lds, lo, hi, bar);
}

#ifndef MK_PER_PHASE
#define MK_PER_PHASE 0
#endif
extern "C" void kernel_launch(void* const* d_in, const int* in_sizes, int n_in, void* d_out, int out_size, void* d_ws, size_t ws_size, hipStream_t stream) {
    static int grid = 0;
    if (grid == 0) {
        if (n_in != 22 || in_sizes[0] != M * D || out_size != M * D || ws_size < WS_END) { fprintf(stderr, "kernel_launch: unexpected shapes (n_in %d, in0 %d, out %d, ws %zu; need ws >= %zu); nothing launched\n", n_in, n_in > 0 ? in_sizes[0] : -1, out_size, ws_size, (size_t)WS_END); grid = -1; return; }
        int dev = 0, cus = 0, per_cu = 0;
        if (hipGetDevice(&dev) != hipSuccess || hipDeviceGetAttribute(&cus, hipDeviceAttributeMultiprocessorCount, dev) != hipSuccess) { fprintf(stderr, "kernel_launch: device query failed\n"); grid = -1; return; }
        if (hipFuncSetAttribute((const void*)mk_fwd, hipFuncAttributeMaxDynamicSharedMemorySize, LDS_BYTES) != hipSuccess) { fprintf(stderr, "kernel_launch: hipFuncSetAttribute failed\n"); grid = -1; return; }
        if (hipOccupancyMaxActiveBlocksPerMultiprocessor(&per_cu, (const void*)mk_fwd, NTHREADS, LDS_BYTES) != hipSuccess || per_cu < 1)
            fprintf(stderr, "kernel_launch: note: occupancy query reports %d workgroups per CU\n", per_cu);
        (void)hipGetLastError();
        grid = cus;
    }
    if (grid < 0) return;
    if (hipMemsetAsync((char*)d_ws + WS_CTL, 0, CTL_ZERO_BYTES, stream) != hipSuccess) { fprintf(stderr, "kernel_launch: memset failed\n"); return; }
    Args a{};
    for (int i = 0; i < 22; ++i) a.in[i] = (const float*)d_in[i];
    a.out = (float*)d_out; a.ws = (unsigned char*)d_ws;
#if MK_PER_PHASE
    for (int p = 0; p < N_PHASES; ++p) { a.ph_lo = p; a.ph_hi = p + 1; hipLaunchKernelGGL(mk_fwd, dim3(grid), dim3(NTHREADS), LDS_BYTES, stream, a); }
#else
    a.ph_lo = 0; a.ph_hi = N_PHASES;
    hipLaunchKernelGGL(mk_fwd, dim3(grid), dim3(NTHREADS), LDS_BYTES, stream, a);
#endif
    const hipError_t le = hipPeekAtLastError();
    if (le != hipSuccess) fprintf(stderr, "kernel_launch: launch failed: %s (grid %d)\n", hipGetErrorName(le), grid);
}
```

```cpp
#include <hip/hip_runtime.h>
#include <cstdio>
#include <cstdint>
#ifndef MK_SUBPROBE
#define MK_SUBPROBE 0
#endif
namespace pg8 {
#define PG8_LAS __attribute__((address_space(3)))
typedef unsigned short bf16_t;
typedef short bf16x8 __attribute__((ext_vector_type(8)));
typedef float f32x4 __attribute__((ext_vector_type(4)));
typedef unsigned u32x4 __attribute__((ext_vector_type(4)));
typedef unsigned u32x2 __attribute__((ext_vector_type(2)));
constexpr int BM = 256, BK = 64, HALF = 128, HTB = HALF * BK * 2  , STAGE_BYTES = 8 * HTB, NXCD = 8, WGM = 8;

__host__ __device__ __forceinline__ int lds_byte(int r, int c) { const int st = (r >> 4) * 2 + (c >> 5), rr = r & 15, cc = c & 31, ob = rr * 64 + cc * 2; return st * 1024 + (ob ^ (((ob >> 9) & 1) << 5)); }
__host__ __device__ __forceinline__ void stage_rc(int b, int& R, int& C) { const int st = b / 1024, sb = b % 1024, swz = sb ^ (((sb >> 9) & 1) << 5); R = (st >> 1) * 16 + swz / 64; C = (st & 1) * 32 + (swz % 64) / 2; }
__host__ __device__ __forceinline__ int perm32(int rho) { const int n = rho >> 4, i = rho & 15; return 8 * (i >> 2) + 4 * n + (i & 3); }

struct Unit { int pm, pn, brow; };
struct Gemm { const bf16_t* A; const bf16_t* Bt; int M, N, K; };

struct StaticOrder {
    int nM, nN, nwg, G, c;
    __host__ __device__ void init(int M, int N, int G_, int c_) { nM = M / BM; nN = N / BM; nwg = nM * nN; G = G_; c = c_; }
    __host__ __device__ bool next(int i, Unit& u) const {
        const long L = (long)i * G + c; if (L >= nwg) return false;
        int wgid = (int)L; { const int q = nwg / NXCD, r = nwg % NXCD, xcd = wgid % NXCD, off = wgid / NXCD; wgid = (xcd < r ? xcd * (q + 1) : r * (q + 1) + (xcd - r) * q) + off; }
        const int nig = WGM * nN, gid = wgid / nig, fm = gid * WGM, gsz = (nM - fm) < WGM ? (nM - fm) : WGM;
        u.pm = fm + ((wgid % nig) % gsz); u.pn = (wgid % nig) / gsz; u.brow = u.pn * BM; return true;
    }
    __device__ __forceinline__ void a_ready(const Unit&) const {}
    __device__ __forceinline__ void done(const Unit&) const {}
};
struct GroupedOrder {
    int nM, nN, nwg, G, c; const int* tile_exp;
    __device__ void init(int nT, int N, int G_, int c_, const int* te) { nM = nT; nN = N / BM; nwg = nM * nN; G = G_; c = c_; tile_exp = te; }
    __device__ bool next(int i, Unit& u) const {
        const long L = (long)i * G + c; if (L >= nwg) return false;
        int wgid = (int)L; { const int q = nwg / NXCD, r = nwg % NXCD, xcd = wgid % NXCD, off = wgid / NXCD; wgid = (xcd < r ? xcd * (q + 1) : r * (q + 1) + (xcd - r) * q) + off; }
        const int nig = WGM * nN, gid = wgid / nig, fm = gid * WGM, gsz = (nM - fm) < WGM ? (nM - fm) : WGM;
        u.pm = fm + ((wgid % nig) % gsz); u.pn = (wgid % nig) / gsz;
        const int e = __builtin_amdgcn_readfirstlane((int)__hip_atomic_load((const unsigned*)tile_exp + u.pm, __ATOMIC_RELAXED, __HIP_MEMORY_SCOPE_AGENT));
        u.brow = e * (nN * BM) + u.pn * BM; return true;
    }
    __device__ __forceinline__ void a_ready(const Unit&) const {}
    __device__ __forceinline__ void done(const Unit&) const {}
};

__device__ __forceinline__ unsigned cvt_pk_bf16(float lo, float hi) { unsigned r; asm volatile("v_cvt_pk_bf16_f32 %0, %1, %2" : "=v"(r) : "v"(lo), "v"(hi)); return r; }

struct EpiProj {
    static constexpr bool PERM = true, AFTER_DRAIN = false;
    bf16_t* O; int ldc; float* gates; int gate_pn;
    __device__ __forceinline__ void operator()(const f32x4 (&acc)[2][2][4][2], const Unit& u, int wr, int wc, int fr, int fq) const {
        const int row0 = u.pm * BM + wr * 64 + fr, col0 = u.pn * BM + wc * 32 + 8 * fq;
#pragma unroll
        for (int ai = 0; ai < 2; ++ai)
#pragma unroll
            for (int m = 0; m < 4; ++m) { bf16_t* rowp = O + (size_t)(row0 + ai * HALF + m * 16) * ldc + col0;
#pragma unroll
                for (int bj = 0; bj < 2; ++bj) { const f32x4 v0 = acc[ai][bj][m][0], v1 = acc[ai][bj][m][1];
                    u32x4 w; w.x = cvt_pk_bf16(v0[0], v0[1]); w.y = cvt_pk_bf16(v0[2], v0[3]); w.z = cvt_pk_bf16(v1[0], v1[1]); w.w = cvt_pk_bf16(v1[2], v1[3]);
                    *(u32x4*)(rowp + bj * HALF) = w; } }
        if (gates != nullptr && u.pn == gate_pn && wc == 0 && fq < 2) {
#pragma unroll
            for (int ai = 0; ai < 2; ++ai)
#pragma unroll
                for (int m = 0; m < 4; ++m) { float* gp = gates + (size_t)(row0 + ai * HALF + m * 16) * 16 + 8 * fq;
                    *(f32x4*)gp = acc[ai][0][m][0]; *(f32x4*)(gp + 4) = acc[ai][0][m][1]; }
        }
    }
};
struct EpiF32 {
    static constexpr bool PERM = false, AFTER_DRAIN = false;
    float* C; int ldc;
    __device__ __forceinline__ void operator()(const f32x4 (&acc)[2][2][4][2], const Unit& u, int wr, int wc, int fr, int fq) const {
        const int row0 = u.pm * BM + wr * 64 + fr, col0 = u.pn * BM + wc * 32 + 4 * fq;
#pragma unroll
        for (int ai = 0; ai < 2; ++ai)
#pragma unroll
            for (int m = 0; m < 4; ++m) { float* rowp = C + (size_t)(row0 + ai * HALF + m * 16) * ldc + col0;
#pragma unroll
                for (int bj = 0; bj < 2; ++bj)
#pragma unroll
                    for (int n = 0; n < 2; ++n) *(f32x4*)(rowp + bj * HALF + n * 16) = acc[ai][bj][m][n]; }
    }
};
struct EpiResBf16 {
    static constexpr bool PERM = true, AFTER_DRAIN = false;
    const bf16_t* base; bf16_t* out; int ldc; float alpha;
    __device__ __forceinline__ void operator()(const f32x4 (&acc)[2][2][4][2], const Unit& u, int wr, int wc, int fr, int fq) const {
        const int row0 = u.pm * BM + wr * 64 + fr, col0 = u.pn * BM + wc * 32 + 8 * fq;
#pragma unroll
        for (int ai = 0; ai < 2; ++ai)
#pragma unroll
            for (int m = 0; m < 4; ++m) { const size_t off = (size_t)(row0 + ai * HALF + m * 16) * ldc + col0;
#pragma unroll
                for (int bj = 0; bj < 2; ++bj) { const u32x4 bw = *(const u32x4*)(base + off + bj * HALF);
                    const f32x4 b0 = {__uint_as_float(bw.x << 16), __uint_as_float(bw.x & 0xffff0000u), __uint_as_float(bw.y << 16), __uint_as_float(bw.y & 0xffff0000u)};
                    const f32x4 b1 = {__uint_as_float(bw.z << 16), __uint_as_float(bw.z & 0xffff0000u), __uint_as_float(bw.w << 16), __uint_as_float(bw.w & 0xffff0000u)};
                    const f32x4 v0 = b0 * alpha + acc[ai][bj][m][0], v1 = b1 * alpha + acc[ai][bj][m][1];
                    u32x4 w; w.x = cvt_pk_bf16(v0[0], v0[1]); w.y = cvt_pk_bf16(v0[2], v0[3]); w.z = cvt_pk_bf16(v1[0], v1[1]); w.w = cvt_pk_bf16(v1[2], v1[3]);
                    *(u32x4*)(out + off + bj * HALF) = w; } }
    }
};
struct EpiSwiGLU {
    static constexpr bool PERM = false, AFTER_DRAIN = false;
    bf16_t* H; int ldh;
    __device__ __forceinline__ void operator()(const f32x4 (&acc)[2][2][4][2], const Unit& u, int wr, int wc, int fr, int fq) const {
        const int row0 = u.pm * BM + wr * 64 + fr, col0 = u.pn * HALF + wc * 16 + 4 * fq;
#pragma unroll
        for (int ai = 0; ai < 2; ++ai)
#pragma unroll
            for (int m = 0; m < 4; ++m) { bf16_t* rowp = H + (size_t)(row0 + ai * HALF + m * 16) * ldh + col0;
#pragma unroll
                for (int bj = 0; bj < 2; ++bj) { const f32x4 a = acc[ai][bj][m][0], b = acc[ai][bj][m][1]; float h[4];
#pragma unroll
                    for (int j = 0; j < 4; ++j) h[j] = a[j] / (1.0f + __expf(-a[j])) * b[j];
                    u32x2 w; w.x = cvt_pk_bf16(h[0], h[1]); w.y = cvt_pk_bf16(h[2], h[3]);
                    *(u32x2*)(rowp + bj * 64) = w; } }
    }
};
struct EpiMoeDown {
    static constexpr bool PERM = true, AFTER_DRAIN = false;
    bf16_t* Y; int ldc; const int* row_slot; const float* row_gate;
    __device__ __forceinline__ void operator()(const f32x4 (&acc)[2][2][4][2], const Unit& u, int wr, int wc, int fr, int fq) const {
        const int row0 = u.pm * BM + wr * 64 + fr, col0 = u.pn * BM + wc * 32 + 8 * fq;
#pragma unroll
        for (int ai = 0; ai < 2; ++ai)
#pragma unroll
            for (int m = 0; m < 4; ++m) { const int row = row0 + ai * HALF + m * 16;
                const int slot = (int)__hip_atomic_load((const unsigned*)row_slot + row, __ATOMIC_RELAXED, __HIP_MEMORY_SCOPE_AGENT);
                const float gt = __uint_as_float(__hip_atomic_load((const unsigned*)row_gate + row, __ATOMIC_RELAXED, __HIP_MEMORY_SCOPE_AGENT));
                if (slot >= 0) { bf16_t* rowp = Y + (size_t)slot * ldc + col0;
#pragma unroll
                    for (int bj = 0; bj < 2; ++bj) { const f32x4 v0 = acc[ai][bj][m][0] * gt, v1 = acc[ai][bj][m][1] * gt;
                        u32x4 w; w.x = cvt_pk_bf16(v0[0], v0[1]); w.y = cvt_pk_bf16(v0[2], v0[3]); w.z = cvt_pk_bf16(v1[0], v1[1]); w.w = cvt_pk_bf16(v1[2], v1[3]);
                        *(u32x4*)(rowp + bj * HALF) = w; } } }
    }
};

template <class Epi, class Sched, bool ALIGN_EPI = false, bool SP2 = false>
__device__ __forceinline__ void gemm_phase(PG8_LAS unsigned char* lds, const Gemm g, const Sched& S, const Epi& E) {
    int tid_l = threadIdx.x; asm volatile("" : "+v"(tid_l));
    const int tid = tid_l, wid = __builtin_amdgcn_readfirstlane(tid >> 6), lane = tid & 63, wr = wid >> 2, wc = wid & 3, fr = lane & 15, fq = lane >> 4;
    const int K = g.K, nt = K / BK;
    unsigned voffA[2], voffB[2];
#pragma unroll
    for (int i = 0; i < 2; ++i) { int R, C; stage_rc(tid * 16 + i * 8192, R, C); const int Rb = Epi::PERM ? ((R & ~31) + perm32(R & 31)) : R;
        voffA[i] = (unsigned)(R * K + C) * 2u; voffB[i] = (unsigned)(Rb * K + C) * 2u; }
    const size_t kstep = (size_t)(BK * 2);
    const size_t hstep = (size_t)HALF * K * 2;
    const size_t tstep = 2 * hstep;
    const unsigned ldsw = (unsigned)wid * 1024u;
    const int aoff = lds_byte(wr * 64 + fr, fq * 8), boff = lds_byte(wc * 32 + fr, fq * 8);
#define PG8_SA(b, h) (((b) * 2 + (h)) * HTB)
#define PG8_SB(b, h) ((4 + (b) * 2 + (h)) * HTB)
#define PG8_STAGE(bufoff, gbase, voff) do { _Pragma("unroll") for (int _i = 0; _i < 2; ++_i) \
        __builtin_amdgcn_global_load_lds((const unsigned*)((const char*)(gbase) + (voff)[_i]), (PG8_LAS unsigned*)(lds + (bufoff) + ldsw + _i * 8192), 16, 0, 0); } while (0)
#define PG8_LDA(dst, b, h) do { _Pragma("unroll") for (int m = 0; m < 4; ++m) _Pragma("unroll") for (int k = 0; k < 2; ++k) dst[m][k] = *(const PG8_LAS bf16x8*)(lds + PG8_SA(b, h) + aoff + m * 2048 + k * 1024); } while (0)
#define PG8_LDB(dst, b, h) do { _Pragma("unroll") for (int n = 0; n < 2; ++n) _Pragma("unroll") for (int k = 0; k < 2; ++k) dst[n][k] = *(const PG8_LAS bf16x8*)(lds + PG8_SB(b, h) + boff + n * 2048 + k * 1024); } while (0)
#define PG8_MMA(ai, bj, At, Bt) do { __builtin_amdgcn_s_setprio(1); _Pragma("unroll") for (int m = 0; m < 4; ++m) _Pragma("unroll") for (int n = 0; n < 2; ++n) _Pragma("unroll") for (int k = 0; k < 2; ++k) \
        acc[ai][bj][m][n] = __builtin_amdgcn_mfma_f32_16x16x32_bf16(Bt[n][k], At[m][k], acc[ai][bj][m][n], 0, 0, 0); __builtin_amdgcn_s_setprio(0); } while (0)
#define PG8_WAIT_V(n) asm volatile("s_waitcnt vmcnt(" #n ")" ::: "memory")
#define PG8_WAIT_L(n) asm volatile("s_waitcnt lgkmcnt(" #n ")" ::: "memory")
#define PG8_BAR __builtin_amdgcn_s_barrier()
#define PG8_SCHED __builtin_amdgcn_sched_barrier(0)
    Unit cur, nxt; int ui = 0;
    if (!S.next(0, cur)) return;
    f32x4 acc[2][2][4][2];
#pragma unroll
    for (int a = 0; a < 2; ++a)
#pragma unroll
        for (int b = 0; b < 2; ++b)
#pragma unroll
            for (int m = 0; m < 4; ++m)
#pragma unroll
                for (int n = 0; n < 2; ++n) acc[a][b][m][n] = (f32x4){0.f, 0.f, 0.f, 0.f};
    bf16x8 At[4][2], B0[2][2], B1[2][2];
    const char* cA = (const char*)g.A + (size_t)cur.pm * tstep; const char* cB = (const char*)g.Bt + (size_t)cur.brow * (size_t)K * 2;
    S.a_ready(cur);
    if constexpr (SP2) {
        PG8_STAGE(PG8_SB(0, 0), cB, voffB); PG8_STAGE(PG8_SB(0, 1), cB + hstep, voffB); PG8_STAGE(PG8_SA(0, 0), cA, voffA); PG8_STAGE(PG8_SA(0, 1), cA + hstep, voffA);
        if (wr == 1) PG8_BAR;
        PG8_WAIT_V(2); PG8_BAR;
        PG8_STAGE(PG8_SB(1, 0), cB + kstep, voffB); PG8_STAGE(PG8_SA(1, 0), cA + kstep, voffA); PG8_STAGE(PG8_SB(1, 1), cB + hstep + kstep, voffB);
        PG8_WAIT_V(6); PG8_BAR;
    } else {
        PG8_STAGE(PG8_SB(0, 0), cB, voffB); PG8_STAGE(PG8_SA(0, 0), cA, voffA); PG8_STAGE(PG8_SB(0, 1), cB + hstep, voffB); PG8_STAGE(PG8_SA(0, 1), cA + hstep, voffA);
        if (wr == 1) PG8_BAR;
        PG8_WAIT_V(4); PG8_BAR;
        PG8_STAGE(PG8_SB(1, 0), cB + kstep, voffB); PG8_STAGE(PG8_SA(1, 0), cA + kstep, voffA); PG8_STAGE(PG8_SB(1, 1), cB + hstep + kstep, voffB);
        PG8_WAIT_V(6); PG8_BAR;
    }
    for (;;) {
        const bool has_next = S.next(ui + 1, nxt);
        const char* nA = has_next ? (const char*)g.A + (size_t)nxt.pm * tstep : cA; const char* nB = has_next ? (const char*)g.Bt + (size_t)nxt.brow * (size_t)K * 2 : cB;
        for (int t = 0; t < nt; t += 2) {
            const bool last = (t == nt - 2);
            const char* a1 = cA + (size_t)(t + 1) * kstep;
            const char* a2 = last ? nA : cA + (size_t)(t + 2) * kstep; const char* b2 = last ? nB : cB + (size_t)(t + 2) * kstep;
            const char* a3 = a2 + kstep; const char* b3 = b2 + kstep;
            if (last && has_next) S.a_ready(nxt);
            if constexpr (SP2) {
            PG8_LDB(B0, 0, 0); PG8_LDB(B1, 0, 1); PG8_SCHED; PG8_LDA(At, 0, 0); PG8_STAGE(PG8_SA(1, 1), a1 + hstep, voffA);
            PG8_WAIT_V(8); PG8_WAIT_L(0); PG8_BAR; PG8_MMA(0, 0, At, B0); PG8_MMA(0, 1, At, B1); PG8_BAR; PG8_SCHED;
            PG8_LDA(At, 0, 1); PG8_STAGE(PG8_SB(0, 0), b2, voffB); PG8_STAGE(PG8_SB(0, 1), b2 + hstep, voffB); PG8_STAGE(PG8_SA(0, 0), a2, voffA);
            PG8_WAIT_V(8); PG8_WAIT_L(0); PG8_BAR; PG8_MMA(1, 0, At, B0); PG8_MMA(1, 1, At, B1); PG8_BAR; PG8_SCHED;
            PG8_LDB(B0, 1, 0); PG8_LDB(B1, 1, 1); PG8_SCHED; PG8_LDA(At, 1, 0); PG8_STAGE(PG8_SA(0, 1), a2 + hstep, voffA);
            PG8_WAIT_V(8); PG8_WAIT_L(0); PG8_BAR; PG8_MMA(0, 0, At, B0); PG8_MMA(0, 1, At, B1); PG8_BAR; PG8_SCHED;
            PG8_LDA(At, 1, 1); PG8_STAGE(PG8_SB(1, 0), b3, voffB); PG8_STAGE(PG8_SB(1, 1), b3 + hstep, voffB); PG8_STAGE(PG8_SA(1, 0), a3, voffA);
            PG8_WAIT_V(8); PG8_WAIT_L(0); PG8_BAR; PG8_MMA(1, 0, At, B0); PG8_MMA(1, 1, At, B1); PG8_BAR; PG8_SCHED;
            } else {
            PG8_LDB(B0, 0, 0); PG8_SCHED; PG8_LDA(At, 0, 0); PG8_STAGE(PG8_SA(1, 1), a1 + hstep, voffA);
            PG8_WAIT_L(8); PG8_BAR; PG8_WAIT_L(0); PG8_MMA(0, 0, At, B0); PG8_BAR; PG8_SCHED;
            PG8_LDB(B1, 0, 1); PG8_STAGE(PG8_SB(0, 0), b2, voffB);
            PG8_BAR; PG8_WAIT_L(0); PG8_MMA(0, 1, At, B1); PG8_BAR;
            PG8_LDA(At, 0, 1); PG8_STAGE(PG8_SA(0, 0), a2, voffA);
            PG8_BAR; PG8_WAIT_L(0); PG8_MMA(1, 0, At, B0); PG8_BAR; PG8_SCHED;
            PG8_STAGE(PG8_SB(0, 1), b2 + hstep, voffB);
            PG8_WAIT_V(6); PG8_BAR; PG8_MMA(1, 1, At, B1); PG8_BAR;
            PG8_LDB(B0, 1, 0); PG8_SCHED; PG8_LDA(At, 1, 0); PG8_STAGE(PG8_SA(0, 1), a2 + hstep, voffA);
            PG8_WAIT_L(8); PG8_BAR; PG8_WAIT_L(0); PG8_MMA(0, 0, At, B0); PG8_BAR; PG8_SCHED;
            PG8_LDB(B1, 1, 1); PG8_STAGE(PG8_SB(1, 0), b3, voffB);
            PG8_BAR; PG8_WAIT_L(0); PG8_MMA(0, 1, At, B1); PG8_BAR;
            PG8_LDA(At, 1, 1); PG8_STAGE(PG8_SA(1, 0), a3, voffA);
            PG8_BAR; PG8_WAIT_L(0); PG8_MMA(1, 0, At, B0); PG8_BAR; PG8_SCHED;
            PG8_STAGE(PG8_SB(1, 1), b3 + hstep, voffB);
            PG8_WAIT_V(6); PG8_BAR; PG8_MMA(1, 1, At, B1); PG8_BAR;
            }
        }
        if constexpr (ALIGN_EPI) { if (wr == 0) PG8_BAR; }
        if constexpr (!Epi::AFTER_DRAIN) { E(acc, cur, wr, wc, fr, fq); S.done(cur); }
        if (!has_next) break;
#pragma unroll
        for (int a = 0; a < 2; ++a)
#pragma unroll
            for (int b = 0; b < 2; ++b)
#pragma unroll
                for (int m = 0; m < 4; ++m)
#pragma unroll
                    for (int n = 0; n < 2; ++n) acc[a][b][m][n] = (f32x4){0.f, 0.f, 0.f, 0.f};
        cur = nxt; cA = nA; cB = nB; ++ui;
        if constexpr (ALIGN_EPI) { if (wr == 1) PG8_BAR; }
    }
    PG8_WAIT_V(0);
    if constexpr (!ALIGN_EPI) { if (wr == 0) PG8_BAR; }
    PG8_BAR;
    if constexpr (Epi::AFTER_DRAIN) { E.fused(acc, cur, wr, wc, fr, fq, lds, wid, lane); S.done(cur); }
#undef PG8_SA
#undef PG8_SB
#undef PG8_STAGE
#undef PG8_LDA
#undef PG8_LDB
#undef PG8_MMA
#undef PG8_WAIT_V
#undef PG8_WAIT_L
#undef PG8_BAR
#undef PG8_SCHED
}
}
#ifndef PG8_SP2
#define PG8_SP2 true
#endif
#ifndef PG8_ALIGN
#define PG8_ALIGN true
#endif

constexpr int NWAVES = 8, NTHREADS = NWAVES * 64;
constexpr int BATCH = 8, SEQ = 4096, D = 1024, M = BATCH * SEQ, DEPTH = 4;
constexpr int NMEM = 256, TOKW = 768, MEMW = 256, MEMH = 4, NAH = 12, MLH = 4, MLDH = 192;
constexpr int NA_IN = 2560, NA_LDP = 1792  , ML_IN = 3344, ML_INP = 3584, ML_LDP = 2816  , ML_GATE_PN = 10;
constexpr int NEXP = 32, EPG = 8, NGRP = 4, DEXP = 512;
constexpr int P_MAX = 288 * 256;
constexpr float LN_EPS = 1e-5f;
constexpr float ALPHA = 1.6817928305074290f;

constexpr size_t MiB = 1u << 20;
constexpr size_t WS_CTL = 0, CTL_ZERO_BYTES = 1 * MiB;
constexpr size_t WS_MISC = 1 * MiB;
constexpr size_t WS_RGB = WS_MISC + 128 * 1024;
constexpr size_t WS_STATS = 47 * MiB;
constexpr size_t WS_WR = WS_MISC + 256 * 1024;
constexpr size_t WS_WINNA = 2 * MiB, WS_WINML = 12 * MiB, WS_WOUT = 26 * MiB, WS_WMEMKV = 34 * MiB, WS_MEMB = 35 * MiB, WS_MEMKV = 39 * MiB, WS_GATES = 43 * MiB;
constexpr size_t WS_TOKE = 45 * MiB, WS_TOKG = WS_TOKE + 262144, WS_TOKP = WS_TOKG + 262144, WS_ROWSLOT = WS_TOKP + 262144, WS_ROWGATE = WS_ROWSLOT + 294912;
static_assert(WS_ROWGATE + 294912 <= 48 * MiB, "ws map");
constexpr size_t WS_W13 = 48 * MiB, WS_W2 = 304 * MiB, WS_PRE = 432 * MiB, WS_XB = 560 * MiB, WS_PROJ = 624 * MiB, WS_MIXED = 848 * MiB, WS_H = 912 * MiB, WS_END = 1012 * MiB;
constexpr size_t WS_VT = WS_PROJ + 112 * MiB;
constexpr size_t WS_VTML = WS_PROJ + 176 * MiB;
constexpr size_t WS_MEMK = WS_MEMKV, WS_MEMVT = WS_MEMKV + 2 * MiB;
constexpr size_t WS_SCAL = 1008 * MiB;
constexpr size_t WS_QKC = WS_PRE;
constexpr size_t WS_Y = WS_PROJ, WS_HID = WS_PROJ + 128 * MiB;
constexpr size_t WS_XS = WS_MIXED;
static_assert(WS_HID + (size_t)P_MAX * DEXP * 2 <= WS_MIXED && WS_XS + (size_t)P_MAX * D * 2 <= 1008 * MiB && WS_PROJ + (size_t)M * ML_INP * 2 <= WS_MIXED, "ws map");
static_assert(WS_H + (size_t)2 * M * TOKW * 2 <= 1008 * MiB && WS_QKC + (size_t)M * 1536 * 2 <= WS_XB, "ws map");
constexpr int CW_BAR = 4096;
constexpr int CW_CNT = 16384;
constexpr int RING_BYTES = 131072, LDSCTL_OFF = RING_BYTES, LDSCTL_BYTES = 32768, LDS_BYTES = RING_BYTES + LDSCTL_BYTES;
constexpr int L_PROBE = LDSCTL_OFF + 2048;
constexpr int L_MISC = LDSCTL_OFF + 320, L_HIST = LDSCTL_OFF + 512, L_WGBASE = LDSCTL_OFF + 768, L_PADSTART = LDSCTL_OFF + 1024, L_CNT = LDSCTL_OFF + 1280;

#define GAS __attribute__((address_space(1)))
#define LAS __attribute__((address_space(3)))
typedef unsigned short bf16;
typedef unsigned v4u __attribute__((ext_vector_type(4)));
typedef unsigned u32x4 __attribute__((ext_vector_type(4)));
typedef float f32x4 __attribute__((ext_vector_type(4)));
typedef short bf16x8 __attribute__((ext_vector_type(8)));
typedef GAS unsigned gu32;
typedef GAS unsigned long long gu64;
#define RLX_AGENT __ATOMIC_RELAXED, __HIP_MEMORY_SCOPE_AGENT
#define LDS_WAIT() asm volatile("s_waitcnt lgkmcnt(0)" ::: "memory")
#define VM_WAIT() asm volatile("s_waitcnt vmcnt(0)" ::: "memory")
__device__ __forceinline__ unsigned long long rt() { return __builtin_amdgcn_s_memrealtime(); }
__device__ __forceinline__ unsigned pk2(float lo, float hi) { unsigned r; asm("v_cvt_pk_bf16_f32 %0, %1, %2" : "=v"(r) : "v"(lo), "v"(hi)); return r; }
__device__ __forceinline__ unsigned f2bf(float f) { return pk2(f, 0.f) & 0xffffu; }

#define XB_TMO      128
#define XB_XCNT(j)  (256  + 64 * (j))
#define XB_XSUB(j)  (1280 + 64 * (j))
#define XB_XGEN(j)  (2304 + 64 * (j))
#define XB_TOP      3328
#define XB_TOPGEN   3392
#define XCD_BAR_WORDS 3456
#define XB_SPIN_CAP (1u << 24)

__device__ __forceinline__ unsigned xb_ld(unsigned* p)              { return __hip_atomic_load(p, __ATOMIC_RELAXED, __HIP_MEMORY_SCOPE_AGENT); }
__device__ __forceinline__ unsigned xb_add(unsigned* p, unsigned v) { return __hip_atomic_fetch_add(p, v, __ATOMIC_RELAXED, __HIP_MEMORY_SCOPE_AGENT); }
__device__ __forceinline__ unsigned xb_xcc_id() { return (unsigned)__builtin_amdgcn_s_getreg((3 << 11) | 20) & 0xFu; }
#define XB_SPIN(cond, bar) do { unsigned _sp = 0; while (cond) { __builtin_amdgcn_s_sleep(1); \
    if ((++_sp & 255u) == 0u) { if (xb_ld(&(bar)[XB_TMO])) break; if (_sp > XB_SPIN_CAP) { atomicAdd(&(bar)[XB_TMO], 1u); break; } } } } while (0)

struct XcdBarrier {
    unsigned* bar; unsigned x;
    volatile LAS unsigned* st;
};

__device__ __forceinline__ XcdBarrier xcd_barrier_post(unsigned* bar, volatile LAS unsigned* st) {
    XcdBarrier b; b.bar = bar; b.x = xb_xcc_id(); b.st = st;
    if (threadIdx.x == 0) (void)xb_add(&bar[XB_XCNT(b.x)], 1u);
    return b;
}
__device__ __forceinline__ void xcd_barrier_complete(unsigned* bar, unsigned x, unsigned& nloc, unsigned& nx) {
    const unsigned G = gridDim.x * gridDim.y * gridDim.z;
    unsigned sum, cnt, mine, sp = 0u;
    for (;;) {
        sum = 0u; cnt = 0u; mine = 0u;
#pragma unroll
        for (unsigned j = 0; j < 16; ++j) { const unsigned c = xb_ld(&bar[XB_XCNT(j)]); sum += c; cnt += (c > 0u) ? 1u : 0u; mine = (j == x) ? c : mine; }
        if (sum == G) break;
        __builtin_amdgcn_s_sleep(1);
        if ((++sp & 255u) == 0u) { if (xb_ld(&bar[XB_TMO])) break; if (sp > XB_SPIN_CAP) { atomicAdd(&bar[XB_TMO], 1u); break; } }
    }
    nloc = mine > 0u ? mine : 1u; nx = cnt > 0u ? cnt : 1u;
}

__device__ __forceinline__ void xcd_barrier(const XcdBarrier& b) {
    asm volatile("s_waitcnt vmcnt(0)" ::: "memory");
    __syncthreads();
    if (threadIdx.x == 0) {
        unsigned* bar = b.bar;
        __builtin_amdgcn_s_waitcnt(0);
        unsigned nloc = b.st[0], nx = b.st[1];
        if (nloc == 0u) { xcd_barrier_complete(bar, b.x, nloc, nx); b.st[0] = nloc; b.st[1] = nx; }
        const unsigned old = xb_add(&bar[XB_XSUB(b.x)], 1u);
        const unsigned gen = old / nloc;
        if (old + 1u == (gen + 1u) * nloc) {
            __builtin_amdgcn_fence(__ATOMIC_RELEASE, "agent");
            asm volatile("s_waitcnt vmcnt(0)" ::: "memory");
            const unsigned og = xb_add(&bar[XB_TOP], 1u);
            const unsigned tg = og / nx;
            if (og + 1u == (tg + 1u) * nx) xb_add(&bar[XB_TOPGEN], 1u);
            else XB_SPIN(xb_ld(&bar[XB_TOPGEN]) == tg, bar);
            __builtin_amdgcn_fence(__ATOMIC_ACQUIRE, "agent");
            xb_add(&bar[XB_XGEN(b.x)], 1u);
            asm volatile("s_waitcnt vmcnt(0)" ::: "memory");
        } else {
            XB_SPIN(xb_ld(&bar[XB_XGEN(b.x)]) == gen, bar);
            __builtin_amdgcn_fence(__ATOMIC_ACQUIRE, "agent");
            asm volatile("s_waitcnt vmcnt(0)" ::: "memory");
        }
    }
    __syncthreads();
}


struct Frame {
    LAS unsigned char* lds;
    gu32* ctl;
    int tid, lane, wave, vcu, G, bx;
};
template <int CTRL> __device__ __forceinline__ float dpp_mov(float v) { return __builtin_bit_cast(float, __builtin_amdgcn_update_dpp(0, __builtin_bit_cast(int, v), CTRL, 0xf, 0xf, true)); }
__device__ __forceinline__ float wave_sum(float v) {
    v += dpp_mov<0xB1>(v);
    v += dpp_mov<0x4E>(v);
    v += dpp_mov<0x141>(v);
    v += dpp_mov<0x140>(v);
    const int iv = __builtin_bit_cast(int, v);
    return (__builtin_bit_cast(float, __builtin_amdgcn_readlane(iv, 0)) + __builtin_bit_cast(float, __builtin_amdgcn_readlane(iv, 16))) +
           (__builtin_bit_cast(float, __builtin_amdgcn_readlane(iv, 32)) + __builtin_bit_cast(float, __builtin_amdgcn_readlane(iv, 48)));
}
__device__ __forceinline__ void qd_swap16(float v, float& x, float& y) { x = v; y = v; asm volatile("v_nop\n\tv_nop\n\tv_permlane16_swap_b32 %0, %1" : "+v"(x), "+v"(y)); }
__device__ __forceinline__ void qd_swap32(float v, float& x, float& y) { x = v; y = v; asm volatile("v_nop\n\tv_nop\n\tv_permlane32_swap_b32 %0, %1" : "+v"(x), "+v"(y)); }
__device__ __forceinline__ float qd_max(float v) { float x, y; qd_swap16(v, x, y); v = fmaxf(x, y); qd_swap32(v, x, y); return fmaxf(x, y); }
__device__ __forceinline__ float qd_sum(float v) { float x, y; qd_swap16(v, x, y); v = x + y; qd_swap32(v, x, y); return x + y; }
__device__ __forceinline__ float bf2f(unsigned short h) { return __uint_as_float((unsigned)h << 16); }
__device__ __forceinline__ float bflo(unsigned w) { return __uint_as_float(w << 16); }
__device__ __forceinline__ float bfhi(unsigned w) { return __uint_as_float(w & 0xffff0000u); }
__device__ __forceinline__ unsigned ld_agent(const void* p) { return __hip_atomic_load((const unsigned*)p, __ATOMIC_RELAXED, __HIP_MEMORY_SCOPE_AGENT); }

__device__ __forceinline__ int rowmap(int kind, int n) {
    if (kind == 0) return n;
    if (kind == 1) return n < 1536 ? n : (n < 2304 ? ML_LDP + (n - 1536) : (n < 3072 ? n - 768 : (n < 3088 ? 2560 + (n - 3072) : 2304 + (n - 3088))));
    if (kind == 4) return n < 1536 ? n : (n < 2304 ? n + 256 : n - 768);
    return 32 * (n >> 4) + (n & 15) + (kind == 3 ? 16 : 0);
}
__device__ __forceinline__ void transpose_item(const float* W, int K, int N, bf16* WT, int kind, LAS float* scr, int item, int lane) {
    const int nblk = (N + 31) / 32, kb = item / nblk, nb = item % nblk, k0 = 64 * kb, n0 = 32 * nb;
    const int nn = n0 + (lane & 31); const bool ok = nn < N;
    float tv[32];
#pragma unroll
    for (int i = 0; i < 32; ++i) { const int kk = 2 * i + (lane >> 5); tv[i] = ok ? W[(size_t)(k0 + kk) * N + nn] : 0.f; }
#pragma unroll
    for (int i = 0; i < 32; ++i) { const int kk = 2 * i + (lane >> 5); scr[kk * 33 + (lane & 31)] = tv[i]; }
    LDS_WAIT(); asm volatile("" ::: "memory");
    const int c = lane & 7;
#pragma unroll
    for (int j = 0; j < 4; ++j) { const int n = (lane >> 3) + 8 * j; const LAS float* s = scr + (8 * c) * 33 + n;
        v4u o; o.x = pk2(s[0 * 33], s[1 * 33]); o.y = pk2(s[2 * 33], s[3 * 33]); o.z = pk2(s[4 * 33], s[5 * 33]); o.w = pk2(s[6 * 33], s[7 * 33]);
        if (n0 + n < N) *(GAS v4u*)(WT + (size_t)rowmap(kind, n0 + n) * K + k0 + 8 * c) = o; }
    LDS_WAIT(); asm volatile("" ::: "memory");
}
struct TrItem { const float* W; bf16* WT; int K, N, kind, item; };
__device__ __forceinline__ void tr_load2(const TrItem& t, int lane, float (&tv)[32]) {
    const int nblk = (t.N + 31) / 32, kb = t.item / nblk, nb = t.item % nblk, k0 = 64 * kb, n0 = 32 * nb;
#pragma unroll
    for (int i = 0; i < 32; ++i) tv[i] = t.W[(size_t)(k0 + i + 32 * (lane >> 5)) * t.N + n0 + (lane & 31)];
}
__device__ __forceinline__ void tr_finish2(const TrItem& t, int lane, const float (&tv)[32], LAS unsigned* scr) {
    const int nblk = (t.N + 31) / 32, kb = t.item / nblk, nb = t.item % nblk, k0 = 64 * kb, n0 = 32 * nb;
#pragma unroll
    for (int j = 0; j < 16; ++j) scr[(16 * (lane >> 5) + j) * 33 + (lane & 31)] = pk2(tv[2 * j], tv[2 * j + 1]);
    LDS_WAIT(); asm volatile("" ::: "memory");
    const int c = lane & 7;
#pragma unroll
    for (int j = 0; j < 4; ++j) { const int n = (lane >> 3) + 8 * j; const LAS unsigned* sp = scr + (4 * c) * 33 + n;
        *(GAS v4u*)(t.WT + (size_t)rowmap(t.kind, n0 + n) * t.K + k0 + 8 * c) = (v4u){sp[0], sp[33], sp[66], sp[99]}; }
    LDS_WAIT(); asm volatile("" ::: "memory");
}
__device__ __forceinline__ TrItem moe_tritem(int it, const float* w1, const float* w3, const float* w2, bf16* W13, bf16* W2) {
    const int mat = it >> 8, sub = it & 255, le = mat / 3, which = mat - 3 * le;
    if (which == 0) return TrItem{w1 + (size_t)le * 1024 * 512, W13 + (size_t)le * 1024 * 1024, 1024, 512, 2, sub};
    if (which == 1) return TrItem{w3 + (size_t)le * 1024 * 512, W13 + (size_t)le * 1024 * 1024, 1024, 512, 3, sub};
    return TrItem{w2 + (size_t)le * 512 * 1024, W2 + (size_t)le * 1024 * 512, 512, 1024, 0, sub};
}
struct P0Args { const float *x, *mem, *wmemkv, *nawin, *mlwin, *wout, *w1, *w3, *w2, *wg, *we, *g1, *b1, *bg, *be; unsigned char* ws; };
__device__ __forceinline__ void p0_prologue(const Frame& F, const P0Args& a) {
    LAS float* scr = (LAS float*)(F.lds + F.wave * 16384);
    const int gw = F.vcu * NWAVES + F.wave, NGW = F.G * NWAVES;
    bf16* const W13 = (bf16*)(a.ws + WS_W13); bf16* const W2 = (bf16*)(a.ws + WS_W2);
    constexpr int I_MKV = 16 * 16, I_NA = 16 * 80, I_ML = 16 * 105, I_WO = 16 * 32;
    constexpr int I_MOE0 = 32768;
    constexpr int NITEMS = I_MOE0 + I_MKV + 2 * I_NA + 2 * I_ML + DEPTH * I_WO;
    for (int it = gw; it < NITEMS; it += NGW) {
        int r = it;
        if (r < I_MOE0) { const TrItem t = moe_tritem(r, a.w1, a.w3, a.w2, W13, W2); float tv[32]; tr_load2(t, F.lane, tv); tr_finish2(t, F.lane, tv, (LAS unsigned*)scr); continue; }
        r -= I_MOE0;
        if (r < I_MKV) { transpose_item(a.wmemkv, D, 512, (bf16*)(a.ws + WS_WMEMKV), 0, scr, r, F.lane); continue; } r -= I_MKV;
        if (r < 2 * I_NA) { const int j = r / I_NA; transpose_item(a.nawin + (size_t)j * D * NA_IN, D, NA_IN, (bf16*)(a.ws + WS_WINNA) + (size_t)j * NA_IN * D, 4, scr, r - j * I_NA, F.lane); continue; } r -= 2 * I_NA;
        if (r < 2 * I_ML) { const int j = r / I_ML; transpose_item(a.mlwin + (size_t)j * D * ML_IN, D, ML_IN, (bf16*)(a.ws + WS_WINML) + (size_t)j * ML_INP * D, 1, scr, r - j * I_ML, F.lane); continue; } r -= 2 * I_ML;
        { const int l = r / I_WO; transpose_item(a.wout + (size_t)l * D * D, D, D, (bf16*)(a.ws + WS_WOUT) + (size_t)l * D * D, 0, scr, r - l * I_WO, F.lane); }
    }
    const int gt = F.vcu * NTHREADS + F.tid, NT = F.G * NTHREADS;
    for (int i = gt; i < 2 * 240 * (D / 8); i += NT) { const int j = i / (240 * (D / 8)), rr = i - j * 240 * (D / 8);
        *(GAS v4u*)((bf16*)(a.ws + WS_WINML) + (size_t)j * ML_INP * D + (size_t)2576 * D + (size_t)rr * 8) = (v4u){0u, 0u, 0u, 0u}; }
    for (int i = gt; i < DEPTH * 48 * D; i += NT) { const int l = i / (48 * D), n = (i / D) % 48, k = i % D;
        const float wv = n < 4 ? a.wg[((size_t)l * D + k) * NGRP + n] : (n < 36 ? a.we[((size_t)l * D + k) * NEXP + (n - 4)] : 0.f);
        const float v = wv * a.g1[(size_t)l * D + k];
        const unsigned hi = f2bf(v); const float lo = v - bf2f((unsigned short)hi);
        bf16* wr = (bf16*)(a.ws + WS_WR) + (size_t)l * 2 * 48 * D; wr[(size_t)n * D + k] = (bf16)hi; wr[(size_t)(48 + n) * D + k] = (bf16)f2bf(lo); }
    for (int jn = gw; jn < DEPTH * 48; jn += NGW) { const int l = jn / 48, n = jn % 48; float sg = 0.f, sb = 0.f;
        if (n < 36) for (int k = F.lane; k < D; k += 64) { const float wv = n < 4 ? a.wg[((size_t)l * D + k) * NGRP + n] : a.we[((size_t)l * D + k) * NEXP + (n - 4)];
            sg += wv * a.g1[(size_t)l * D + k]; sb += wv * a.b1[(size_t)l * D + k]; }
        sg = wave_sum(sg); sb = wave_sum(sb);
        if (F.lane == 0) { float* rgb = (float*)(a.ws + WS_RGB) + l * 96; rgb[n] = sg; rgb[48 + n] = n < 4 ? sb + a.bg[l * NGRP + n] : (n < 36 ? sb + a.be[l * NEXP + (n - 4)] : 0.f); } }
    for (int i = gt; i < M * D / 8; i += NT) { const f32x4 v0 = *(const GAS f32x4*)(a.x + (size_t)i * 8), v1 = *(const GAS f32x4*)(a.x + (size_t)i * 8 + 4);
        *(GAS v4u*)((bf16*)(a.ws + WS_XB) + (size_t)i * 8) = (v4u){pk2(v0.x, v0.y), pk2(v0.z, v0.w), pk2(v1.x, v1.y), pk2(v1.z, v1.w)}; }
    for (int i = gt; i < BATCH * NMEM * D / 8; i += NT) { const f32x4 v0 = *(const GAS f32x4*)(a.mem + (size_t)i * 8), v1 = *(const GAS f32x4*)(a.mem + (size_t)i * 8 + 4);
        *(GAS v4u*)((bf16*)(a.ws + WS_MEMB) + (size_t)i * 8) = (v4u){pk2(v0.x, v0.y), pk2(v0.z, v0.w), pk2(v1.x, v1.y), pk2(v1.z, v1.w)}; }
}

__device__ __forceinline__ void load8(const bf16* p, float* f) { const v4u w = *(const GAS v4u*)p;
    f[0] = bflo(w.x); f[1] = bfhi(w.x); f[2] = bflo(w.y); f[3] = bfhi(w.y); f[4] = bflo(w.z); f[5] = bfhi(w.z); f[6] = bflo(w.w); f[7] = bfhi(w.w); }
__device__ __forceinline__ bf16x8 ld_frag(const bf16* p) { return *(const GAS bf16x8*)p; }
template <bool NA_LAYER>
__device__ __forceinline__ void attn_mfma(const Frame& F, const bf16* PROJ, const bf16* VT, const bf16* MEMK, const bf16* MEMVT, const float* rpb  , bf16* MIXED) {
    constexpr int ldp = NA_LAYER ? NA_LDP : ML_LDP;
    constexpr int nheads = NA_LAYER ? 16 : 4;
    const int gw = F.vcu * NWAVES + F.wave, NGW = F.G * NWAVES, lane = F.lane, qi = lane & 15, qd = lane >> 4;
    LAS float* rpl = (LAS float*)F.lds;
    if (NA_LAYER) { for (int i = F.tid; i < NAH * 15 * 31; i += NTHREADS) rpl[i] = rpb[i]; __syncthreads(); }
    for (int it = gw; it < BATCH * nheads * 64 * 4; it += NGW) {
        const int g = it & 3, r = (it >> 2) & 63, hb = it >> 8, hh = hb % nheads, b = hb / nheads;
        const int head = NA_LAYER ? hh : 12 + hh;
        const bool is_mem = head >= 12;
        const int tq0 = b * SEQ + r * 64 + 16 * g;
        const int qcol = is_mem ? (NA_LAYER ? 1536 : 2304) + (head - 12) * 64 : head * 64;
        const int rs = min(max(r - 4, 0), 56), w0 = g == 0 ? 0 : (g == 1 ? 8 : (g == 2 ? 24 : 32));
        const bf16* kbase; const bf16* vbase; size_t kblk, kstride, vblk, vstride;
        if (is_mem) { const int hm = head - 12; kbase = MEMK + (size_t)(b * NMEM) * 256 + hm * 64; kblk = 32 * 256; kstride = 256;
                      vbase = MEMVT + (size_t)(hm * 64) * (BATCH * NMEM) + b * NMEM; vblk = 32; vstride = BATCH * NMEM; }
        else { kbase = PROJ + (size_t)(b * SEQ + rs * 64 + w0) * ldp + 768 + head * 64; kblk = (size_t)64 * ldp; kstride = ldp;
               vbase = VT + (size_t)(head * 64) * M + (b * SEQ + rs * 64 + w0); vblk = 64; vstride = M; }
        const bf16* qp = PROJ + (size_t)(tq0 + qi) * ldp + qcol + 8 * qd;
        const bf16x8 qf0 = ld_frag(qp), qf1 = ld_frag(qp + 32);
        float sc[8][8];
        { bf16x8 kf[8][2][2];
#pragma unroll
          for (int blk = 0; blk < 8; ++blk)
#pragma unroll
            for (int t = 0; t < 2; ++t) { const bf16* kp = kbase + blk * kblk + (size_t)(8 * (qi >> 2) + 4 * t + (qi & 3)) * kstride + 8 * qd; kf[blk][t][0] = ld_frag(kp); kf[blk][t][1] = ld_frag(kp + 32); }
          __builtin_amdgcn_sched_barrier(0);
#pragma unroll
          for (int blk = 0; blk < 8; ++blk)
#pragma unroll
            for (int t = 0; t < 2; ++t) { f32x4 a = {0.f, 0.f, 0.f, 0.f};
                a = __builtin_amdgcn_mfma_f32_16x16x32_bf16(kf[blk][t][0], qf0, a, 0, 0, 0);
                a = __builtin_amdgcn_mfma_f32_16x16x32_bf16(kf[blk][t][1], qf1, a, 0, 0, 0);
#pragma unroll
                for (int j = 0; j < 4; ++j) sc[blk][4 * t + j] = a[j] * 0.125f; } }
        bf16x8 vfa[4][4];
#pragma unroll
        for (int blk = 0; blk < 4; ++blk)
#pragma unroll
            for (int dt = 0; dt < 4; ++dt) vfa[blk][dt] = ld_frag(vbase + (size_t)(16 * (qi >> 2) + 4 * dt + (qi & 3)) * vstride + blk * vblk + 8 * qd);
        __builtin_amdgcn_sched_barrier(0);
        if (!is_mem) {
            const int c = 16 * g + qi, cs = min(max(c - 8, 0), 48), kc0 = w0 + 8 * qd;
#pragma unroll
            for (int blk = 0; blk < 8; ++blk) { const LAS float* rp = rpl + (head * 15 + (rs + blk - r + 7)) * 31;
#pragma unroll
                for (int e = 0; e < 8; ++e) { const int kc = kc0 + e; const bool valid = kc >= cs && kc < cs + 16;
                    const float bias = rp[min(max(kc - c + 15, 0), 30)]; sc[blk][e] = valid ? sc[blk][e] + bias : -INFINITY; } }
        }
        float mx = -INFINITY;
#pragma unroll
        for (int blk = 0; blk < 8; ++blk)
#pragma unroll
            for (int e = 0; e < 8; ++e) mx = fmaxf(mx, sc[blk][e]);
        mx = qd_max(mx);
        float ls = 0.f; bf16x8 pf[8];
#pragma unroll
        for (int blk = 0; blk < 8; ++blk) { float p[8];
#pragma unroll
            for (int e = 0; e < 8; ++e) { p[e] = __expf(sc[blk][e] - mx); ls += p[e]; }
            u32x4 w; w.x = pk2(p[0], p[1]); w.y = pk2(p[2], p[3]); w.z = pk2(p[4], p[5]); w.w = pk2(p[6], p[7]);
            pf[blk] = __builtin_bit_cast(bf16x8, w); }
        ls = qd_sum(ls);
        f32x4 o[4]; bf16x8 vfb[4][4];
#pragma unroll
        for (int dt = 0; dt < 4; ++dt) o[dt] = (f32x4){0.f, 0.f, 0.f, 0.f};
#pragma unroll
        for (int blk = 0; blk < 4; ++blk)
#pragma unroll
            for (int dt = 0; dt < 4; ++dt) vfb[blk][dt] = ld_frag(vbase + (size_t)(16 * (qi >> 2) + 4 * dt + (qi & 3)) * vstride + (blk + 4) * vblk + 8 * qd);
        __builtin_amdgcn_sched_barrier(0);
#pragma unroll
        for (int blk = 0; blk < 4; ++blk)
#pragma unroll
            for (int dt = 0; dt < 4; ++dt) o[dt] = __builtin_amdgcn_mfma_f32_16x16x32_bf16(vfa[blk][dt], pf[blk], o[dt], 0, 0, 0);
#pragma unroll
        for (int blk = 0; blk < 4; ++blk)
#pragma unroll
            for (int dt = 0; dt < 4; ++dt) o[dt] = __builtin_amdgcn_mfma_f32_16x16x32_bf16(vfb[blk][dt], pf[blk + 4], o[dt], 0, 0, 0);
        const float inv = 1.0f / ls;
        bf16* op = MIXED + (size_t)(tq0 + qi) * D + head * 64 + 16 * qd;
        *(GAS u32x4*)op = (u32x4){pk2(o[0][0] * inv, o[0][1] * inv), pk2(o[0][2] * inv, o[0][3] * inv), pk2(o[1][0] * inv, o[1][1] * inv), pk2(o[1][2] * inv, o[1][3] * inv)};
        *(GAS u32x4*)(op + 8) = (u32x4){pk2(o[2][0] * inv, o[2][1] * inv), pk2(o[2][2] * inv, o[2][3] * inv), pk2(o[3][0] * inv, o[3][1] * inv), pk2(o[3][2] * inv, o[3][3] * inv)};
    }
}

__device__ __forceinline__ int att_fk(int tok) { return (((tok >> 3) & 3) << 1) | ((tok >> 1) & 1); }
__device__ __forceinline__ int att_fv(int d) { return (((d >> 4) & 3) << 1) | ((d >> 1) & 1); }
template <bool NA_LAYER>
__device__ __forceinline__ void attn_lds(const Frame& F, const bf16* PROJ, const bf16* VT, const bf16* MEMK, const bf16* MEMVT, const float* rpb  , bf16* MIXED) {
    constexpr int ldp = NA_LAYER ? NA_LDP : ML_LDP;
    const int tid = F.tid, lane = F.lane, wave = F.wave, qi = lane & 15, qd = lane >> 4, g = wave & 3;
    const int half = wave >> 2;
    LAS float* mrg = (LAS float*)(F.lds + LDSCTL_OFF + 8192) + ((wave & 3) * 64 + lane) * 18;
    LAS unsigned char* slots = F.lds;
    LAS float* rpl = (LAS float*)(F.lds + LDSCTL_OFF + 4096);
#define ATT_BAR() do { asm volatile("s_waitcnt lgkmcnt(0)" ::: "memory"); __builtin_amdgcn_s_barrier(); asm volatile("" ::: "memory"); } while (0)
    const int w0g = g == 0 ? 0 : (g == 1 ? 8 : (g == 2 ? 24 : 32));
    for (int uk = 0; uk < (NA_LAYER ? 4 : 1); ++uk) {
        const int u = F.vcu + 256 * uk;
        const bool is_mem = NA_LAYER ? (u >= 768) : true;
        const int v = is_mem ? (NA_LAYER ? u - 768 : u) : u, bh = v >> 3, seg = v & 7;
        const int b = is_mem ? (bh >> 2) : bh / 12, head = is_mem ? 12 + (bh & 3) : bh % 12, r0 = 8 * seg;
        const int qcol = is_mem ? (NA_LAYER ? 1536 : 2304) + (head - 12) * 64 : head * 64;
        const int w0 = is_mem ? 0 : w0g;
        const bf16 *ga, *gb; size_t stepa, stepb; int la, lb;
        if (is_mem) { const int hm = head - 12;
            if (tid < 256) { const int tok = tid >> 3, c = tid & 7; ga = MEMK + (size_t)(b * NMEM + tok) * 256 + hm * 64 + 8 * c; stepa = 32 * 256; la = tok * 128 + ((c ^ att_fk(tok)) << 4); }
            else { const int t2 = tid - 256, d = t2 >> 2, c = t2 & 3; ga = MEMVT + (size_t)(hm * 64 + d) * (BATCH * NMEM) + b * NMEM + 8 * c; stepa = 32; la = 8192 + d * 128 + ((c ^ att_fv(d)) << 4); }
            gb = ga; stepb = stepa; lb = la;
        } else { const int tok = tid >> 3, c = tid & 7;
            ga = PROJ + (size_t)(b * SEQ + tok) * ldp + 768 + head * 64 + 8 * c; stepa = (size_t)64 * ldp; la = tok * 128 + ((c ^ att_fk(tok)) << 4);
            gb = VT + (size_t)(head * 64 + tok) * M + b * SEQ + 8 * c; stepb = 64; lb = 8192 + tok * 128 + ((c ^ att_fv(tok)) << 4); }
        ATT_BAR();
        if (!is_mem) for (int i = tid; i < 15 * 48; i += NTHREADS) { const int ri = i / 48, cj = i % 48 - 8; rpl[i] = (cj >= 0 && cj < 31) ? rpb[head * 465 + ri * 31 + cj] : 0.f; }
        const int rs0 = is_mem ? 0 : min(max(r0 - 4, 0), 56);
        { v4u ra[8], rb[8];
#pragma unroll
          for (int i = 0; i < 8; ++i) { ra[i] = *(const GAS v4u*)(ga + (size_t)(rs0 + i) * stepa); if (!is_mem) rb[i] = *(const GAS v4u*)(gb + (size_t)(rs0 + i) * stepb); }
#pragma unroll
          for (int i = 0; i < 8; ++i) { *(LAS v4u*)(slots + ((rs0 + i) & 7) * 16384 + la) = ra[i]; if (!is_mem) *(LAS v4u*)(slots + ((rs0 + i) & 7) * 16384 + lb) = rb[i]; } }
        v4u pa0 = {0u, 0u, 0u, 0u}, pb0 = pa0, pa1 = pa0, pb1 = pa0;
#define ATT_RS(r) (is_mem ? 0 : min(max((r) - 4, 0), 56))
#define ATT_SLIDE(r) (!is_mem && (r) + 1 < r0 + 8 && ATT_RS((r) + 1) != ATT_RS(r))
        if (ATT_SLIDE(r0)) { pa0 = *(const GAS v4u*)(ga + (size_t)(ATT_RS(r0) + 8) * stepa); pb0 = *(const GAS v4u*)(gb + (size_t)(ATT_RS(r0) + 8) * stepb); }
        if (ATT_SLIDE(r0 + 1)) { pa1 = *(const GAS v4u*)(ga + (size_t)(ATT_RS(r0 + 1) + 8) * stepa); pb1 = *(const GAS v4u*)(gb + (size_t)(ATT_RS(r0 + 1) + 8) * stepb); }
        const bf16* qp = PROJ + (size_t)(b * SEQ + r0 * 64 + 16 * g + qi) * ldp + qcol + 8 * qd;
        bf16x8 qf0 = ld_frag(qp), qf1 = ld_frag(qp + 32);
        ATT_BAR();
#pragma unroll 2
        for (int rr8 = 0; rr8 < 8; ++rr8) {
            const int r = r0 + rr8, rs = ATT_RS(r);
            bf16x8 qn0 = qf0, qn1 = qf1;
            if (rr8 < 7) { qn0 = ld_frag(qp + (size_t)(rr8 + 1) * 64 * ldp); qn1 = ld_frag(qp + (size_t)(rr8 + 1) * 64 * ldp + 32); }
            float sc[4][8];
#pragma unroll
            for (int bl = 0; bl < 4; ++bl) { const LAS unsigned char* sl = slots + ((rs + 4 * half + bl) & 7) * 16384; bf16x8 kf[2][2];
#pragma unroll
                for (int t = 0; t < 2; ++t) { const int tok = w0 + 8 * (qi >> 2) + 4 * t + (qi & 3); const int fk = att_fk(tok);
                    kf[t][0] = *(const LAS bf16x8*)(sl + tok * 128 + ((qd ^ fk) << 4)); kf[t][1] = *(const LAS bf16x8*)(sl + tok * 128 + (((4 + qd) ^ fk) << 4)); }
#pragma unroll
                for (int t = 0; t < 2; ++t) { f32x4 a = {0.f, 0.f, 0.f, 0.f};
                    a = __builtin_amdgcn_mfma_f32_16x16x32_bf16(kf[t][0], qf0, a, 0, 0, 0);
                    a = __builtin_amdgcn_mfma_f32_16x16x32_bf16(kf[t][1], qf1, a, 0, 0, 0);
#pragma unroll
                    for (int j = 0; j < 4; ++j) sc[bl][4 * t + j] = a[j] * 0.125f; } }
            if (!is_mem) {
                const int c = 16 * g + qi, cs = min(max(c - 8, 0), 48), kc0 = w0 + 8 * qd, lo = cs - kc0, hi = lo + 16;
                const LAS float* rp = rpl + (rs + 4 * half - r + 7) * 48 + 8 + min(max(kc0 - c + 15, -8), 31);
                float bias[4][8];
#pragma unroll
                for (int bl = 0; bl < 4; ++bl)
#pragma unroll
                    for (int e = 0; e < 8; ++e) bias[bl][e] = rp[bl * 48 + e];
#pragma unroll
                for (int bl = 0; bl < 4; ++bl)
#pragma unroll
                    for (int e = 0; e < 8; ++e) sc[bl][e] = (e >= lo && e < hi) ? sc[bl][e] + bias[bl][e] : -INFINITY;
            }
            float mx = -INFINITY;
#pragma unroll
            for (int bl = 0; bl < 4; ++bl)
#pragma unroll
                for (int e = 0; e < 8; ++e) mx = fmaxf(mx, sc[bl][e]);
            mx = qd_max(mx);
            float ls = 0.f; bf16x8 pf[4];
#pragma unroll
            for (int bl = 0; bl < 4; ++bl) { float p[8];
#pragma unroll
                for (int e = 0; e < 8; ++e) { p[e] = __expf(sc[bl][e] - mx); ls += p[e]; }
                u32x4 w; w.x = pk2(p[0], p[1]); w.y = pk2(p[2], p[3]); w.z = pk2(p[4], p[5]); w.w = pk2(p[6], p[7]);
                pf[bl] = __builtin_bit_cast(bf16x8, w); }
            ls = qd_sum(ls);
            f32x4 o[4];
#pragma unroll
            for (int dt = 0; dt < 4; ++dt) o[dt] = (f32x4){0.f, 0.f, 0.f, 0.f};
            const int vc = (w0 >> 3) + qd;
#pragma unroll
            for (int bl = 0; bl < 4; ++bl) { const LAS unsigned char* sl = slots + ((rs + 4 * half + bl) & 7) * 16384 + 8192; bf16x8 vf[4];
#pragma unroll
                for (int dt = 0; dt < 4; ++dt) { const int d = 16 * (qi >> 2) + 4 * dt + (qi & 3); vf[dt] = *(const LAS bf16x8*)(sl + d * 128 + ((vc ^ att_fv(d)) << 4)); }
#pragma unroll
                for (int dt = 0; dt < 4; ++dt) o[dt] = __builtin_amdgcn_mfma_f32_16x16x32_bf16(vf[dt], pf[bl], o[dt], 0, 0, 0); }
            if (half == 1) { mrg[0] = mx; mrg[1] = ls;
#pragma unroll
                for (int dt = 0; dt < 4; ++dt)
#pragma unroll
                    for (int j = 0; j < 4; ++j) mrg[2 + 4 * dt + j] = o[dt][j]; }
            qf0 = qn0; qf1 = qn1;
            ATT_BAR();
            if (half == 0) {
                const float m1 = mrg[0], l1 = mrg[1], mm = fmaxf(mx, m1), f0 = __expf(mx - mm), f1 = __expf(m1 - mm), inv = 1.0f / (ls * f0 + l1 * f1), s0 = f0 * inv, s1 = f1 * inv;
                float ov[16];
#pragma unroll
                for (int dt = 0; dt < 4; ++dt)
#pragma unroll
                    for (int j = 0; j < 4; ++j) ov[4 * dt + j] = o[dt][j] * s0 + mrg[2 + 4 * dt + j] * s1;
                bf16* op = MIXED + (size_t)(b * SEQ + r * 64 + 16 * g + qi) * D + head * 64 + 16 * qd;
                *(GAS u32x4*)op = (u32x4){pk2(ov[0], ov[1]), pk2(ov[2], ov[3]), pk2(ov[4], ov[5]), pk2(ov[6], ov[7])};
                *(GAS u32x4*)(op + 8) = (u32x4){pk2(ov[8], ov[9]), pk2(ov[10], ov[11]), pk2(ov[12], ov[13]), pk2(ov[14], ov[15])};
            }
            if (ATT_SLIDE(r)) {
                const int sl = rs & 7;
                if ((rr8 & 1) == 0) { *(LAS v4u*)(slots + sl * 16384 + la) = pa0; *(LAS v4u*)(slots + sl * 16384 + lb) = pb0; }
                else                { *(LAS v4u*)(slots + sl * 16384 + la) = pa1; *(LAS v4u*)(slots + sl * 16384 + lb) = pb1; }
            }
            if (ATT_SLIDE(r + 2)) {
                if ((rr8 & 1) == 0) { pa0 = *(const GAS v4u*)(ga + (size_t)(ATT_RS(r + 2) + 8) * stepa); pb0 = *(const GAS v4u*)(gb + (size_t)(ATT_RS(r + 2) + 8) * stepb); }
                else                { pa1 = *(const GAS v4u*)(ga + (size_t)(ATT_RS(r + 2) + 8) * stepa); pb1 = *(const GAS v4u*)(gb + (size_t)(ATT_RS(r + 2) + 8) * stepb); }
            }
            ATT_BAR();
        }
    }
#undef ATT_RS
#undef ATT_SLIDE
#undef ATT_BAR
}

struct CvArgs { const float *w1, *w3, *w2; bf16 *W13, *W2; int item0; };
__device__ __forceinline__ void attn_lds_cv(const Frame& F, const bf16* PROJ, const bf16* VT, const bf16* MEMK, const bf16* MEMVT, const float* rpb  , bf16* MIXED, const CvArgs cv) {
    constexpr bool NA_LAYER = true;
    constexpr int ldp = NA_LAYER ? NA_LDP : ML_LDP;
    const int tid = F.tid, lane = F.lane, wave = F.wave, qi = lane & 15, qd = lane >> 4, g = wave & 3;
    const bool compute = wave < 4;
    LAS unsigned char* slots = F.lds;
    LAS float* rpl = (LAS float*)(F.lds + LDSCTL_OFF + 4096);
#define ATT_BAR() do { asm volatile("s_waitcnt lgkmcnt(0)" ::: "memory"); __builtin_amdgcn_s_barrier(); asm volatile("" ::: "memory"); } while (0)
    const int w0g = g == 0 ? 0 : (g == 1 ? 8 : (g == 2 ? 24 : 32));
    float tvA[32]; TrItem itA = {nullptr, nullptr, 0, 0, 0, 0}; bool pend = false;
    LAS unsigned* cscr = (LAS unsigned*)(F.lds + LDSCTL_OFF + 8192 + (wave & 3) * 4352);
    const int cbase = cv.item0 + (F.vcu * 4 + (wave & 3)) * 32;
    for (int uk = 0; uk < (NA_LAYER ? 4 : 1); ++uk) {
        const int u = F.vcu + 256 * uk;
        const bool is_mem = NA_LAYER ? (u >= 768) : true;
        const int v = is_mem ? (NA_LAYER ? u - 768 : u) : u, bh = v >> 3, seg = v & 7;
        const int b = is_mem ? (bh >> 2) : bh / 12, head = is_mem ? 12 + (bh & 3) : bh % 12, r0 = 8 * seg;
        const int qcol = is_mem ? (NA_LAYER ? 1536 : 2304) + (head - 12) * 64 : head * 64;
        const int w0 = is_mem ? 0 : w0g;
        const bf16 *ga, *gb; size_t stepa, stepb; int la, lb;
        if (is_mem) { const int hm = head - 12;
            if (tid < 256) { const int tok = tid >> 3, c = tid & 7; ga = MEMK + (size_t)(b * NMEM + tok) * 256 + hm * 64 + 8 * c; stepa = 32 * 256; la = tok * 128 + ((c ^ att_fk(tok)) << 4); }
            else { const int t2 = tid - 256, d = t2 >> 2, c = t2 & 3; ga = MEMVT + (size_t)(hm * 64 + d) * (BATCH * NMEM) + b * NMEM + 8 * c; stepa = 32; la = 8192 + d * 128 + ((c ^ att_fv(d)) << 4); }
            gb = ga; stepb = stepa; lb = la;
        } else { const int tok = tid >> 3, c = tid & 7;
            ga = PROJ + (size_t)(b * SEQ + tok) * ldp + 768 + head * 64 + 8 * c; stepa = (size_t)64 * ldp; la = tok * 128 + ((c ^ att_fk(tok)) << 4);
            gb = VT + (size_t)(head * 64 + tok) * M + b * SEQ + 8 * c; stepb = 64; lb = 8192 + tok * 128 + ((c ^ att_fv(tok)) << 4); }
        ATT_BAR();
        if (!is_mem) for (int i = tid; i < 15 * 48; i += NTHREADS) { const int ri = i / 48, cj = i % 48 - 8; rpl[i] = (cj >= 0 && cj < 31) ? rpb[head * 465 + ri * 31 + cj] : 0.f; }
        const int rs0 = is_mem ? 0 : min(max(r0 - 4, 0), 56);
        { v4u ra[8], rb[8];
#pragma unroll
          for (int i = 0; i < 8; ++i) { ra[i] = *(const GAS v4u*)(ga + (size_t)(rs0 + i) * stepa); if (!is_mem) rb[i] = *(const GAS v4u*)(gb + (size_t)(rs0 + i) * stepb); }
#pragma unroll
          for (int i = 0; i < 8; ++i) { *(LAS v4u*)(slots + ((rs0 + i) & 7) * 16384 + la) = ra[i]; if (!is_mem) *(LAS v4u*)(slots + ((rs0 + i) & 7) * 16384 + lb) = rb[i]; } }
        v4u pa0 = {0u, 0u, 0u, 0u}, pb0 = pa0, pa1 = pa0, pb1 = pa0;
#define ATT_RS(r) (is_mem ? 0 : min(max((r) - 4, 0), 56))
#define ATT_SLIDE(r) (!is_mem && (r) + 1 < r0 + 8 && ATT_RS((r) + 1) != ATT_RS(r))
        if (ATT_SLIDE(r0)) { pa0 = *(const GAS v4u*)(ga + (size_t)(ATT_RS(r0) + 8) * stepa); pb0 = *(const GAS v4u*)(gb + (size_t)(ATT_RS(r0) + 8) * stepb); }
        if (ATT_SLIDE(r0 + 1)) { pa1 = *(const GAS v4u*)(ga + (size_t)(ATT_RS(r0 + 1) + 8) * stepa); pb1 = *(const GAS v4u*)(gb + (size_t)(ATT_RS(r0 + 1) + 8) * stepb); }
        const bf16* qp = PROJ + (size_t)(b * SEQ + r0 * 64 + 16 * g + qi) * ldp + qcol + 8 * qd;
        bf16x8 qf0 = ld_frag(qp), qf1 = ld_frag(qp + 32);
        ATT_BAR();
#pragma unroll 2
        for (int rr8 = 0; rr8 < 8; ++rr8) {
            const int r = r0 + rr8, rs = ATT_RS(r);
            if (compute) {
                bf16x8 qn0 = qf0, qn1 = qf1;
                if (rr8 < 7) { qn0 = ld_frag(qp + (size_t)(rr8 + 1) * 64 * ldp); qn1 = ld_frag(qp + (size_t)(rr8 + 1) * 64 * ldp + 32); }
                float mx = -INFINITY, ls = 0.f; f32x4 o[4];
#pragma unroll
                for (int dt = 0; dt < 4; ++dt) o[dt] = (f32x4){0.f, 0.f, 0.f, 0.f};
                const int vc = (w0 >> 3) + qd;
#pragma unroll
                for (int half = 0; half < 2; ++half) {
                    float sc[4][8];
#pragma unroll
                    for (int bl = 0; bl < 4; ++bl) { const LAS unsigned char* sl = slots + ((rs + 4 * half + bl) & 7) * 16384; bf16x8 kf[2][2];
#pragma unroll
                        for (int t = 0; t < 2; ++t) { const int tok = w0 + 8 * (qi >> 2) + 4 * t + (qi & 3); const int fk = att_fk(tok);
                            kf[t][0] = *(const LAS bf16x8*)(sl + tok * 128 + ((qd ^ fk) << 4)); kf[t][1] = *(const LAS bf16x8*)(sl + tok * 128 + (((4 + qd) ^ fk) << 4)); }
#pragma unroll
                        for (int t = 0; t < 2; ++t) { f32x4 a = {0.f, 0.f, 0.f, 0.f};
                            a = __builtin_amdgcn_mfma_f32_16x16x32_bf16(kf[t][0], qf0, a, 0, 0, 0);
                            a = __builtin_amdgcn_mfma_f32_16x16x32_bf16(kf[t][1], qf1, a, 0, 0, 0);
#pragma unroll
                            for (int j = 0; j < 4; ++j) sc[bl][4 * t + j] = a[j] * 0.125f; } }
                    constexpr int NHV = 1; bf16x8 vfa[NHV][4];
#pragma unroll
                    for (int bl = 0; bl < NHV; ++bl) { const LAS unsigned char* slv = slots + ((rs + 4 * half + bl) & 7) * 16384 + 8192;
#pragma unroll
                        for (int dt = 0; dt < 4; ++dt) { const int d = 16 * (qi >> 2) + 4 * dt + (qi & 3); vfa[bl][dt] = *(const LAS bf16x8*)(slv + d * 128 + ((vc ^ att_fv(d)) << 4)); } }
                    if (!is_mem) {
                        const int c = 16 * g + qi, cs = min(max(c - 8, 0), 48), kc0 = w0 + 8 * qd, lo = cs - kc0, hi = lo + 16;
                        const LAS float* rp = rpl + (rs + 4 * half - r + 7) * 48 + 8 + min(max(kc0 - c + 15, -8), 31);
#pragma unroll
                        for (int bp = 0; bp < 2; ++bp) { float bias[2][8];
#pragma unroll
                            for (int b2 = 0; b2 < 2; ++b2)
#pragma unroll
                                for (int e = 0; e < 8; ++e) bias[b2][e] = rp[(2 * bp + b2) * 48 + e];
#pragma unroll
                            for (int b2 = 0; b2 < 2; ++b2)
#pragma unroll
                                for (int e = 0; e < 8; ++e) sc[2 * bp + b2][e] = (e >= lo && e < hi) ? sc[2 * bp + b2][e] + bias[b2][e] : -INFINITY; }
                    }
                    float mh = -INFINITY;
#pragma unroll
                    for (int bl = 0; bl < 4; ++bl)
#pragma unroll
                        for (int e = 0; e < 8; ++e) mh = fmaxf(mh, sc[bl][e]);
                    mh = qd_max(mh);
                    const float mn = fmaxf(mx, mh), fo = __expf(mx - mn);
                    mx = mn; ls *= fo;
#pragma unroll
                    for (int dt = 0; dt < 4; ++dt) o[dt] = o[dt] * fo;
                    float lh = 0.f; bf16x8 pf[4];
#pragma unroll
                    for (int bl = 0; bl < 4; ++bl) { float p[8];
#pragma unroll
                        for (int e = 0; e < 8; ++e) { p[e] = __expf(sc[bl][e] - mn); lh += p[e]; }
                        u32x4 w; w.x = pk2(p[0], p[1]); w.y = pk2(p[2], p[3]); w.z = pk2(p[4], p[5]); w.w = pk2(p[6], p[7]);
                        pf[bl] = __builtin_bit_cast(bf16x8, w); }
                    lh = qd_sum(lh); ls += lh;
#pragma unroll
                    for (int bl = 0; bl < NHV; ++bl) {
#pragma unroll
                        for (int dt = 0; dt < 4; ++dt) o[dt] = __builtin_amdgcn_mfma_f32_16x16x32_bf16(vfa[bl][dt], pf[bl], o[dt], 0, 0, 0); }
#pragma unroll
                    for (int bl = NHV; bl < 4; ++bl) { const LAS unsigned char* sl = slots + ((rs + 4 * half + bl) & 7) * 16384 + 8192; bf16x8 vf[4];
#pragma unroll
                        for (int dt = 0; dt < 4; ++dt) { const int d = 16 * (qi >> 2) + 4 * dt + (qi & 3); vf[dt] = *(const LAS bf16x8*)(sl + d * 128 + ((vc ^ att_fv(d)) << 4)); }
#pragma unroll
                        for (int dt = 0; dt < 4; ++dt) o[dt] = __builtin_amdgcn_mfma_f32_16x16x32_bf16(vf[dt], pf[bl], o[dt], 0, 0, 0); }
                }
                const float inv = 1.0f / ls;
                bf16* op = MIXED + (size_t)(b * SEQ + r * 64 + 16 * g + qi) * D + head * 64 + 16 * qd;
                *(GAS u32x4*)op = (u32x4){pk2(o[0][0] * inv, o[0][1] * inv), pk2(o[0][2] * inv, o[0][3] * inv), pk2(o[1][0] * inv, o[1][1] * inv), pk2(o[1][2] * inv, o[1][3] * inv)};
                *(GAS u32x4*)(op + 8) = (u32x4){pk2(o[2][0] * inv, o[2][1] * inv), pk2(o[2][2] * inv, o[2][3] * inv), pk2(o[3][0] * inv, o[3][1] * inv), pk2(o[3][2] * inv, o[3][3] * inv)};
                qf0 = qn0; qf1 = qn1;
            }
            if (!compute) { const int ridx = uk * 8 + rr8;
                if (pend) tr_finish2(itA, lane, tvA, cscr);
                itA = moe_tritem(cbase + ridx, cv.w1, cv.w3, cv.w2, cv.W13, cv.W2); tr_load2(itA, lane, tvA); pend = true; }
            ATT_BAR();
            if (ATT_SLIDE(r)) {
                const int sl = rs & 7;
                if ((rr8 & 1) == 0) { *(LAS v4u*)(slots + sl * 16384 + la) = pa0; *(LAS v4u*)(slots + sl * 16384 + lb) = pb0; }
                else                { *(LAS v4u*)(slots + sl * 16384 + la) = pa1; *(LAS v4u*)(slots + sl * 16384 + lb) = pb1; }
            }
            if (ATT_SLIDE(r + 2)) {
                if ((rr8 & 1) == 0) { pa0 = *(const GAS v4u*)(ga + (size_t)(ATT_RS(r + 2) + 8) * stepa); pb0 = *(const GAS v4u*)(gb + (size_t)(ATT_RS(r + 2) + 8) * stepb); }
                else                { pa1 = *(const GAS v4u*)(ga + (size_t)(ATT_RS(r + 2) + 8) * stepa); pb1 = *(const GAS v4u*)(gb + (size_t)(ATT_RS(r + 2) + 8) * stepb); }
            }
            ATT_BAR();
        }
    }
    if (!compute && pend) tr_finish2(itA, lane, tvA, cscr);
#undef ATT_RS
#undef ATT_SLIDE
#undef ATT_BAR
}

__device__ __forceinline__ void ml_conv(const Frame& F, const bf16* PROJ, const float* cw  , const float* cb  , bf16* QKC) {
    const int gt = F.vcu * NTHREADS + F.tid, NT = F.G * NTHREADS;
    for (int it = gt; it < (M / 16) * 192; it += NT) {
        const int tb = it / 192, c0 = (it - tb * 192) * 8, tok0 = tb * 16, t0 = tok0 & (SEQ - 1);
        v4u rw[20];
#pragma unroll
        for (int k = 0; k < 20; ++k) { const int tt = t0 - 2 + k;
            rw[k] = (tt >= 0 && tt < SEQ) ? *(const GAS v4u*)(PROJ + (size_t)(tok0 - 2 + k) * ML_LDP + c0) : (v4u){0u, 0u, 0u, 0u}; }
        float w[5][8], bs[8];
#pragma unroll
        for (int jj = 0; jj < 5; ++jj) { const f32x4 wa = *(const GAS f32x4*)(cw + jj * 1536 + c0), wb = *(const GAS f32x4*)(cw + jj * 1536 + c0 + 4);
            w[jj][0] = wa.x; w[jj][1] = wa.y; w[jj][2] = wa.z; w[jj][3] = wa.w; w[jj][4] = wb.x; w[jj][5] = wb.y; w[jj][6] = wb.z; w[jj][7] = wb.w; }
        { const f32x4 ba = *(const GAS f32x4*)(cb + c0), bb = *(const GAS f32x4*)(cb + c0 + 4); bs[0] = ba.x; bs[1] = ba.y; bs[2] = ba.z; bs[3] = ba.w; bs[4] = bb.x; bs[5] = bb.y; bs[6] = bb.z; bs[7] = bb.w; }
        const float qs = c0 < TOKW ? 0.07216878364870322f : 1.0f;
#pragma unroll
        for (int i = 0; i < 16; ++i) { float acc[8];
#pragma unroll
            for (int j = 0; j < 8; ++j) acc[j] = bs[j];
#pragma unroll
            for (int jj = 0; jj < 5; ++jj) { const v4u r = rw[i + jj];
                acc[0] += bflo(r.x) * w[jj][0]; acc[1] += bfhi(r.x) * w[jj][1]; acc[2] += bflo(r.y) * w[jj][2]; acc[3] += bfhi(r.y) * w[jj][3];
                acc[4] += bflo(r.z) * w[jj][4]; acc[5] += bfhi(r.z) * w[jj][5]; acc[6] += bflo(r.w) * w[jj][6]; acc[7] += bfhi(r.w) * w[jj][7]; }
#pragma unroll
            for (int j = 0; j < 8; ++j) acc[j] = acc[j] * __builtin_amdgcn_rcpf(1.0f + __expf(-acc[j])) * qs;
            *(GAS v4u*)(QKC + (size_t)(tok0 + i) * 1536 + c0) = (v4u){pk2(acc[0], acc[1]), pk2(acc[2], acc[3]), pk2(acc[4], acc[5]), pk2(acc[6], acc[7])}; }
    }
}
constexpr int ML_QS = 200, ML_TS = 72;
constexpr int MLO_Q = 0, MLO_K = MLO_Q + 64 * ML_QS * 2, MLO_KT = MLO_K + 64 * ML_QS * 2, MLO_VT = MLO_KT + 192 * ML_TS * 2, MLO_S = MLO_VT + 64 * ML_TS * 2, MLO_PX = MLO_S + 64 * ML_TS * 2,
              MLO_SC = MLO_PX + 16 * 64 * 16, MLO_MK = MLO_SC + 2 * 6 * 256, MLO_H = MLO_MK + 1024, MLO_END = MLO_H + 2 * 64 * 48 * 2;
static_assert(MLO_END <= RING_BYTES, "mLSTM LDS map");
constexpr size_t SCAL_TAIL = (size_t)64 * 3 * SEQ;
__device__ __forceinline__ void ml_gate_prepass(const Frame& F, const float* GATES, const float* gate_b, float* SCAL) {
    const int gw = F.vcu * NWAVES + F.wave, NGW = F.G * NWAVES, lane = F.lane;
    for (int job = gw; job < 64 * 64; job += NGW) {
        const int sid = job >> 6, ck = job & 63, b = sid >> 3, h = (sid >> 1) & 3, dir = sid & 1;
        const size_t tok = (size_t)b * SEQ + (dir ? SEQ - 64 * (ck + 1) : 64 * ck) + (dir ? 63 - lane : lane);
        const float li = GATES[tok * 16 + dir * 4 + h] + gate_b[dir * 4 + h], gf = GATES[tok * 16 + (2 + dir) * 4 + h] + gate_b[(2 + dir) * 4 + h];
        float bs = fminf(gf, 0.f) - log1pf(__expf(-fabsf(gf)));
#pragma unroll
        for (int o = 1; o < 64; o <<= 1) { const float t = __shfl_up(bs, o); if (lane >= o) bs += t; }
        const float a = li - bs; float A = a;
#pragma unroll
        for (int o = 1; o < 64; o <<= 1) { const float t = __shfl_up(A, o); if (lane >= o) A = fmaxf(A, t); }
        float* base = SCAL + (size_t)sid * 3 * SEQ + ck * 64 + lane;
        base[0] = bs; base[SEQ] = a; base[2 * SEQ] = A;
        if (lane == 63) { SCAL[SCAL_TAIL + sid * 128 + ck] = bs; SCAL[SCAL_TAIL + sid * 128 + 64 + ck] = A; }
    }
}
__device__ __forceinline__ void ml_scan_mfma(const Frame& F, const bf16* QKC, const bf16* VTG  , const float* SCAL, bf16* HOUT  ) {
#define ML_BAR() do { asm volatile("s_waitcnt lgkmcnt(0)" ::: "memory"); __builtin_amdgcn_s_barrier(); asm volatile("" ::: "memory"); } while (0)
    const int x = F.bx & 7, jb = F.bx >> 3;
    const int sid = x * 8 + (jb >> 2), slice = jb & 3;
    const int b = sid >> 3, h = (sid >> 1) & 3, dir = sid & 1;
    const int tid = F.tid, lane = F.lane, wave = F.wave, fr = lane & 15, fq = lane >> 4, et = wave & 3, hf = wave >> 2;
    LAS bf16* Qs = (LAS bf16*)(F.lds + MLO_Q); LAS bf16* Ks = (LAS bf16*)(F.lds + MLO_K); LAS bf16* KTs = (LAS bf16*)(F.lds + MLO_KT);
    LAS bf16* VTs = (LAS bf16*)(F.lds + MLO_VT); LAS bf16* Ss = (LAS bf16*)(F.lds + MLO_S); LAS f32x4* PX = (LAS f32x4*)(F.lds + MLO_PX); LAS float* SC = (LAS float*)(F.lds + MLO_SC);
    for (int i = tid; i < 16 * ML_TS; i += NTHREADS) { const int rr = i / ML_TS, cc = i % ML_TS; VTs[(4 * rr + 3) * ML_TS + cc] = (bf16)0x3F80; }
    LAS float* MK = (LAS float*)(F.lds + MLO_MK); LAS float* B63 = MK + 80;
    if (tid < 64) { B63[tid] = SCAL[SCAL_TAIL + sid * 128 + tid]; B63[64 + tid] = SCAL[SCAL_TAIL + sid * 128 + 64 + tid]; }
    asm volatile("s_waitcnt vmcnt(0) lgkmcnt(0)" ::: "memory"); __builtin_amdgcn_s_barrier(); asm volatile("" ::: "memory");
    if (tid == 0) { float mm = 0.f; MK[0] = 0.f; for (int k = 0; k < 64; ++k) { mm = B63[k] + fmaxf(mm, B63[64 + k]); MK[k + 1] = mm; } }
    f32x4 C[3][2];
#pragma unroll
    for (int i = 0; i < 3; ++i) { C[i][0] = (f32x4){0.f, 0.f, 0.f, 0.f}; C[i][1] = (f32x4){0.f, 0.f, 0.f, 0.f}; }
    v4u qreg[3], kreg[3], vreg = (v4u){0u, 0u, 0u, 0u}; float g_bs = 0.f, g_a = 0.f, g_A = 0.f;
    LAS bf16* Hs = (LAS bf16*)(F.lds + MLO_H);
    size_t hbase1 = 0, hbase2 = 0;
    f32x4 num[4] = {{0.f, 0.f, 0.f, 0.f}, {0.f, 0.f, 0.f, 0.f}, {0.f, 0.f, 0.f, 0.f}, {0.f, 0.f, 0.f, 0.f}};
    const int prow[3] = {tid / 24, (tid + 512) / 24, (tid + 1024) / 24}; const int pc[3] = {tid % 24, (tid + 512) % 24, (tid + 1024) % 24};
    const int vrow = tid >> 3, vc = tid & 7;
#define ML_PREFETCH(kk) do { const size_t tb_ = (size_t)b * SEQ + (dir ? SEQ - 64 * ((kk) + 1) : 64 * (kk)); \
        _Pragma("unroll") for (int i_ = 0; i_ < 3; ++i_) { qreg[i_] = *(const GAS v4u*)(QKC + (tb_ + prow[i_]) * 1536 + h * 192 + 8 * pc[i_]); kreg[i_] = *(const GAS v4u*)(QKC + (tb_ + prow[i_]) * 1536 + 768 + h * 192 + 8 * pc[i_]); } \
        if (tid < 384) vreg = *(const GAS v4u*)(VTG + (size_t)(h * 192 + slice * 48 + vrow) * M + tb_ + 8 * vc); \
        if (wave == 0) { const float* sp_ = SCAL + (size_t)sid * 3 * SEQ + (kk) * 64 + lane; g_bs = sp_[0]; g_a = sp_[SEQ]; g_A = sp_[2 * SEQ]; } } while (0)
    ML_PREFETCH(0);
    ML_BAR();
    unsigned long long sp_t = 0, sp_acc = 0;
#define SP_MARK(r) do { if (MK_SUBPROBE != 0) { const unsigned long long n_ = __builtin_amdgcn_s_memrealtime(); if (MK_SUBPROBE == (r)) sp_acc += n_ - sp_t; sp_t = n_; } } while (0)
    if (MK_SUBPROBE != 0) sp_t = __builtin_amdgcn_s_memrealtime();
    for (int ck = 0; ck < SEQ / 64; ++ck) {
        const size_t tokbase = (size_t)b * SEQ + (dir ? SEQ - 64 * (ck + 1) : 64 * ck);
        LAS float* sc = SC + (ck & 1) * (6 * 64);
        if (wave == 0) {
            const float mk = MK[ck], mnew = MK[ck + 1], b63 = B63[ck], mt = g_bs + fmaxf(mk, g_A);
            const int p = dir ? 63 - lane : lane;
            sc[p] = g_bs - mt; sc[64 + p] = g_a; sc[128 + p] = __expf(g_bs + mk - mt); sc[192 + p] = __expf(b63 + g_a - mnew); sc[256 + p] = __expf(-mt);
            if (lane == 0) sc[320] = __expf(b63 + mk - mnew);
        }
#pragma unroll
        for (int i = 0; i < 3; ++i) { *(LAS v4u*)(Qs + prow[i] * ML_QS + 8 * pc[i]) = qreg[i]; *(LAS v4u*)(Ks + prow[i] * ML_QS + 8 * pc[i]) = kreg[i]; }
        if (tid < 384) *(LAS v4u*)(VTs + (16 * (vrow / 12) + 4 * ((vrow % 12) / 3) + (vrow % 12) % 3) * ML_TS + 8 * vc) = vreg;
        ML_BAR();
        { const int lt = wave >> 1, st0 = 2 * (wave & 1);
          bf16x8 qa[6], kb[2][6];
#pragma unroll
          for (int ks = 0; ks < 6; ++ks) { qa[ks] = *(const LAS bf16x8*)(Qs + (16 * lt + fr) * ML_QS + 32 * ks + 8 * fq);
              kb[0][ks] = *(const LAS bf16x8*)(Ks + (16 * st0 + fr) * ML_QS + 32 * ks + 8 * fq); kb[1][ks] = *(const LAS bf16x8*)(Ks + (16 * st0 + 16 + fr) * ML_QS + 32 * ks + 8 * fq); }
        if (ck > 0) {
            if (hf == 0) { LAS float* scp = SC + ((ck - 1) & 1) * (6 * 64); LAS bf16* Hw = Hs + ((ck - 1) & 1) * (64 * 48);
                f32x4 px[4];
#pragma unroll
                for (int lt = 0; lt < 4; ++lt) px[lt] = PX[(et * 4 + lt) * 64 + lane];
                const float em0 = scp[256 + fr], em1 = scp[256 + 16 + fr], em2 = scp[256 + 32 + fr], em3 = scp[256 + 48 + fr];
#pragma unroll
                for (int lt = 0; lt < 4; ++lt) { const f32x4 o = num[lt] + px[lt]; const float em = lt == 0 ? em0 : (lt == 1 ? em1 : (lt == 2 ? em2 : em3));
                    const float rden = __builtin_amdgcn_rcpf(fmaxf(fabsf(o[3]), em));
                    const unsigned w01 = pk2(o[0] * rden, o[1] * rden), w2 = pk2(o[2] * rden, 0.f); LAS bf16* hq = Hw + (16 * lt + fr) * 48 + 12 * et + 3 * fq;
                    hq[0] = (bf16)(w01 & 0xffffu); hq[1] = (bf16)(w01 >> 16); hq[2] = (bf16)(w2 & 0xffffu); } }
            if (ck > 1 && tid < 384) *(GAS v4u*)(HOUT + hbase2 + (size_t)(tid / 6) * TOKW + 8 * (tid % 6)) = *(const LAS v4u*)(Hs + (ck & 1) * (64 * 48) + (tid / 6) * 48 + 8 * (tid % 6));
        }
        { const float w = sc[192 + lane];
#pragma unroll
          for (int i = 0; i < 3; ++i) { const v4u kr = *(const LAS v4u*)(Ks + lane * ML_QS + 24 * wave + 8 * i); const unsigned kw[4] = {kr.x, kr.y, kr.z, kr.w};
#pragma unroll
            for (int e = 0; e < 4; ++e) { const unsigned pw = pk2(bflo(kw[e]) * w, bfhi(kw[e]) * w);
                KTs[(24 * wave + 8 * i + 2 * e) * ML_TS + lane] = (bf16)(pw & 0xffffu); KTs[(24 * wave + 8 * i + 2 * e + 1) * ML_TS + lane] = (bf16)(pw >> 16); } } }
        if (ck + 1 < SEQ / 64) ML_PREFETCH(ck + 1);
          __builtin_amdgcn_sched_barrier(0);
          f32x4 acc[2] = {{0.f, 0.f, 0.f, 0.f}, {0.f, 0.f, 0.f, 0.f}};
          __builtin_amdgcn_s_setprio(1);
#pragma unroll
          for (int ks = 0; ks < 6; ++ks) { acc[0] = __builtin_amdgcn_mfma_f32_16x16x32_bf16(qa[ks], kb[0][ks], acc[0], 0, 0, 0); acc[1] = __builtin_amdgcn_mfma_f32_16x16x32_bf16(qa[ks], kb[1][ks], acc[1], 0, 0, 0); }
          __builtin_amdgcn_s_setprio(0);
          const f32x4 rt = *(const LAS f32x4*)(sc + 16 * lt + 4 * fq); const float ct0 = sc[64 + 16 * st0 + fr], ct1 = sc[64 + 16 * st0 + 16 + fr];
#pragma unroll
          for (int u = 0; u < 2; ++u) { const int scol = 16 * (st0 + u) + fr; const float ct = u ? ct1 : ct0;
#pragma unroll
            for (int j = 0; j < 4; ++j) { const int l = 16 * lt + 4 * fq + j; const bool ok = dir ? (scol >= l) : (scol <= l);
                const float ev = acc[u][j] * __expf(fminf(rt[j] + ct, 0.f)); Ss[l * ML_TS + scol] = (bf16)f2bf(ok ? ev : 0.f); } } }
        ML_BAR();
        { bf16x8 qf[4][3], sf[2][2], vf[2], kt[3][2][2];
#pragma unroll
          for (int lt = 0; lt < 4; ++lt)
#pragma unroll
            for (int blk = 0; blk < 3; ++blk) qf[lt][blk] = *(const LAS bf16x8*)(Qs + (16 * lt + fr) * ML_QS + 96 * hf + 32 * blk + 8 * fq);
#pragma unroll
          for (int ks = 0; ks < 2; ++ks) { vf[ks] = *(const LAS bf16x8*)(VTs + (16 * et + fr) * ML_TS + 32 * ks + 8 * fq);
#pragma unroll
            for (int u = 0; u < 2; ++u) sf[u][ks] = *(const LAS bf16x8*)(Ss + (16 * (2 * hf + u) + fr) * ML_TS + 32 * ks + 8 * fq); }
#pragma unroll
          for (int blk = 0; blk < 3; ++blk)
#pragma unroll
            for (int t = 0; t < 2; ++t)
#pragma unroll
              for (int ks = 0; ks < 2; ++ks) kt[blk][t][ks] = *(const LAS bf16x8*)(KTs + (96 * hf + 32 * blk + 8 * (fr >> 2) + 4 * t + (fr & 3)) * ML_TS + 32 * ks + 8 * fq);
          float wi[4];
#pragma unroll
          for (int lt = 0; lt < 4; ++lt) wi[lt] = sc[128 + 16 * lt + fr];
          const float decay = sc[320];
          __builtin_amdgcn_sched_barrier(0);
          __builtin_amdgcn_s_setprio(1);
#pragma unroll
          for (int lt = 0; lt < 4; ++lt) num[lt] = (f32x4){0.f, 0.f, 0.f, 0.f};
#pragma unroll
          for (int blk = 0; blk < 3; ++blk) { const u32x4 cw = {pk2(C[blk][0][0], C[blk][0][1]), pk2(C[blk][0][2], C[blk][0][3]), pk2(C[blk][1][0], C[blk][1][1]), pk2(C[blk][1][2], C[blk][1][3])};
            const bf16x8 cf = __builtin_bit_cast(bf16x8, cw);
#pragma unroll
            for (int lt = 0; lt < 4; ++lt) num[lt] = __builtin_amdgcn_mfma_f32_16x16x32_bf16(cf, qf[lt][blk], num[lt], 0, 0, 0); }
#pragma unroll
          for (int blk = 0; blk < 3; ++blk)
#pragma unroll
            for (int t = 0; t < 2; ++t) { C[blk][t] = C[blk][t] * decay;
#pragma unroll
                for (int ks = 0; ks < 2; ++ks) C[blk][t] = __builtin_amdgcn_mfma_f32_16x16x32_bf16(kt[blk][t][ks], vf[ks], C[blk][t], 0, 0, 0); }
#pragma unroll
          for (int lt = 0; lt < 4; ++lt) num[lt] = num[lt] * wi[lt];
          if (hf == 0) {
#pragma unroll
            for (int u = 0; u < 2; ++u)
#pragma unroll
              for (int ks = 0; ks < 2; ++ks) num[u] = __builtin_amdgcn_mfma_f32_16x16x32_bf16(vf[ks], sf[u][ks], num[u], 0, 0, 0);
          } else {
#pragma unroll
            for (int u = 0; u < 2; ++u)
#pragma unroll
              for (int ks = 0; ks < 2; ++ks) num[2 + u] = __builtin_amdgcn_mfma_f32_16x16x32_bf16(vf[ks], sf[u][ks], num[2 + u], 0, 0, 0);
#pragma unroll
            for (int lt = 0; lt < 4; ++lt) PX[(et * 4 + lt) * 64 + lane] = num[lt];
          }
          __builtin_amdgcn_s_setprio(0); }
        ML_BAR();
        hbase2 = hbase1; hbase1 = (size_t)dir * M * TOKW + tokbase * TOKW + h * 192 + slice * 48;
    }
    if (MK_SUBPROBE != 0 && F.bx == 0 && tid == 0) *(LAS unsigned long long*)(F.lds + L_PROBE) += sp_acc;
    if (hf == 0) { LAS float* scp = SC + 1 * (6 * 64); LAS bf16* Hw = Hs + 1 * (64 * 48);
        f32x4 px[4];
#pragma unroll
        for (int lt = 0; lt < 4; ++lt) px[lt] = PX[(et * 4 + lt) * 64 + lane];
        const float em0 = scp[256 + fr], em1 = scp[256 + 16 + fr], em2 = scp[256 + 32 + fr], em3 = scp[256 + 48 + fr];
#pragma unroll
        for (int lt = 0; lt < 4; ++lt) { const f32x4 o = num[lt] + px[lt]; const float em = lt == 0 ? em0 : (lt == 1 ? em1 : (lt == 2 ? em2 : em3));
            const float rden = __builtin_amdgcn_rcpf(fmaxf(fabsf(o[3]), em));
            const unsigned w01 = pk2(o[0] * rden, o[1] * rden), w2 = pk2(o[2] * rden, 0.f); LAS bf16* hq = Hw + (16 * lt + fr) * 48 + 12 * et + 3 * fq;
            hq[0] = (bf16)(w01 & 0xffffu); hq[1] = (bf16)(w01 >> 16); hq[2] = (bf16)(w2 & 0xffffu); } }
    ML_BAR();
    if (tid < 384) { *(GAS v4u*)(HOUT + hbase2 + (size_t)(tid / 6) * TOKW + 8 * (tid % 6)) = *(const LAS v4u*)(Hs + (tid / 6) * 48 + 8 * (tid % 6));
                     *(GAS v4u*)(HOUT + hbase1 + (size_t)(tid / 6) * TOKW + 8 * (tid % 6)) = *(const LAS v4u*)(Hs + 64 * 48 + (tid / 6) * 48 + 8 * (tid % 6)); }
#undef SP_MARK
#undef ML_PREFETCH
#undef ML_BAR
}
__device__ __forceinline__ float row16_sum(float v) {
    v += dpp_mov<0xB1>(v); v += dpp_mov<0x4E>(v); v += dpp_mov<0x141>(v); v += dpp_mov<0x140>(v); return v;
}
__device__ __forceinline__ void ml_norm_gate(const Frame& F, const bf16* PROJ, const bf16* HOUT, const float* norm_g  , bf16* MIXED) {
    const int gw = F.vcu * NWAVES + F.wave, NGW = F.G * NWAVES, lane = F.lane;
    const int c0 = lane * 12;
    float ng[12];
#pragma unroll
    for (int i = 0; i < 3; ++i) { const f32x4 t = *(const GAS f32x4*)(norm_g + c0 + 4 * i); ng[4 * i] = t.x; ng[4 * i + 1] = t.y; ng[4 * i + 2] = t.z; ng[4 * i + 3] = t.w; }
    typedef unsigned u32x2v __attribute__((ext_vector_type(2)));
    u32x2v ca[3], cb[3], co[3];
    int tok = gw;
    if (tok < M) {
#pragma unroll
        for (int i = 0; i < 3; ++i) { ca[i] = *(const GAS u32x2v*)(HOUT + (size_t)tok * TOKW + c0 + 4 * i); cb[i] = *(const GAS u32x2v*)(HOUT + (size_t)M * TOKW + (size_t)tok * TOKW + c0 + 4 * i);
            co[i] = *(const GAS u32x2v*)(PROJ + (size_t)tok * ML_LDP + 1536 + c0 + 4 * i); } }
    while (tok < M) {
        const int ntok = tok + NGW; u32x2v na[3], nb[3], no[3];
        if (ntok < M) {
#pragma unroll
            for (int i = 0; i < 3; ++i) { na[i] = *(const GAS u32x2v*)(HOUT + (size_t)ntok * TOKW + c0 + 4 * i); nb[i] = *(const GAS u32x2v*)(HOUT + (size_t)M * TOKW + (size_t)ntok * TOKW + c0 + 4 * i);
                no[i] = *(const GAS u32x2v*)(PROJ + (size_t)ntok * ML_LDP + 1536 + c0 + 4 * i); } }
        float v[12], op[12]; float s = 0.f;
#pragma unroll
        for (int i = 0; i < 3; ++i) { const u32x2v a = ca[i], b = cb[i], o = co[i];
            v[4 * i] = bflo(a.x) + bflo(b.x); v[4 * i + 1] = bfhi(a.x) + bfhi(b.x); v[4 * i + 2] = bflo(a.y) + bflo(b.y); v[4 * i + 3] = bfhi(a.y) + bfhi(b.y);
            op[4 * i] = bflo(o.x); op[4 * i + 1] = bfhi(o.x); op[4 * i + 2] = bflo(o.y); op[4 * i + 3] = bfhi(o.y); }
#pragma unroll
        for (int i = 0; i < 12; ++i) s += v[i];
        const float mu = row16_sum(s) * (1.0f / 192.0f); float q = 0.f;
#pragma unroll
        for (int i = 0; i < 12; ++i) { v[i] -= mu; q += v[i] * v[i]; }
        const float rstd = 1.0f / sqrtf(row16_sum(q) * (1.0f / 192.0f) + LN_EPS);
        float r[12];
#pragma unroll
        for (int i = 0; i < 12; ++i) r[i] = v[i] * rstd * ng[i] * __builtin_amdgcn_rcpf(1.0f + __expf(-op[i]));
#pragma unroll
        for (int i = 0; i < 3; ++i) *(GAS u32x2v*)(MIXED + (size_t)tok * D + c0 + 4 * i) = (u32x2v){pk2(r[4 * i], r[4 * i + 1]), pk2(r[4 * i + 2], r[4 * i + 3])};
#pragma unroll
        for (int i = 0; i < 3; ++i) { ca[i] = na[i]; cb[i] = nb[i]; co[i] = no[i]; }
        tok = ntok;
    }
}

__device__ __forceinline__ void pd_loadx(u32x4 (&dst)[4], const bf16* xr, int blk) {
#pragma unroll
    for (int q = 0; q < 4; ++q) dst[q] = *(const GAS u32x4*)(xr + 32 * (4 * blk + q));
}
constexpr int PD_ROWB = 272, PD_SLICE = 96 * PD_ROWB;
__device__ __forceinline__ void pd_block(const u32x4 (&cur)[4], const LAS unsigned char* wsl, int fr, int fq, f32x4 (&acc)[3], float& s, float& s2) {
    bf16x8 wh[4][3], wl[4][3];
#pragma unroll
    for (int q = 0; q < 4; ++q)
#pragma unroll
        for (int nt = 0; nt < 3; ++nt) { wh[q][nt] = *(const LAS bf16x8*)(wsl + (16 * nt + fr) * PD_ROWB + 64 * q + 16 * fq); wl[q][nt] = *(const LAS bf16x8*)(wsl + (48 + 16 * nt + fr) * PD_ROWB + 64 * q + 16 * fq); }
    __builtin_amdgcn_sched_barrier(0);
#pragma unroll
    for (int q = 0; q < 4; ++q) { const u32x4 w = cur[q];
        const float x0 = bflo(w.x), x1 = bfhi(w.x), x2 = bflo(w.y), x3 = bfhi(w.y), x4 = bflo(w.z), x5 = bfhi(w.z), x6 = bflo(w.w), x7 = bfhi(w.w);
        s += ((x0 + x1) + (x2 + x3)) + ((x4 + x5) + (x6 + x7));
        s2 += ((x0 * x0 + x1 * x1) + (x2 * x2 + x3 * x3)) + ((x4 * x4 + x5 * x5) + (x6 * x6 + x7 * x7));
        const bf16x8 ah = __builtin_bit_cast(bf16x8, w);
#pragma unroll
        for (int nt = 0; nt < 3; ++nt) {
            acc[nt] = __builtin_amdgcn_mfma_f32_16x16x32_bf16(ah, wh[q][nt], acc[nt], 0, 0, 0);
            acc[nt] = __builtin_amdgcn_mfma_f32_16x16x32_bf16(ah, wl[q][nt], acc[nt], 0, 0, 0); } }
}
__device__ __forceinline__ void ln1_route(const Frame& F, const bf16* PRE, const bf16* WR  , const float* RGB  , float* STATS,
                                           int* TOKE, float* TOKG, int* TOKP, int* ROWSLOT, gu32* cnt, int* WGBASE) {
    const int gw = F.vcu * NWAVES + F.wave, NGW = F.G * NWAVES, lane = F.lane, fr = lane & 15, fq = lane >> 4;
    LAS int* HIST = (LAS int*)(F.lds + L_HIST);
    LAS float* lg = (LAS float*)(F.lds + 8192 + F.wave * 4096);
    if (F.tid < 32) HIST[F.tid] = 0;
    { const int gt = F.vcu * NTHREADS + F.tid, NT = F.G * NTHREADS; for (int i = gt; i < P_MAX; i += NT) ROWSLOT[i] = -1; }
    __syncthreads();
    LAS unsigned char* wbuf = F.lds + 49152;
    for (int jb = F.vcu; jb < M / 128; jb += F.G) {
        const int job = jb * 8 + F.wave, row0 = job * 16;
        const bf16* xr = PRE + (size_t)(row0 + fr) * D + 8 * fq;
        float s = 0.f, s2 = 0.f;
        f32x4 acc[3] = {{0.f, 0.f, 0.f, 0.f}, {0.f, 0.f, 0.f, 0.f}, {0.f, 0.f, 0.f, 0.f}};
        const bf16* wsrc[3]; int wdst[3];
#pragma unroll
        for (int i = 0; i < 3; ++i) { const int q = F.tid + 512 * i; wsrc[i] = WR + (size_t)(q >> 4) * D + 8 * (q & 15); wdst[i] = (q >> 4) * PD_ROWB + 16 * (q & 15); }
        v4u wr[3];
#pragma unroll
        for (int i = 0; i < 3; ++i) wr[i] = *(const GAS v4u*)(wsrc[i]);
        u32x4 xa[4], xb[4];
        pd_loadx(xa, xr, 0);
        __syncthreads();
#pragma unroll
        for (int i = 0; i < 3; ++i) *(LAS v4u*)(wbuf + wdst[i]) = wr[i];
#pragma unroll
        for (int i = 0; i < 3; ++i) wr[i] = *(const GAS v4u*)(wsrc[i] + 128);
        __syncthreads();
#pragma unroll 1
        for (int bp = 0; bp < 4; ++bp) {
            pd_loadx(xb, xr, 2 * bp + 1);
            pd_block(xa, wbuf, fr, fq, acc, s, s2);
#pragma unroll
            for (int i = 0; i < 3; ++i) *(LAS v4u*)(wbuf + PD_SLICE + wdst[i]) = wr[i];
            if (bp < 3) {
#pragma unroll
                for (int i = 0; i < 3; ++i) wr[i] = *(const GAS v4u*)(wsrc[i] + 128 * (2 * bp + 2)); }
            __syncthreads();
            if (bp < 3) pd_loadx(xa, xr, 2 * bp + 2);
            pd_block(xb, wbuf + PD_SLICE, fr, fq, acc, s, s2);
            if (bp < 3) {
#pragma unroll
                for (int i = 0; i < 3; ++i) *(LAS v4u*)(wbuf + wdst[i]) = wr[i];
#pragma unroll
                for (int i = 0; i < 3; ++i) wr[i] = *(const GAS v4u*)(wsrc[i] + 128 * (2 * bp + 3)); }
            __syncthreads();
        }
        s = qd_sum(s); s2 = qd_sum(s2);
        const float mean = s * (1.f / D), rstd = 1.f / sqrtf(fmaxf(s2 * (1.f / D) - mean * mean, 0.f) + LN_EPS);
#pragma unroll
        for (int nt = 0; nt < 3; ++nt)
#pragma unroll
            for (int j = 0; j < 4; ++j) lg[(4 * fq + j) * 52 + 16 * nt + fr] = acc[nt][j];
        asm volatile("s_waitcnt lgkmcnt(0)" ::: "memory");
        if (lane < 16) {
            const LAS float* lr = lg + lane * 52; const int row = row0 + lane;
            STATS[2 * row] = mean; STATS[2 * row + 1] = rstd;
            float gl[4];
#pragma unroll
            for (int g = 0; g < 4; ++g) gl[g] = rstd * (lr[g] - mean * RGB[g]) + RGB[48 + g];
            int gi = 0; float gm = gl[0];
#pragma unroll
            for (int g = 1; g < 4; ++g) if (gl[g] > gm) { gm = gl[g]; gi = g; }
            float gs = 0.f;
#pragma unroll
            for (int g = 0; g < 4; ++g) gs += __expf(gl[g] - gm);
            const float ggate = 1.0f / gs;
            float el[8];
#pragma unroll
            for (int i = 0; i < 8; ++i) el[i] = rstd * (lr[4 + gi * 8 + i] - mean * RGB[4 + gi * 8 + i]) + RGB[48 + 4 + gi * 8 + i];
            int i0 = 0; float l0 = el[0];
#pragma unroll
            for (int i = 1; i < 8; ++i) if (el[i] > l0) { l0 = el[i]; i0 = i; }
            int i1 = -1; float l1 = -INFINITY;
#pragma unroll
            for (int i = 0; i < 8; ++i) if (i != i0 && el[i] > l1) { l1 = el[i]; i1 = i; }
            const float p0 = 1.0f / (1.0f + __expf(l1 - l0)), p1 = 1.0f - p0;
            const int e0 = gi * 8 + i0, e1 = gi * 8 + i1;
            const int q0 = atomicAdd((int*)(HIST + e0), 1), q1 = atomicAdd((int*)(HIST + e1), 1);
            TOKE[2 * row] = e0; TOKE[2 * row + 1] = e1; TOKG[2 * row] = ggate * p0; TOKG[2 * row + 1] = ggate * p1; TOKP[2 * row] = q0; TOKP[2 * row + 1] = q1;
        }
    }
    __syncthreads();
    if (F.tid < 32) WGBASE[F.tid] = (int)__hip_atomic_fetch_add(cnt + F.tid, (unsigned)HIST[F.tid], __ATOMIC_RELAXED, __HIP_MEMORY_SCOPE_AGENT);
    __syncthreads();
}
__device__ __forceinline__ void moe_gather(const Frame& F, const bf16* PRE, const float* STATS, const float* g1, const float* b1, const int* TOKE, const float* TOKG, const int* TOKP, int* ROWSLOT, float* ROWGATE, bf16* XS, gu32* cnt, int* TILETAB, const int* WGBASE) {
    const int gw = F.vcu * NWAVES + F.wave, NGW = F.G * NWAVES, lane = F.lane;
    LAS int* PADSTART = (LAS int*)(F.lds + L_PADSTART); LAS int* CNT = (LAS int*)(F.lds + L_CNT);
    if (F.tid < 32) CNT[F.tid] = (int)__hip_atomic_load(cnt + F.tid, __ATOMIC_RELAXED, __HIP_MEMORY_SCOPE_AGENT);
    __syncthreads();
    if (F.tid == 0) { int t = 0;
        for (int e = 0; e < NEXP; ++e) { PADSTART[e] = t * 256; const int nt = (CNT[e] + 255) >> 8;
            if (F.bx == 0) for (int k = 0; k < nt; ++k) TILETAB[1 + t + k] = e;
            t += nt; }
        if (F.bx == 0) TILETAB[0] = t; }
    __syncthreads();
    f32x4 G1[4], B1[4];
#pragma unroll
    for (int j = 0; j < 4; ++j) { const int col = 4 * lane + 256 * j; G1[j] = *(const GAS f32x4*)(g1 + col); B1[j] = *(const GAS f32x4*)(b1 + col); }
    for (int job = gw; job < M / 16; job += NGW) {
        unsigned long long xc[4]; float mc, rc; int ec0, ec1, qc0, qc1; float gc0, gc1;
        { const int row = job * 16;
#pragma unroll
          for (int j = 0; j < 4; ++j) xc[j] = ((const GAS unsigned long long*)(PRE + (size_t)row * D) + lane)[64 * j];
          mc = STATS[2 * row]; rc = STATS[2 * row + 1]; ec0 = TOKE[2 * row]; ec1 = TOKE[2 * row + 1]; qc0 = TOKP[2 * row]; qc1 = TOKP[2 * row + 1]; gc0 = TOKG[2 * row]; gc1 = TOKG[2 * row + 1]; }
        for (int ri = 0; ri < 16; ++ri) { const int row = job * 16 + ri;
            unsigned long long xn[4]; float mn = 0.f, rn = 0.f; int en0 = 0, en1 = 0, qn0 = 0, qn1 = 0; float gn0 = 0.f, gn1 = 0.f;
            if (ri < 15) { const int nrow = row + 1;
#pragma unroll
                for (int j = 0; j < 4; ++j) xn[j] = ((const GAS unsigned long long*)(PRE + (size_t)nrow * D) + lane)[64 * j];
                mn = STATS[2 * nrow]; rn = STATS[2 * nrow + 1]; en0 = TOKE[2 * nrow]; en1 = TOKE[2 * nrow + 1]; qn0 = TOKP[2 * nrow]; qn1 = TOKP[2 * nrow + 1]; gn0 = TOKG[2 * nrow]; gn1 = TOKG[2 * nrow + 1]; }
            unsigned long long pk[4];
#pragma unroll
            for (int j = 0; j < 4; ++j) { const unsigned x0 = (unsigned)xc[j], x1 = (unsigned)(xc[j] >> 32); const f32x4 xf = {bflo(x0), bfhi(x0), bflo(x1), bfhi(x1)}; const f32x4 v = (xf - mc) * rc * G1[j] + B1[j]; pk[j] = (unsigned long long)pk2(v.x, v.y) | ((unsigned long long)pk2(v.z, v.w) << 32); }
#pragma unroll
            for (int k = 0; k < 2; ++k) { const int e = k ? ec1 : ec0, q = k ? qc1 : qc0; const int dest = PADSTART[e] + WGBASE[e] + q;
                if (lane == 0) { ROWSLOT[dest] = 2 * row + k; ROWGATE[dest] = k ? gc1 : gc0; }
                GAS unsigned long long* o8 = (GAS unsigned long long*)(XS + (size_t)dest * D) + lane;
#pragma unroll
                for (int j = 0; j < 4; ++j) o8[64 * j] = pk[j]; }
#pragma unroll
            for (int j = 0; j < 4; ++j) xc[j] = xn[j];
            mc = mn; rc = rn; ec0 = en0; ec1 = en1; qc0 = qn0; qc1 = qn1; gc0 = gn0; gc1 = gn1;
        }
    }
}
__device__ __forceinline__ void ln2_pass(const Frame& F, const bf16* PRE, const float* STATS, const float* g1, const float* b1, const bf16* Y, const float* g2, const float* b2, float* XOUT  , bf16* XB) {
    const int gw = F.vcu * NWAVES + F.wave, NGW = F.G * NWAVES, lane = F.lane;
    typedef unsigned long long u64;
    f32x4 G1[4], B1[4], G2[4], B2[4];
#pragma unroll
    for (int j = 0; j < 4; ++j) { const int col = 4 * lane + 256 * j; G1[j] = *(const GAS f32x4*)(g1 + col); B1[j] = *(const GAS f32x4*)(b1 + col); G2[j] = *(const GAS f32x4*)(g2 + col); B2[j] = *(const GAS f32x4*)(b2 + col); }
    u64 xc[4], y0c[4], y1c[4]; float m1c = 0.f, r1c = 0.f;
    int row = gw;
    if (row < M) {
#pragma unroll
        for (int j = 0; j < 4; ++j) { xc[j] = ((const GAS u64*)(PRE + (size_t)row * D) + lane)[64 * j]; y0c[j] = ((const GAS u64*)(Y + (size_t)(2 * row) * D) + lane)[64 * j]; y1c[j] = ((const GAS u64*)(Y + (size_t)(2 * row + 1) * D) + lane)[64 * j]; }
        m1c = STATS[2 * row]; r1c = STATS[2 * row + 1]; }
    while (row < M) {
        const int nrow = row + NGW; u64 xn[4], y0n[4], y1n[4]; float m1n = 0.f, r1n = 0.f;
        if (nrow < M) {
#pragma unroll
            for (int j = 0; j < 4; ++j) { xn[j] = ((const GAS u64*)(PRE + (size_t)nrow * D) + lane)[64 * j]; y0n[j] = ((const GAS u64*)(Y + (size_t)(2 * nrow) * D) + lane)[64 * j]; y1n[j] = ((const GAS u64*)(Y + (size_t)(2 * nrow + 1) * D) + lane)[64 * j]; }
            m1n = STATS[2 * nrow]; r1n = STATS[2 * nrow + 1]; }
        f32x4 v[4]; float s = 0.f;
#pragma unroll
        for (int j = 0; j < 4; ++j) { const unsigned p0 = (unsigned)xc[j], p1 = (unsigned)(xc[j] >> 32); const f32x4 xf = {bflo(p0), bfhi(p0), bflo(p1), bfhi(p1)};
            const f32x4 x = (xf - m1c) * r1c * G1[j] + B1[j];
            const unsigned a0 = (unsigned)y0c[j], a1 = (unsigned)(y0c[j] >> 32), c0 = (unsigned)y1c[j], c1 = (unsigned)(y1c[j] >> 32);
            v[j].x = ALPHA * x.x + (bflo(a0) + bflo(c0)); v[j].y = ALPHA * x.y + (bfhi(a0) + bfhi(c0)); v[j].z = ALPHA * x.z + (bflo(a1) + bflo(c1)); v[j].w = ALPHA * x.w + (bfhi(a1) + bfhi(c1));
            s += (v[j].x + v[j].y) + (v[j].z + v[j].w); }
        const float mean = wave_sum(s) * (1.f / D); float s2 = 0.f;
#pragma unroll
        for (int j = 0; j < 4; ++j) { v[j] = v[j] - mean; s2 += (v[j].x * v[j].x + v[j].y * v[j].y) + (v[j].z * v[j].z + v[j].w * v[j].w); }
        const float rstd = 1.f / sqrtf(wave_sum(s2) * (1.f / D) + LN_EPS);
        GAS f32x4* orow = (GAS f32x4*)(XOUT + (size_t)row * D) + lane; GAS u64* ob = (GAS u64*)(XB + (size_t)row * D) + lane;
#pragma unroll
        for (int j = 0; j < 4; ++j) { const f32x4 y = v[j] * rstd * G2[j] + B2[j]; if (XOUT != nullptr) orow[64 * j] = y; else ob[64 * j] = (u64)pk2(y.x, y.y) | ((u64)pk2(y.z, y.w) << 32); }
#pragma unroll
        for (int j = 0; j < 4; ++j) { xc[j] = xn[j]; y0c[j] = y0n[j]; y1c[j] = y1n[j]; }
        m1c = m1n; r1c = r1n; row = nrow;
    }
}

struct Args { const float* in[22]; float* out; unsigned char* ws; int ph_lo, ph_hi; };
static_assert(sizeof(Args) == 22 * 8 + 8 + 8 + 8, "Args has no padding");
enum PhaseKind { K_P0 = 0, K_P1, K_PA, K_PB, K_PB2, K_PB3, K_PC, K_PD, K_PE, K_PF, K_PG, K_PH };
constexpr int N_PHASES = 2 + 2 * 8 + 2 * 10;
__device__ __forceinline__ void decode_phase(int ph, int& layer, int& kind) {
    if (ph < 2) { layer = 0; kind = ph; return; }
    int r = ph - 2; const int pair = r / 18; r -= pair * 18;
    if (r < 8) { layer = 2 * pair; kind = r == 0 ? K_PA : (r == 1 ? K_PB : K_PC + (r - 2)); }
    else { r -= 8; layer = 2 * pair + 1; kind = K_PA + r; }
}
__host__ __device__ constexpr int phase_layer(int ph) { if (ph < 2) return 0; int r = ph - 2; const int pair = r / 18; r -= pair * 18; return r < 8 ? 2 * pair : 2 * pair + 1; }
__host__ __device__ constexpr int phase_kind(int ph) { if (ph < 2) return ph; int r = ph - 2; const int pair = r / 18; r -= pair * 18;
    if (r < 8) return r == 0 ? K_PA : (r == 1 ? K_PB : K_PC + (r - 2)); return K_PA + (r - 8); }
template <int PH>
__device__ __forceinline__ void run_phase(const Args& args, LAS unsigned char* lds) {
    constexpr int layer = phase_layer(PH), kind = phase_kind(PH), jj = layer >> 1; constexpr bool is_na = (layer & 1) == 0;
    int tid_ = threadIdx.x; asm volatile("" : "+v"(tid_));
    int bx_ = blockIdx.x; asm volatile("" : "+s"(bx_));
    Frame F;
    F.lds = lds;
    F.tid = tid_; F.lane = F.tid & 63; F.wave = __builtin_amdgcn_readfirstlane(F.tid >> 6);
    F.G = gridDim.x; F.bx = bx_; F.vcu = (F.G % 8 == 0) ? (bx_ % 8) * (F.G / 8) + bx_ / 8 : bx_;
    unsigned char* ws = args.ws; asm volatile("" : "+s"(ws)); F.ctl = (gu32*)(ws + WS_CTL);
    float* const outp = args.out;
#define IN_(k) (args.in[k])
        if constexpr (kind == K_P0) {
        P0Args a{IN_(0), IN_(1), IN_(2), IN_(3), IN_(5), IN_(10), IN_(19), IN_(20), IN_(21), IN_(15), IN_(17), IN_(11), IN_(12), IN_(16), IN_(18), ws};
        p0_prologue(F, a);
    }
    if constexpr (kind == K_P1) {
        { pg8::Gemm g{(const bf16*)(ws + WS_MEMB), (const bf16*)(ws + WS_WMEMKV), BATCH * NMEM, 256, D}; pg8::StaticOrder S; S.init(BATCH * NMEM, 256, F.G, F.bx);
          pg8::EpiProj E{(bf16*)(ws + WS_MEMK), 256, nullptr, 0};
          pg8::gemm_phase<pg8::EpiProj, pg8::StaticOrder, PG8_ALIGN, PG8_SP2>(F.lds, g, S, E); }
        { pg8::Gemm g{(const bf16*)(ws + WS_WMEMKV) + (size_t)256 * D, (const bf16*)(ws + WS_MEMB), 256, BATCH * NMEM, D}; pg8::StaticOrder S; S.init(256, BATCH * NMEM, F.G, (F.bx + 128) % F.G);
          pg8::EpiProj E{(bf16*)(ws + WS_MEMVT), BATCH * NMEM, nullptr, 0};
          pg8::gemm_phase<pg8::EpiProj, pg8::StaticOrder, PG8_ALIGN, PG8_SP2>(F.lds, g, S, E); }
    }
    if constexpr (kind == K_PA) {
        if constexpr (is_na) {
            const bf16* W = (const bf16*)(ws + WS_WINNA) + (size_t)jj * NA_IN * D;
            { pg8::Gemm g{(const bf16*)(ws + WS_XB), W, M, NA_LDP, D}; pg8::StaticOrder S; S.init(M, NA_LDP, F.G, F.bx);
              pg8::EpiProj E{(bf16*)(ws + WS_PROJ), NA_LDP, nullptr, 0};
              pg8::gemm_phase<pg8::EpiProj, pg8::StaticOrder, PG8_ALIGN, PG8_SP2>(F.lds, g, S, E); }
            { pg8::Gemm g{W + (size_t)NA_LDP * D, (const bf16*)(ws + WS_XB), TOKW, M, D}; pg8::StaticOrder S; S.init(TOKW, M, F.G, (F.bx + 128) % F.G);
              pg8::EpiProj E{(bf16*)(ws + WS_VT), M, nullptr, 0};
              pg8::gemm_phase<pg8::EpiProj, pg8::StaticOrder, PG8_ALIGN, PG8_SP2>(F.lds, g, S, E); }
        } else {
            const bf16* W = (const bf16*)(ws + WS_WINML) + (size_t)jj * ML_INP * D;
            { pg8::Gemm g{(const bf16*)(ws + WS_XB), W, M, ML_LDP, D}; pg8::StaticOrder S; S.init(M, ML_LDP, F.G, F.bx);
              pg8::EpiProj E{(bf16*)(ws + WS_PROJ), ML_LDP, (float*)(ws + WS_GATES), ML_GATE_PN};
              pg8::gemm_phase<pg8::EpiProj, pg8::StaticOrder, PG8_ALIGN, PG8_SP2>(F.lds, g, S, E); }
            { pg8::Gemm g{W + (size_t)ML_LDP * D, (const bf16*)(ws + WS_XB), TOKW, M, D}; pg8::StaticOrder S; S.init(TOKW, M, F.G, (F.bx + 128) % F.G);
              pg8::EpiProj E{(bf16*)(ws + WS_VTML), M, nullptr, 0};
              pg8::gemm_phase<pg8::EpiProj, pg8::StaticOrder, PG8_ALIGN, PG8_SP2>(F.lds, g, S, E); }
        }
    }
    if constexpr (kind == K_PB) {
        if constexpr (is_na) attn_lds_cv(F, (const bf16*)(ws + WS_PROJ), (const bf16*)(ws + WS_VT), (const bf16*)(ws + WS_MEMK), (const bf16*)(ws + WS_MEMVT), IN_(4) + (size_t)jj * NAH * 15 * 31, (bf16*)(ws + WS_MIXED),
                                         CvArgs{IN_(19), IN_(20), IN_(21), (bf16*)(ws + WS_W13), (bf16*)(ws + WS_W2), 32768 + jj * 32768});
        else { attn_lds<false>(F, (const bf16*)(ws + WS_PROJ), nullptr, (const bf16*)(ws + WS_MEMK), (const bf16*)(ws + WS_MEMVT), nullptr, (bf16*)(ws + WS_MIXED));
               ml_conv(F, (const bf16*)(ws + WS_PROJ), IN_(6) + (size_t)jj * 5 * 1536, IN_(7) + (size_t)jj * 1536, (bf16*)(ws + WS_QKC));
               ml_gate_prepass(F, (const float*)(ws + WS_GATES), IN_(8) + (size_t)jj * 16, (float*)(ws + WS_SCAL)); }
    }
    if constexpr (kind == K_PB2) {
        ml_scan_mfma(F, (const bf16*)(ws + WS_QKC), (const bf16*)(ws + WS_VTML), (const float*)(ws + WS_SCAL), (bf16*)(ws + WS_H));
    }
    if constexpr (kind == K_PB3) {
        ml_norm_gate(F, (const bf16*)(ws + WS_PROJ), (const bf16*)(ws + WS_H), IN_(9) + (size_t)jj * TOKW, (bf16*)(ws + WS_MIXED));
    }
    if constexpr (kind == K_PC) {
        pg8::Gemm g{(const bf16*)(ws + WS_MIXED), (const bf16*)(ws + WS_WOUT) + (size_t)layer * D * D, M, D, D}; pg8::StaticOrder S; S.init(M, D, F.G, F.bx);
        pg8::EpiResBf16 E{(const bf16*)(ws + WS_XB), (bf16*)(ws + WS_PRE), D, ALPHA};
        pg8::gemm_phase<pg8::EpiResBf16, pg8::StaticOrder, PG8_ALIGN, PG8_SP2>(F.lds, g, S, E);
    }
    if constexpr (kind == K_PD) {
        ln1_route(F, (const bf16*)(ws + WS_PRE), (const bf16*)(ws + WS_WR) + (size_t)layer * 2 * 48 * D, (const float*)(ws + WS_RGB) + layer * 96, (float*)(ws + WS_STATS),
                  (int*)(ws + WS_TOKE), (float*)(ws + WS_TOKG), (int*)(ws + WS_TOKP), (int*)(ws + WS_ROWSLOT),
                  F.ctl + CW_CNT + 64 * layer, (int*)(ws + WS_MISC) + 1024 + 32 * F.bx);
    }
    if constexpr (kind == K_PE) {
        moe_gather(F, (const bf16*)(ws + WS_PRE), (const float*)(ws + WS_STATS), IN_(11) + (size_t)layer * D, IN_(12) + (size_t)layer * D, (const int*)(ws + WS_TOKE), (const float*)(ws + WS_TOKG), (const int*)(ws + WS_TOKP), (int*)(ws + WS_ROWSLOT), (float*)(ws + WS_ROWGATE),
                   (bf16*)(ws + WS_XS), F.ctl + CW_CNT + 64 * layer, (int*)(ws + WS_MISC), (const int*)(ws + WS_MISC) + 1024 + 32 * F.bx);
    }
    if constexpr (kind == K_PF) {
        const int* TILETAB = (const int*)(ws + WS_MISC);
        const int nT = __builtin_amdgcn_readfirstlane((int)ld_agent(TILETAB));
        pg8::Gemm g{(const bf16*)(ws + WS_XS), (const bf16*)(ws + WS_W13) + (size_t)layer * NEXP * 1024 * 1024, nT * 256, 1024, D}; pg8::GroupedOrder S; S.init(nT, 1024, F.G, F.bx, TILETAB + 1);
        pg8::EpiSwiGLU E{(bf16*)(ws + WS_HID), DEXP};
        pg8::gemm_phase<pg8::EpiSwiGLU, pg8::GroupedOrder, PG8_ALIGN, PG8_SP2>(F.lds, g, S, E);
    }
    if constexpr (kind == K_PG) {
        const int* TILETAB = (const int*)(ws + WS_MISC);
        const int nT = __builtin_amdgcn_readfirstlane((int)ld_agent(TILETAB));
        pg8::Gemm g{(const bf16*)(ws + WS_HID), (const bf16*)(ws + WS_W2) + (size_t)layer * NEXP * 1024 * 512, nT * 256, 1024, DEXP}; pg8::GroupedOrder S; S.init(nT, 1024, F.G, F.bx, TILETAB + 1);
        pg8::EpiMoeDown E{(bf16*)(ws + WS_Y), D, (const int*)(ws + WS_ROWSLOT), (const float*)(ws + WS_ROWGATE)};
        pg8::gemm_phase<pg8::EpiMoeDown, pg8::GroupedOrder, PG8_ALIGN, PG8_SP2>(F.lds, g, S, E);
    }
    if constexpr (kind == K_PH) {
        ln2_pass(F, (const bf16*)(ws + WS_PRE), (const float*)(ws + WS_STATS), IN_(11) + (size_t)layer * D, IN_(12) + (size_t)layer * D, (const bf16*)(ws + WS_Y), IN_(13) + (size_t)layer * D, IN_(14) + (size_t)layer * D, layer == DEPTH - 1 ? outp : nullptr, (bf16*)(ws + WS_XB));
    }
}
#ifndef MK_PROBE_MASK
#define MK_PROBE_MASK 0ull
#endif
#define MK_PROBE_AMP 10ull
template <int PH>
__device__ __forceinline__ void run_all(const Args& args, LAS unsigned char* lds, int lo, int hi, const XcdBarrier& bar, unsigned long long& tacc) {
    if constexpr (PH < N_PHASES) {
        if (lo <= PH && PH < hi) {
            unsigned long long t0 = 0;
            if constexpr (((MK_PROBE_MASK >> PH) & 1ull) != 0ull) t0 = __builtin_amdgcn_s_memrealtime();
            run_phase<PH>(args, lds); if (PH + 1 < hi) xcd_barrier(bar);
            if constexpr (((MK_PROBE_MASK >> PH) & 1ull) != 0ull) tacc += __builtin_amdgcn_s_memrealtime() - t0;
        }
        run_all<PH + 1>(args, lds, lo, hi, bar, tacc);
    }
}
__global__ void __launch_bounds__(NTHREADS, 2) mk_fwd(Args args) {
    extern __shared__ __attribute__((aligned(16))) unsigned char lds[];
    for (int u = threadIdx.x; u < LDSCTL_BYTES / 4; u += NTHREADS) ((LAS unsigned*)((LAS unsigned char*)lds + LDSCTL_OFF))[u] = 0u;
    __syncthreads();
    const int lo = args.ph_lo, hi = args.ph_hi;
    XcdBarrier bar; bar.bar = (unsigned*)((gu32*)(args.ws + WS_CTL) + CW_BAR); bar.x = 0; bar.st = nullptr;
    if (hi - lo > 1) bar = xcd_barrier_post((unsigned*)((gu32*)(args.ws + WS_CTL) + CW_BAR), (volatile LAS unsigned*)((LAS unsigned char*)lds + L_MISC) + 8);
    unsigned long long tacc = 0;
    run_all<0>(args, (LAS unsigned char*)lds, lo, hi, bar, tacc);
    if ((MK_PROBE_MASK != 0ull || MK_SUBPROBE != 0) && blockIdx.x == 0 && threadIdx.x == 0) {
        if (MK_SUBPROBE != 0) tacc += *(LAS unsigned long long*)((LAS unsigned char*)lds + L_PROBE);
        const unsigned long long t_end = __builtin_amdgcn_s_memrealtime() + MK_PROBE_AMP * tacc;
        while (__builtin_amdgcn_s_memrealtime() < t_end) __builtin_amdgcn_s_sleep(32);
    }
}

#ifndef MK_PER_PHASE
#define MK_PER_PHASE 0
#endif
extern "C" void kernel_launch(void* const* d_in, const int* in_sizes, int n_in, void* d_out, int out_size, void* d_ws, size_t ws_size, hipStream_t stream) {
    static int grid = 0;
    if (grid == 0) {
        if (n_in != 22 || in_sizes[0] != M * D || out_size != M * D || ws_size < WS_END) { fprintf(stderr, "kernel_launch: unexpected shapes (n_in %d, in0 %d, out %d, ws %zu; need ws >= %zu); nothing launched\n", n_in, n_in > 0 ? in_sizes[0] : -1, out_size, ws_size, (size_t)WS_END); grid = -1; return; }
        int dev = 0, cus = 0, per_cu = 0;
        if (hipGetDevice(&dev) != hipSuccess || hipDeviceGetAttribute(&cus, hipDeviceAttributeMultiprocessorCount, dev) != hipSuccess) { fprintf(stderr, "kernel_launch: device query failed\n"); grid = -1; return; }
        if (hipFuncSetAttribute((const void*)mk_fwd, hipFuncAttributeMaxDynamicSharedMemorySize, LDS_BYTES) != hipSuccess) { fprintf(stderr, "kernel_launch: hipFuncSetAttribute failed\n"); grid = -1; return; }
        if (hipOccupancyMaxActiveBlocksPerMultiprocessor(&per_cu, (const void*)mk_fwd, NTHREADS, LDS_BYTES) != hipSuccess || per_cu < 1)
            fprintf(stderr, "kernel_launch: note: occupancy query reports %d workgroups per CU\n", per_cu);
        (void)hipGetLastError();
        grid = cus;
    }
    if (grid < 0) return;
    if (hipMemsetAsync((char*)d_ws + WS_CTL, 0, CTL_ZERO_BYTES, stream) != hipSuccess) { fprintf(stderr, "kernel_launch: memset failed\n"); return; }
    Args a{};
    for (int i = 0; i < 22; ++i) a.in[i] = (const float*)d_in[i];
    a.out = (float*)d_out; a.ws = (unsigned char*)d_ws;
#if MK_PER_PHASE
    for (int p = 0; p < N_PHASES; ++p) { a.ph_lo = p; a.ph_hi = p + 1; hipLaunchKernelGGL(mk_fwd, dim3(grid), dim3(NTHREADS), LDS_BYTES, stream, a); }
#else
    a.ph_lo = 0; a.ph_hi = N_PHASES;
    hipLaunchKernelGGL(mk_fwd, dim3(grid), dim3(NTHREADS), LDS_BYTES, stream, a);
#endif
    const hipError_t le = hipPeekAtLastError();
    if (le != hipSuccess) fprintf(stderr, "kernel_launch: launch failed: %s (grid %d)\n", hipGetErrorName(le), grid);
}
```

```cpp
#include <hip/hip_runtime.h>
#include <cstdio>
#include <cstdint>
#ifndef MK_SUBPROBE
#define MK_SUBPROBE 0
#endif
namespace pg8 {
#define PG8_LAS __attribute__((address_space(3)))
typedef unsigned short bf16_t;
typedef short bf16x8 __attribute__((ext_vector_type(8)));
typedef float f32x4 __attribute__((ext_vector_type(4)));
typedef unsigned u32x4 __attribute__((ext_vector_type(4)));
typedef unsigned u32x2 __attribute__((ext_vector_type(2)));
constexpr int BM = 256, BK = 64, HALF = 128, HTB = HALF * BK * 2  , STAGE_BYTES = 8 * HTB, NXCD = 8, WGM = 8;

__host__ __device__ __forceinline__ int lds_byte(int r, int c) { const int st = (r >> 4) * 2 + (c >> 5), rr = r & 15, cc = c & 31, ob = rr * 64 + cc * 2; return st * 1024 + (ob ^ (((ob >> 9) & 1) << 5)); }
__host__ __device__ __forceinline__ void stage_rc(int b, int& R, int& C) { const int st = b / 1024, sb = b % 1024, swz = sb ^ (((sb >> 9) & 1) << 5); R = (st >> 1) * 16 + swz / 64; C = (st & 1) * 32 + (swz % 64) / 2; }
__host__ __device__ __forceinline__ int perm32(int rho) { const int n = rho >> 4, i = rho & 15; return 8 * (i >> 2) + 4 * n + (i & 3); }

struct Unit { int pm, pn, brow; };
struct Gemm { const bf16_t* A; const bf16_t* Bt; int M, N, K; };

struct StaticOrder {
    int nM, nN, nwg, G, c;
    __host__ __device__ void init(int M, int N, int G_, int c_) { nM = M / BM; nN = N / BM; nwg = nM * nN; G = G_; c = c_; }
    __host__ __device__ bool next(int i, Unit& u) const {
        const long L = (long)i * G + c; if (L >= nwg) return false;
        int wgid = (int)L; { const int q = nwg / NXCD, r = nwg % NXCD, xcd = wgid % NXCD, off = wgid / NXCD; wgid = (xcd < r ? xcd * (q + 1) : r * (q + 1) + (xcd - r) * q) + off; }
        const int nig = WGM * nN, gid = wgid / nig, fm = gid * WGM, gsz = (nM - fm) < WGM ? (nM - fm) : WGM;
        u.pm = fm + ((wgid % nig) % gsz); u.pn = (wgid % nig) / gsz; u.brow = u.pn * BM; return true;
    }
    __device__ __forceinline__ void a_ready(const Unit&) const {}
    __device__ __forceinline__ void done(const Unit&) const {}
};
struct GroupedOrder {
    int nM, nN, nwg, G, c; const int* tile_exp;
    __device__ void init(int nT, int N, int G_, int c_, const int* te) { nM = nT; nN = N / BM; nwg = nM * nN; G = G_; c = c_; tile_exp = te; }
    __device__ bool next(int i, Unit& u) const {
        const long L = (long)i * G + c; if (L >= nwg) return false;
        int wgid = (int)L; { const int q = nwg / NXCD, r = nwg % NXCD, xcd = wgid % NXCD, off = wgid / NXCD; wgid = (xcd < r ? xcd * (q + 1) : r * (q + 1) + (xcd - r) * q) + off; }
        const int nig = WGM * nN, gid = wgid / nig, fm = gid * WGM, gsz = (nM - fm) < WGM ? (nM - fm) : WGM;
        u.pm = fm + ((wgid % nig) % gsz); u.pn = (wgid % nig) / gsz;
        const int e = __builtin_amdgcn_readfirstlane((int)__hip_atomic_load((const unsigned*)tile_exp + u.pm, __ATOMIC_RELAXED, __HIP_MEMORY_SCOPE_AGENT));
        u.brow = e * (nN * BM) + u.pn * BM; return true;
    }
    __device__ __forceinline__ void a_ready(const Unit&) const {}
    __device__ __forceinline__ void done(const Unit&) const {}
};

__device__ __forceinline__ unsigned cvt_pk_bf16(float lo, float hi) { unsigned r; asm volatile("v_cvt_pk_bf16_f32 %0, %1, %2" : "=v"(r) : "v"(lo), "v"(hi)); return r; }

struct EpiProj {
    static constexpr bool PERM = true, AFTER_DRAIN = false;
    bf16_t* O; int ldc; float* gates; int gate_pn;
    __device__ __forceinline__ void operator()(const f32x4 (&acc)[2][2][4][2], const Unit& u, int wr, int wc, int fr, int fq) const {
        const int row0 = u.pm * BM + wr * 64 + fr, col0 = u.pn * BM + wc * 32 + 8 * fq;
#pragma unroll
        for (int ai = 0; ai < 2; ++ai)
#pragma unroll
            for (int m = 0; m < 4; ++m) { bf16_t* rowp = O + (size_t)(row0 + ai * HALF + m * 16) * ldc + col0;
#pragma unroll
                for (int bj = 0; bj < 2; ++bj) { const f32x4 v0 = acc[ai][bj][m][0], v1 = acc[ai][bj][m][1];
                    u32x4 w; w.x = cvt_pk_bf16(v0[0], v0[1]); w.y = cvt_pk_bf16(v0[2], v0[3]); w.z = cvt_pk_bf16(v1[0], v1[1]); w.w = cvt_pk_bf16(v1[2], v1[3]);
                    *(u32x4*)(rowp + bj * HALF) = w; } }
        if (gates != nullptr && u.pn == gate_pn && wc == 0 && fq < 2) {
#pragma unroll
            for (int ai = 0; ai < 2; ++ai)
#pragma unroll
                for (int m = 0; m < 4; ++m) { float* gp = gates + (size_t)(row0 + ai * HALF + m * 16) * 16 + 8 * fq;
                    *(f32x4*)gp = acc[ai][0][m][0]; *(f32x4*)(gp + 4) = acc[ai][0][m][1]; }
        }
    }
};
struct EpiF32 {
    static constexpr bool PERM = false, AFTER_DRAIN = false;
    float* C; int ldc;
    __device__ __forceinline__ void operator()(const f32x4 (&acc)[2][2][4][2], const Unit& u, int wr, int wc, int fr, int fq) const {
        const int row0 = u.pm * BM + wr * 64 + fr, col0 = u.pn * BM + wc * 32 + 4 * fq;
#pragma unroll
        for (int ai = 0; ai < 2; ++ai)
#pragma unroll
            for (int m = 0; m < 4; ++m) { float* rowp = C + (size_t)(row0 + ai * HALF + m * 16) * ldc + col0;
#pragma unroll
                for (int bj = 0; bj < 2; ++bj)
#pragma unroll
                    for (int n = 0; n < 2; ++n) *(f32x4*)(rowp + bj * HALF + n * 16) = acc[ai][bj][m][n]; }
    }
};
struct EpiResBf16 {
    static constexpr bool PERM = true, AFTER_DRAIN = false;
    const bf16_t* base; bf16_t* out; int ldc; float alpha;
    __device__ __forceinline__ void operator()(const f32x4 (&acc)[2][2][4][2], const Unit& u, int wr, int wc, int fr, int fq) const {
        const int row0 = u.pm * BM + wr * 64 + fr, col0 = u.pn * BM + wc * 32 + 8 * fq;
#pragma unroll
        for (int ai = 0; ai < 2; ++ai) {
            u32x4 bwv[4][2];
#pragma unroll
            for (int m = 0; m < 4; ++m)
#pragma unroll
                for (int bj = 0; bj < 2; ++bj) bwv[m][bj] = *(const u32x4*)(base + (size_t)(row0 + ai * HALF + m * 16) * ldc + col0 + bj * HALF);
            __builtin_amdgcn_sched_barrier(0);
#pragma unroll
            for (int m = 0; m < 4; ++m) { const size_t off = (size_t)(row0 + ai * HALF + m * 16) * ldc + col0;
#pragma unroll
                for (int bj = 0; bj < 2; ++bj) { const u32x4 bw = bwv[m][bj];
                    const f32x4 b0 = {__uint_as_float(bw.x << 16), __uint_as_float(bw.x & 0xffff0000u), __uint_as_float(bw.y << 16), __uint_as_float(bw.y & 0xffff0000u)};
                    const f32x4 b1 = {__uint_as_float(bw.z << 16), __uint_as_float(bw.z & 0xffff0000u), __uint_as_float(bw.w << 16), __uint_as_float(bw.w & 0xffff0000u)};
                    const f32x4 v0 = b0 * alpha + acc[ai][bj][m][0], v1 = b1 * alpha + acc[ai][bj][m][1];
                    u32x4 w; w.x = cvt_pk_bf16(v0[0], v0[1]); w.y = cvt_pk_bf16(v0[2], v0[3]); w.z = cvt_pk_bf16(v1[0], v1[1]); w.w = cvt_pk_bf16(v1[2], v1[3]);
                    *(u32x4*)(out + off + bj * HALF) = w; } }
            __builtin_amdgcn_sched_barrier(0);
        }
    }
};
struct EpiSwiGLU {
    static constexpr bool PERM = false, AFTER_DRAIN = false;
    bf16_t* H; int ldh;
    __device__ __forceinline__ void operator()(const f32x4 (&acc)[2][2][4][2], const Unit& u, int wr, int wc, int fr, int fq) const {
        const int row0 = u.pm * BM + wr * 64 + fr, col0 = u.pn * HALF + wc * 16 + 4 * fq;
#pragma unroll
        for (int ai = 0; ai < 2; ++ai)
#pragma unroll
            for (int m = 0; m < 4; ++m) { bf16_t* rowp = H + (size_t)(row0 + ai * HALF + m * 16) * ldh + col0;
#pragma unroll
                for (int bj = 0; bj < 2; ++bj) { const f32x4 a = acc[ai][bj][m][0], b = acc[ai][bj][m][1]; float h[4];
#pragma unroll
                    for (int j = 0; j < 4; ++j) h[j] = a[j] / (1.0f + __expf(-a[j])) * b[j];
                    u32x2 w; w.x = cvt_pk_bf16(h[0], h[1]); w.y = cvt_pk_bf16(h[2], h[3]);
                    *(u32x2*)(rowp + bj * 64) = w; } }
    }
};
struct EpiMoeDown {
    static constexpr bool PERM = true, AFTER_DRAIN = false;
    bf16_t* Y; int ldc; const int* row_slot; const float* row_gate;
    __device__ __forceinline__ void operator()(const f32x4 (&acc)[2][2][4][2], const Unit& u, int wr, int wc, int fr, int fq) const {
        const int row0 = u.pm * BM + wr * 64 + fr, col0 = u.pn * BM + wc * 32 + 8 * fq;
        int slot[2][4]; float gt[2][4];
#pragma unroll
        for (int ai = 0; ai < 2; ++ai)
#pragma unroll
            for (int m = 0; m < 4; ++m) { const int row = row0 + ai * HALF + m * 16;
                slot[ai][m] = (int)__hip_atomic_load((const unsigned*)row_slot + row, __ATOMIC_RELAXED, __HIP_MEMORY_SCOPE_AGENT);
                gt[ai][m] = __uint_as_float(__hip_atomic_load((const unsigned*)row_gate + row, __ATOMIC_RELAXED, __HIP_MEMORY_SCOPE_AGENT)); }
        __builtin_amdgcn_sched_barrier(0);
#pragma unroll
        for (int ai = 0; ai < 2; ++ai)
#pragma unroll
            for (int m = 0; m < 4; ++m) {
                if (slot[ai][m] >= 0) { bf16_t* rowp = Y + (size_t)slot[ai][m] * ldc + col0; const float g = gt[ai][m];
#pragma unroll
                    for (int bj = 0; bj < 2; ++bj) { const f32x4 v0 = acc[ai][bj][m][0] * g, v1 = acc[ai][bj][m][1] * g;
                        u32x4 w; w.x = cvt_pk_bf16(v0[0], v0[1]); w.y = cvt_pk_bf16(v0[2], v0[3]); w.z = cvt_pk_bf16(v1[0], v1[1]); w.w = cvt_pk_bf16(v1[2], v1[3]);
                        *(u32x4*)(rowp + bj * HALF) = w; } } }
    }
};

template <class Epi, class Sched, bool ALIGN_EPI = false, bool SP2 = false>
__device__ __forceinline__ void gemm_phase(PG8_LAS unsigned char* lds, const Gemm g, const Sched& S, const Epi& E) {
    int tid_l = threadIdx.x; asm volatile("" : "+v"(tid_l));
    const int tid = tid_l, wid = __builtin_amdgcn_readfirstlane(tid >> 6), lane = tid & 63, wr = wid >> 2, wc = wid & 3, fr = lane & 15, fq = lane >> 4;
    const int K = g.K, nt = K / BK;
    unsigned voffA[2], voffB[2];
#pragma unroll
    for (int i = 0; i < 2; ++i) { int R, C; stage_rc(tid * 16 + i * 8192, R, C); const int Rb = Epi::PERM ? ((R & ~31) + perm32(R & 31)) : R;
        voffA[i] = (unsigned)(R * K + C) * 2u; voffB[i] = (unsigned)(Rb * K + C) * 2u; }
    const size_t kstep = (size_t)(BK * 2);
    const size_t hstep = (size_t)HALF * K * 2;
    const size_t tstep = 2 * hstep;
    const unsigned ldsw = (unsigned)wid * 1024u;
    const int aoff = lds_byte(wr * 64 + fr, fq * 8), boff = lds_byte(wc * 32 + fr, fq * 8);
#define PG8_SA(b, h) (((b) * 2 + (h)) * HTB)
#define PG8_SB(b, h) ((4 + (b) * 2 + (h)) * HTB)
#define PG8_STAGE(bufoff, gbase, voff) do { _Pragma("unroll") for (int _i = 0; _i < 2; ++_i) \
        __builtin_amdgcn_global_load_lds((const unsigned*)((const char*)(gbase) + (voff)[_i]), (PG8_LAS unsigned*)(lds + (bufoff) + ldsw + _i * 8192), 16, 0, 0); } while (0)
#define PG8_LDA(dst, b, h) do { _Pragma("unroll") for (int m = 0; m < 4; ++m) _Pragma("unroll") for (int k = 0; k < 2; ++k) dst[m][k] = *(const PG8_LAS bf16x8*)(lds + PG8_SA(b, h) + aoff + m * 2048 + k * 1024); } while (0)
#define PG8_LDB(dst, b, h) do { _Pragma("unroll") for (int n = 0; n < 2; ++n) _Pragma("unroll") for (int k = 0; k < 2; ++k) dst[n][k] = *(const PG8_LAS bf16x8*)(lds + PG8_SB(b, h) + boff + n * 2048 + k * 1024); } while (0)
#define PG8_MMA(ai, bj, At, Bt) do { __builtin_amdgcn_s_setprio(1); _Pragma("unroll") for (int m = 0; m < 4; ++m) _Pragma("unroll") for (int n = 0; n < 2; ++n) _Pragma("unroll") for (int k = 0; k < 2; ++k) \
        acc[ai][bj][m][n] = __builtin_amdgcn_mfma_f32_16x16x32_bf16(Bt[n][k], At[m][k], acc[ai][bj][m][n], 0, 0, 0); __builtin_amdgcn_s_setprio(0); } while (0)
#define PG8_WAIT_V(n) asm volatile("s_waitcnt vmcnt(" #n ")" ::: "memory")
#define PG8_WAIT_L(n) asm volatile("s_waitcnt lgkmcnt(" #n ")" ::: "memory")
#define PG8_BAR __builtin_amdgcn_s_barrier()
#define PG8_SCHED __builtin_amdgcn_sched_barrier(0)
    Unit cur, nxt; int ui = 0;
    if (!S.next(0, cur)) return;
    f32x4 acc[2][2][4][2];
#pragma unroll
    for (int a = 0; a < 2; ++a)
#pragma unroll
        for (int b = 0; b < 2; ++b)
#pragma unroll
            for (int m = 0; m < 4; ++m)
#pragma unroll
                for (int n = 0; n < 2; ++n) acc[a][b][m][n] = (f32x4){0.f, 0.f, 0.f, 0.f};
    bf16x8 At[4][2], B0[2][2], B1[2][2];
    const char* cA = (const char*)g.A + (size_t)cur.pm * tstep; const char* cB = (const char*)g.Bt + (size_t)cur.brow * (size_t)K * 2;
    S.a_ready(cur);
    if constexpr (SP2) {
        PG8_STAGE(PG8_SB(0, 0), cB, voffB); PG8_STAGE(PG8_SB(0, 1), cB + hstep, voffB); PG8_STAGE(PG8_SA(0, 0), cA, voffA); PG8_STAGE(PG8_SA(0, 1), cA + hstep, voffA);
        if (wr == 1) PG8_BAR;
        PG8_WAIT_V(2); PG8_BAR;
        PG8_STAGE(PG8_SB(1, 0), cB + kstep, voffB); PG8_STAGE(PG8_SA(1, 0), cA + kstep, voffA); PG8_STAGE(PG8_SB(1, 1), cB + hstep + kstep, voffB);
        PG8_WAIT_V(6); PG8_BAR;
    } else {
        PG8_STAGE(PG8_SB(0, 0), cB, voffB); PG8_STAGE(PG8_SA(0, 0), cA, voffA); PG8_STAGE(PG8_SB(0, 1), cB + hstep, voffB); PG8_STAGE(PG8_SA(0, 1), cA + hstep, voffA);
        if (wr == 1) PG8_BAR;
        PG8_WAIT_V(4); PG8_BAR;
        PG8_STAGE(PG8_SB(1, 0), cB + kstep, voffB); PG8_STAGE(PG8_SA(1, 0), cA + kstep, voffA); PG8_STAGE(PG8_SB(1, 1), cB + hstep + kstep, voffB);
        PG8_WAIT_V(6); PG8_BAR;
    }
    for (;;) {
        const bool has_next = S.next(ui + 1, nxt);
        const char* nA = has_next ? (const char*)g.A + (size_t)nxt.pm * tstep : cA; const char* nB = has_next ? (const char*)g.Bt + (size_t)nxt.brow * (size_t)K * 2 : cB;
        for (int t = 0; t < nt; t += 2) {
            const bool last = (t == nt - 2);
            const char* a1 = cA + (size_t)(t + 1) * kstep;
            const char* a2 = last ? nA : cA + (size_t)(t + 2) * kstep; const char* b2 = last ? nB : cB + (size_t)(t + 2) * kstep;
            const char* a3 = a2 + kstep; const char* b3 = b2 + kstep;
            if (last && has_next) S.a_ready(nxt);
            if constexpr (SP2) {
            PG8_LDB(B0, 0, 0); PG8_LDB(B1, 0, 1); PG8_SCHED; PG8_LDA(At, 0, 0); PG8_STAGE(PG8_SA(1, 1), a1 + hstep, voffA);
            PG8_WAIT_V(8); PG8_WAIT_L(0); PG8_BAR; PG8_MMA(0, 0, At, B0); PG8_MMA(0, 1, At, B1); PG8_BAR; PG8_SCHED;
            PG8_LDA(At, 0, 1); PG8_STAGE(PG8_SB(0, 0), b2, voffB); PG8_STAGE(PG8_SB(0, 1), b2 + hstep, voffB); PG8_STAGE(PG8_SA(0, 0), a2, voffA);
            PG8_WAIT_V(8); PG8_WAIT_L(0); PG8_BAR; PG8_MMA(1, 0, At, B0); PG8_MMA(1, 1, At, B1); PG8_BAR; PG8_SCHED;
            PG8_LDB(B0, 1, 0); PG8_LDB(B1, 1, 1); PG8_SCHED; PG8_LDA(At, 1, 0); PG8_STAGE(PG8_SA(0, 1), a2 + hstep, voffA);
            PG8_WAIT_V(8); PG8_WAIT_L(0); PG8_BAR; PG8_MMA(0, 0, At, B0); PG8_MMA(0, 1, At, B1); PG8_BAR; PG8_SCHED;
            PG8_LDA(At, 1, 1); PG8_STAGE(PG8_SB(1, 0), b3, voffB); PG8_STAGE(PG8_SB(1, 1), b3 + hstep, voffB); PG8_STAGE(PG8_SA(1, 0), a3, voffA);
            PG8_WAIT_V(8); PG8_WAIT_L(0); PG8_BAR; PG8_MMA(1, 0, At, B0); PG8_MMA(1, 1, At, B1); PG8_BAR; PG8_SCHED;
            } else {
            PG8_LDB(B0, 0, 0); PG8_SCHED; PG8_LDA(At, 0, 0); PG8_STAGE(PG8_SA(1, 1), a1 + hstep, voffA);
            PG8_WAIT_L(8); PG8_BAR; PG8_WAIT_L(0); PG8_MMA(0, 0, At, B0); PG8_BAR; PG8_SCHED;
            PG8_LDB(B1, 0, 1); PG8_STAGE(PG8_SB(0, 0), b2, voffB);
            PG8_BAR; PG8_WAIT_L(0); PG8_MMA(0, 1, At, B1); PG8_BAR;
            PG8_LDA(At, 0, 1); PG8_STAGE(PG8_SA(0, 0), a2, voffA);
            PG8_BAR; PG8_WAIT_L(0); PG8_MMA(1, 0, At, B0); PG8_BAR; PG8_SCHED;
            PG8_STAGE(PG8_SB(0, 1), b2 + hstep, voffB);
            PG8_WAIT_V(6); PG8_BAR; PG8_MMA(1, 1, At, B1); PG8_BAR;
            PG8_LDB(B0, 1, 0); PG8_SCHED; PG8_LDA(At, 1, 0); PG8_STAGE(PG8_SA(0, 1), a2 + hstep, voffA);
            PG8_WAIT_L(8); PG8_BAR; PG8_WAIT_L(0); PG8_MMA(0, 0, At, B0); PG8_BAR; PG8_SCHED;
            PG8_LDB(B1, 1, 1); PG8_STAGE(PG8_SB(1, 0), b3, voffB);
            PG8_BAR; PG8_WAIT_L(0); PG8_MMA(0, 1, At, B1); PG8_BAR;
            PG8_LDA(At, 1, 1); PG8_STAGE(PG8_SA(1, 0), a3, voffA);
            PG8_BAR; PG8_WAIT_L(0); PG8_MMA(1, 0, At, B0); PG8_BAR; PG8_SCHED;
            PG8_STAGE(PG8_SB(1, 1), b3 + hstep, voffB);
            PG8_WAIT_V(6); PG8_BAR; PG8_MMA(1, 1, At, B1); PG8_BAR;
            }
        }
        if constexpr (ALIGN_EPI) { if (wr == 0) PG8_BAR; }
        if constexpr (!Epi::AFTER_DRAIN) { E(acc, cur, wr, wc, fr, fq); S.done(cur); }
        if (!has_next) break;
#pragma unroll
        for (int a = 0; a < 2; ++a)
#pragma unroll
            for (int b = 0; b < 2; ++b)
#pragma unroll
                for (int m = 0; m < 4; ++m)
#pragma unroll
                    for (int n = 0; n < 2; ++n) acc[a][b][m][n] = (f32x4){0.f, 0.f, 0.f, 0.f};
        cur = nxt; cA = nA; cB = nB; ++ui;
        if constexpr (ALIGN_EPI) { if (wr == 1) PG8_BAR; }
    }
    PG8_WAIT_V(0);
    if constexpr (!ALIGN_EPI) { if (wr == 0) PG8_BAR; }
    PG8_BAR;
    if constexpr (Epi::AFTER_DRAIN) { E.fused(acc, cur, wr, wc, fr, fq, lds, wid, lane); S.done(cur); }
#undef PG8_SA
#undef PG8_SB
#undef PG8_STAGE
#undef PG8_LDA
#undef PG8_LDB
#undef PG8_MMA
#undef PG8_WAIT_V
#undef PG8_WAIT_L
#undef PG8_BAR
#undef PG8_SCHED
}
}
#ifndef PG8_SP2
#define PG8_SP2 true
#endif
#ifndef PG8_ALIGN
#define PG8_ALIGN true
#endif

constexpr int NWAVES = 8, NTHREADS = NWAVES * 64;
constexpr int BATCH = 8, SEQ = 4096, D = 1024, M = BATCH * SEQ, DEPTH = 4;
constexpr int NMEM = 256, TOKW = 768, MEMW = 256, MEMH = 4, NAH = 12, MLH = 4, MLDH = 192;
constexpr int NA_IN = 2560, NA_LDP = 1792  , ML_IN = 3344, ML_INP = 3584, ML_LDP = 2816  , ML_GATE_PN = 10;
constexpr int NEXP = 32, EPG = 8, NGRP = 4, DEXP = 512;
constexpr int P_MAX = 288 * 256;
constexpr float LN_EPS = 1e-5f;
constexpr float ALPHA = 1.6817928305074290f;

constexpr size_t MiB = 1u << 20;
constexpr size_t WS_CTL = 0, CTL_ZERO_BYTES = 1 * MiB;
constexpr size_t WS_MISC = 1 * MiB;
constexpr size_t WS_RGB = WS_MISC + 128 * 1024;
constexpr size_t WS_STATS = 47 * MiB;
constexpr size_t WS_WR = WS_MISC + 256 * 1024;
constexpr size_t WS_WINNA = 2 * MiB, WS_WINML = 12 * MiB, WS_WOUT = 26 * MiB, WS_WMEMKV = 34 * MiB, WS_MEMB = 35 * MiB, WS_MEMKV = 39 * MiB, WS_GATES = 43 * MiB;
constexpr size_t WS_TOKE = 45 * MiB, WS_TOKG = WS_TOKE + 262144, WS_TOKP = WS_TOKG + 262144, WS_ROWSLOT = WS_TOKP + 262144, WS_ROWGATE = WS_ROWSLOT + 294912;
static_assert(WS_ROWGATE + 294912 <= 48 * MiB, "ws map");
constexpr size_t WS_W13 = 48 * MiB, WS_W2 = 304 * MiB, WS_PRE = 432 * MiB, WS_XB = 560 * MiB, WS_PROJ = 624 * MiB, WS_MIXED = 848 * MiB, WS_H = 912 * MiB, WS_END = 1012 * MiB;
constexpr size_t WS_VT = WS_PROJ + 112 * MiB;
constexpr size_t WS_VTML = WS_PROJ + 176 * MiB;
constexpr size_t WS_MEMK = WS_MEMKV, WS_MEMVT = WS_MEMKV + 2 * MiB;
constexpr size_t WS_SCAL = 1008 * MiB;
constexpr size_t WS_QKC = WS_PRE;
constexpr size_t WS_Y = WS_PROJ, WS_HID = WS_PROJ + 128 * MiB;
constexpr size_t WS_XS = WS_MIXED;
static_assert(WS_HID + (size_t)P_MAX * DEXP * 2 <= WS_MIXED && WS_XS + (size_t)P_MAX * D * 2 <= 1008 * MiB && WS_PROJ + (size_t)M * ML_INP * 2 <= WS_MIXED, "ws map");
static_assert(WS_H + (size_t)2 * M * TOKW * 2 <= 1008 * MiB && WS_QKC + (size_t)M * 1536 * 2 <= WS_XB, "ws map");
constexpr int CW_BAR = 4096;
constexpr int CW_CNT = 16384;
constexpr int RING_BYTES = 131072, LDSCTL_OFF = RING_BYTES, LDSCTL_BYTES = 32768, LDS_BYTES = RING_BYTES + LDSCTL_BYTES;
constexpr int L_PROBE = LDSCTL_OFF + 2048;
constexpr int L_MISC = LDSCTL_OFF + 320, L_HIST = LDSCTL_OFF + 512, L_WGBASE = LDSCTL_OFF + 768, L_PADSTART = LDSCTL_OFF + 1024, L_CNT = LDSCTL_OFF + 1280;

#define GAS __attribute__((address_space(1)))
#define LAS __attribute__((address_space(3)))
typedef unsigned short bf16;
typedef unsigned v4u __attribute__((ext_vector_type(4)));
typedef unsigned u32x4 __attribute__((ext_vector_type(4)));
typedef float f32x4 __attribute__((ext_vector_type(4)));
typedef short bf16x8 __attribute__((ext_vector_type(8)));
typedef GAS unsigned gu32;
typedef GAS unsigned long long gu64;
#define RLX_AGENT __ATOMIC_RELAXED, __HIP_MEMORY_SCOPE_AGENT
#define LDS_WAIT() asm volatile("s_waitcnt lgkmcnt(0)" ::: "memory")
#define VM_WAIT() asm volatile("s_waitcnt vmcnt(0)" ::: "memory")
__device__ __forceinline__ unsigned long long rt() { return __builtin_amdgcn_s_memrealtime(); }
__device__ __forceinline__ unsigned pk2(float lo, float hi) { unsigned r; asm("v_cvt_pk_bf16_f32 %0, %1, %2" : "=v"(r) : "v"(lo), "v"(hi)); return r; }
__device__ __forceinline__ unsigned f2bf(float f) { return pk2(f, 0.f) & 0xffffu; }

#define XB_TMO      128
#define XB_XCNT(j)  (256  + 64 * (j))
#define XB_XSUB(j)  (1280 + 64 * (j))
#define XB_XGEN(j)  (2304 + 64 * (j))
#define XB_TOP      3328
#define XB_TOPGEN   3392
#define XCD_BAR_WORDS 3456
#define XB_SPIN_CAP (1u << 24)

__device__ __forceinline__ unsigned xb_ld(unsigned* p)              { return __hip_atomic_load(p, __ATOMIC_RELAXED, __HIP_MEMORY_SCOPE_AGENT); }
__device__ __forceinline__ unsigned xb_add(unsigned* p, unsigned v) { return __hip_atomic_fetch_add(p, v, __ATOMIC_RELAXED, __HIP_MEMORY_SCOPE_AGENT); }
__device__ __forceinline__ unsigned xb_xcc_id() { return (unsigned)__builtin_amdgcn_s_getreg((3 << 11) | 20) & 0xFu; }
#define XB_SPIN(cond, bar) do { unsigned _sp = 0; while (cond) { __builtin_amdgcn_s_sleep(1); \
    if ((++_sp & 255u) == 0u) { if (xb_ld(&(bar)[XB_TMO])) break; if (_sp > XB_SPIN_CAP) { atomicAdd(&(bar)[XB_TMO], 1u); break; } } } } while (0)

struct XcdBarrier {
    unsigned* bar; unsigned x;
    volatile LAS unsigned* st;
};

__device__ __forceinline__ XcdBarrier xcd_barrier_post(unsigned* bar, volatile LAS unsigned* st) {
    XcdBarrier b; b.bar = bar; b.x = xb_xcc_id(); b.st = st;
    if (threadIdx.x == 0) (void)xb_add(&bar[XB_XCNT(b.x)], 1u);
    return b;
}
__device__ __forceinline__ void xcd_barrier_complete(unsigned* bar, unsigned x, unsigned& nloc, unsigned& nx) {
    const unsigned G = gridDim.x * gridDim.y * gridDim.z;
    unsigned sum, cnt, mine, sp = 0u;
    for (;;) {
        sum = 0u; cnt = 0u; mine = 0u;
#pragma unroll
        for (unsigned j = 0; j < 16; ++j) { const unsigned c = xb_ld(&bar[XB_XCNT(j)]); sum += c; cnt += (c > 0u) ? 1u : 0u; mine = (j == x) ? c : mine; }
        if (sum == G) break;
        __builtin_amdgcn_s_sleep(1);
        if ((++sp & 255u) == 0u) { if (xb_ld(&bar[XB_TMO])) break; if (sp > XB_SPIN_CAP) { atomicAdd(&bar[XB_TMO], 1u); break; } }
    }
    nloc = mine > 0u ? mine : 1u; nx = cnt > 0u ? cnt : 1u;
}

__device__ __forceinline__ void xcd_barrier(const XcdBarrier& b) {
    asm volatile("s_waitcnt vmcnt(0)" ::: "memory");
    __syncthreads();
    if (threadIdx.x == 0) {
        unsigned* bar = b.bar;
        __builtin_amdgcn_s_waitcnt(0);
        unsigned nloc = b.st[0], nx = b.st[1];
        if (nloc == 0u) { xcd_barrier_complete(bar, b.x, nloc, nx); b.st[0] = nloc; b.st[1] = nx; }
        const unsigned old = xb_add(&bar[XB_XSUB(b.x)], 1u);
        const unsigned gen = old / nloc;
        if (old + 1u == (gen + 1u) * nloc) {
            __builtin_amdgcn_fence(__ATOMIC_RELEASE, "agent");
            asm volatile("s_waitcnt vmcnt(0)" ::: "memory");
            const unsigned og = xb_add(&bar[XB_TOP], 1u);
            const unsigned tg = og / nx;
            if (og + 1u == (tg + 1u) * nx) xb_add(&bar[XB_TOPGEN], 1u);
            else XB_SPIN(xb_ld(&bar[XB_TOPGEN]) == tg, bar);
            __builtin_amdgcn_fence(__ATOMIC_ACQUIRE, "agent");
            xb_add(&bar[XB_XGEN(b.x)], 1u);
            asm volatile("s_waitcnt vmcnt(0)" ::: "memory");
        } else {
            XB_SPIN(xb_ld(&bar[XB_XGEN(b.x)]) == gen, bar);
            __builtin_amdgcn_fence(__ATOMIC_ACQUIRE, "agent");
            asm volatile("s_waitcnt vmcnt(0)" ::: "memory");
        }
    }
    __syncthreads();
}


struct Frame {
    LAS unsigned char* lds;
    gu32* ctl;
    int tid, lane, wave, vcu, G, bx;
};
template <int CTRL> __device__ __forceinline__ float dpp_mov(float v) { return __builtin_bit_cast(float, __builtin_amdgcn_update_dpp(0, __builtin_bit_cast(int, v), CTRL, 0xf, 0xf, true)); }
__device__ __forceinline__ float wave_sum(float v) {
    v += dpp_mov<0xB1>(v);
    v += dpp_mov<0x4E>(v);
    v += dpp_mov<0x141>(v);
    v += dpp_mov<0x140>(v);
    const int iv = __builtin_bit_cast(int, v);
    return (__builtin_bit_cast(float, __builtin_amdgcn_readlane(iv, 0)) + __builtin_bit_cast(float, __builtin_amdgcn_readlane(iv, 16))) +
           (__builtin_bit_cast(float, __builtin_amdgcn_readlane(iv, 32)) + __builtin_bit_cast(float, __builtin_amdgcn_readlane(iv, 48)));
}
__device__ __forceinline__ void qd_swap16(float v, float& x, float& y) { x = v; y = v; asm volatile("v_nop\n\tv_nop\n\tv_permlane16_swap_b32 %0, %1" : "+v"(x), "+v"(y)); }
__device__ __forceinline__ void qd_swap32(float v, float& x, float& y) { x = v; y = v; asm volatile("v_nop\n\tv_nop\n\tv_permlane32_swap_b32 %0, %1" : "+v"(x), "+v"(y)); }
__device__ __forceinline__ float qd_max(float v) { float x, y; qd_swap16(v, x, y); v = fmaxf(x, y); qd_swap32(v, x, y); return fmaxf(x, y); }
__device__ __forceinline__ float qd_sum(float v) { float x, y; qd_swap16(v, x, y); v = x + y; qd_swap32(v, x, y); return x + y; }
__device__ __forceinline__ float bf2f(unsigned short h) { return __uint_as_float((unsigned)h << 16); }
__device__ __forceinline__ float bflo(unsigned w) { return __uint_as_float(w << 16); }
__device__ __forceinline__ float bfhi(unsigned w) { return __uint_as_float(w & 0xffff0000u); }
__device__ __forceinline__ unsigned ld_agent(const void* p) { return __hip_atomic_load((const unsigned*)p, __ATOMIC_RELAXED, __HIP_MEMORY_SCOPE_AGENT); }

__device__ __forceinline__ int rowmap(int kind, int n) {
    if (kind == 0) return n;
    if (kind == 1) return n < 1536 ? n : (n < 2304 ? ML_LDP + (n - 1536) : (n < 3072 ? n - 768 : (n < 3088 ? 2560 + (n - 3072) : 2304 + (n - 3088))));
    if (kind == 4) return n < 1536 ? n : (n < 2304 ? n + 256 : n - 768);
    return 32 * (n >> 4) + (n & 15) + (kind == 3 ? 16 : 0);
}
__device__ __forceinline__ void transpose_item(const float* W, int K, int N, bf16* WT, int kind, LAS float* scr, int item, int lane) {
    const int nblk = (N + 31) / 32, kb = item / nblk, nb = item % nblk, k0 = 64 * kb, n0 = 32 * nb;
    const int nn = n0 + (lane & 31); const bool ok = nn < N;
    float tv[32];
#pragma unroll
    for (int i = 0; i < 32; ++i) { const int kk = 2 * i + (lane >> 5); tv[i] = ok ? W[(size_t)(k0 + kk) * N + nn] : 0.f; }
#pragma unroll
    for (int i = 0; i < 32; ++i) { const int kk = 2 * i + (lane >> 5); scr[kk * 33 + (lane & 31)] = tv[i]; }
    LDS_WAIT(); asm volatile("" ::: "memory");
    const int c = lane & 7;
#pragma unroll
    for (int j = 0; j < 4; ++j) { const int n = (lane >> 3) + 8 * j; const LAS float* s = scr + (8 * c) * 33 + n;
        v4u o; o.x = pk2(s[0 * 33], s[1 * 33]); o.y = pk2(s[2 * 33], s[3 * 33]); o.z = pk2(s[4 * 33], s[5 * 33]); o.w = pk2(s[6 * 33], s[7 * 33]);
        if (n0 + n < N) *(GAS v4u*)(WT + (size_t)rowmap(kind, n0 + n) * K + k0 + 8 * c) = o; }
    LDS_WAIT(); asm volatile("" ::: "memory");
}
struct TrItem { const float* W; bf16* WT; int K, N, kind, item; };
__device__ __forceinline__ void tr_load2(const TrItem& t, int lane, float (&tv)[32]) {
    const int nblk = (t.N + 31) / 32, kb = t.item / nblk, nb = t.item % nblk, k0 = 64 * kb, n0 = 32 * nb;
#pragma unroll
    for (int i = 0; i < 32; ++i) tv[i] = t.W[(size_t)(k0 + i + 32 * (lane >> 5)) * t.N + n0 + (lane & 31)];
}
__device__ __forceinline__ void tr_finish2(const TrItem& t, int lane, const float (&tv)[32], LAS unsigned* scr) {
    const int nblk = (t.N + 31) / 32, kb = t.item / nblk, nb = t.item % nblk, k0 = 64 * kb, n0 = 32 * nb;
#pragma unroll
    for (int j = 0; j < 16; ++j) scr[(16 * (lane >> 5) + j) * 33 + (lane & 31)] = pk2(tv[2 * j], tv[2 * j + 1]);
    LDS_WAIT(); asm volatile("" ::: "memory");
    const int c = lane & 7;
#pragma unroll
    for (int j = 0; j < 4; ++j) { const int n = (lane >> 3) + 8 * j; const LAS unsigned* sp = scr + (4 * c) * 33 + n;
        *(GAS v4u*)(t.WT + (size_t)rowmap(t.kind, n0 + n) * t.K + k0 + 8 * c) = (v4u){sp[0], sp[33], sp[66], sp[99]}; }
    LDS_WAIT(); asm volatile("" ::: "memory");
}
__device__ __forceinline__ TrItem moe_tritem(int it, const float* w1, const float* w3, const float* w2, bf16* W13, bf16* W2) {
    const int mat = it >> 8, sub = it & 255, le = mat / 3, which = mat - 3 * le;
    if (which == 0) return TrItem{w1 + (size_t)le * 1024 * 512, W13 + (size_t)le * 1024 * 1024, 1024, 512, 2, sub};
    if (which == 1) return TrItem{w3 + (size_t)le * 1024 * 512, W13 + (size_t)le * 1024 * 1024, 1024, 512, 3, sub};
    return TrItem{w2 + (size_t)le * 512 * 1024, W2 + (size_t)le * 1024 * 512, 512, 1024, 0, sub};
}
struct P0Args { const float *x, *mem, *wmemkv, *nawin, *mlwin, *wout, *w1, *w3, *w2, *wg, *we, *g1, *b1, *bg, *be; unsigned char* ws; };
__device__ __forceinline__ void p0_prologue(const Frame& F, const P0Args& a) {
    LAS float* scr = (LAS float*)(F.lds + F.wave * 16384);
    const int gw = F.vcu * NWAVES + F.wave, NGW = F.G * NWAVES;
    bf16* const W13 = (bf16*)(a.ws + WS_W13); bf16* const W2 = (bf16*)(a.ws + WS_W2);
    constexpr int I_MKV = 16 * 16, I_NA = 16 * 80, I_ML = 16 * 105, I_WO = 16 * 32;
    constexpr int I_MOE0 = 32768;
    constexpr int NITEMS = I_MOE0 + I_MKV + 2 * I_NA + 2 * I_ML + DEPTH * I_WO;
    for (int it = gw; it < NITEMS; it += NGW) {
        int r = it;
        if (r < I_MOE0) { const TrItem t = moe_tritem(r, a.w1, a.w3, a.w2, W13, W2); float tv[32]; tr_load2(t, F.lane, tv); tr_finish2(t, F.lane, tv, (LAS unsigned*)scr); continue; }
        r -= I_MOE0;
        if (r < I_MKV) { transpose_item(a.wmemkv, D, 512, (bf16*)(a.ws + WS_WMEMKV), 0, scr, r, F.lane); continue; } r -= I_MKV;
        if (r < 2 * I_NA) { const int j = r / I_NA; transpose_item(a.nawin + (size_t)j * D * NA_IN, D, NA_IN, (bf16*)(a.ws + WS_WINNA) + (size_t)j * NA_IN * D, 4, scr, r - j * I_NA, F.lane); continue; } r -= 2 * I_NA;
        if (r < 2 * I_ML) { const int j = r / I_ML; transpose_item(a.mlwin + (size_t)j * D * ML_IN, D, ML_IN, (bf16*)(a.ws + WS_WINML) + (size_t)j * ML_INP * D, 1, scr, r - j * I_ML, F.lane); continue; } r -= 2 * I_ML;
        { const int l = r / I_WO; transpose_item(a.wout + (size_t)l * D * D, D, D, (bf16*)(a.ws + WS_WOUT) + (size_t)l * D * D, 0, scr, r - l * I_WO, F.lane); }
    }
    const int gt = F.vcu * NTHREADS + F.tid, NT = F.G * NTHREADS;
    for (int i = gt; i < 2 * 240 * (D / 8); i += NT) { const int j = i / (240 * (D / 8)), rr = i - j * 240 * (D / 8);
        *(GAS v4u*)((bf16*)(a.ws + WS_WINML) + (size_t)j * ML_INP * D + (size_t)2576 * D + (size_t)rr * 8) = (v4u){0u, 0u, 0u, 0u}; }
    for (int i = gt; i < DEPTH * 48 * D; i += NT) { const int l = i / (48 * D), n = (i / D) % 48, k = i % D;
        const float wv = n < 4 ? a.wg[((size_t)l * D + k) * NGRP + n] : (n < 36 ? a.we[((size_t)l * D + k) * NEXP + (n - 4)] : 0.f);
        const float v = wv * a.g1[(size_t)l * D + k];
        const unsigned hi = f2bf(v); const float lo = v - bf2f((unsigned short)hi);
        bf16* wr = (bf16*)(a.ws + WS_WR) + (size_t)l * 2 * 48 * D; wr[(size_t)n * D + k] = (bf16)hi; wr[(size_t)(48 + n) * D + k] = (bf16)f2bf(lo); }
    for (int jn = gw; jn < DEPTH * 48; jn += NGW) { const int l = jn / 48, n = jn % 48; float sg = 0.f, sb = 0.f;
        if (n < 36) for (int k = F.lane; k < D; k += 64) { const float wv = n < 4 ? a.wg[((size_t)l * D + k) * NGRP + n] : a.we[((size_t)l * D + k) * NEXP + (n - 4)];
            sg += wv * a.g1[(size_t)l * D + k]; sb += wv * a.b1[(size_t)l * D + k]; }
        sg = wave_sum(sg); sb = wave_sum(sb);
        if (F.lane == 0) { float* rgb = (float*)(a.ws + WS_RGB) + l * 96; rgb[n] = sg; rgb[48 + n] = n < 4 ? sb + a.bg[l * NGRP + n] : (n < 36 ? sb + a.be[l * NEXP + (n - 4)] : 0.f); } }
    for (int i = gt; i < M * D / 8; i += NT) { const f32x4 v0 = *(const GAS f32x4*)(a.x + (size_t)i * 8), v1 = *(const GAS f32x4*)(a.x + (size_t)i * 8 + 4);
        *(GAS v4u*)((bf16*)(a.ws + WS_XB) + (size_t)i * 8) = (v4u){pk2(v0.x, v0.y), pk2(v0.z, v0.w), pk2(v1.x, v1.y), pk2(v1.z, v1.w)}; }
    for (int i = gt; i < BATCH * NMEM * D / 8; i += NT) { const f32x4 v0 = *(const GAS f32x4*)(a.mem + (size_t)i * 8), v1 = *(const GAS f32x4*)(a.mem + (size_t)i * 8 + 4);
        *(GAS v4u*)((bf16*)(a.ws + WS_MEMB) + (size_t)i * 8) = (v4u){pk2(v0.x, v0.y), pk2(v0.z, v0.w), pk2(v1.x, v1.y), pk2(v1.z, v1.w)}; }
}

__device__ __forceinline__ void load8(const bf16* p, float* f) { const v4u w = *(const GAS v4u*)p;
    f[0] = bflo(w.x); f[1] = bfhi(w.x); f[2] = bflo(w.y); f[3] = bfhi(w.y); f[4] = bflo(w.z); f[5] = bfhi(w.z); f[6] = bflo(w.w); f[7] = bfhi(w.w); }
__device__ __forceinline__ bf16x8 ld_frag(const bf16* p) { return *(const GAS bf16x8*)p; }
template <bool NA_LAYER>
__device__ __forceinline__ void attn_mfma(const Frame& F, const bf16* PROJ, const bf16* VT, const bf16* MEMK, const bf16* MEMVT, const float* rpb  , bf16* MIXED) {
    constexpr int ldp = NA_LAYER ? NA_LDP : ML_LDP;
    constexpr int nheads = NA_LAYER ? 16 : 4;
    const int gw = F.vcu * NWAVES + F.wave, NGW = F.G * NWAVES, lane = F.lane, qi = lane & 15, qd = lane >> 4;
    LAS float* rpl = (LAS float*)F.lds;
    if (NA_LAYER) { for (int i = F.tid; i < NAH * 15 * 31; i += NTHREADS) rpl[i] = rpb[i]; __syncthreads(); }
    for (int it = gw; it < BATCH * nheads * 64 * 4; it += NGW) {
        const int g = it & 3, r = (it >> 2) & 63, hb = it >> 8, hh = hb % nheads, b = hb / nheads;
        const int head = NA_LAYER ? hh : 12 + hh;
        const bool is_mem = head >= 12;
        const int tq0 = b * SEQ + r * 64 + 16 * g;
        const int qcol = is_mem ? (NA_LAYER ? 1536 : 2304) + (head - 12) * 64 : head * 64;
        const int rs = min(max(r - 4, 0), 56), w0 = g == 0 ? 0 : (g == 1 ? 8 : (g == 2 ? 24 : 32));
        const bf16* kbase; const bf16* vbase; size_t kblk, kstride, vblk, vstride;
        if (is_mem) { const int hm = head - 12; kbase = MEMK + (size_t)(b * NMEM) * 256 + hm * 64; kblk = 32 * 256; kstride = 256;
                      vbase = MEMVT + (size_t)(hm * 64) * (BATCH * NMEM) + b * NMEM; vblk = 32; vstride = BATCH * NMEM; }
        else { kbase = PROJ + (size_t)(b * SEQ + rs * 64 + w0) * ldp + 768 + head * 64; kblk = (size_t)64 * ldp; kstride = ldp;
               vbase = VT + (size_t)(head * 64) * M + (b * SEQ + rs * 64 + w0); vblk = 64; vstride = M; }
        const bf16* qp = PROJ + (size_t)(tq0 + qi) * ldp + qcol + 8 * qd;
        const bf16x8 qf0 = ld_frag(qp), qf1 = ld_frag(qp + 32);
        float sc[8][8];
        { bf16x8 kf[8][2][2];
#pragma unroll
          for (int blk = 0; blk < 8; ++blk)
#pragma unroll
            for (int t = 0; t < 2; ++t) { const bf16* kp = kbase + blk * kblk + (size_t)(8 * (qi >> 2) + 4 * t + (qi & 3)) * kstride + 8 * qd; kf[blk][t][0] = ld_frag(kp); kf[blk][t][1] = ld_frag(kp + 32); }
          __builtin_amdgcn_sched_barrier(0);
#pragma unroll
          for (int blk = 0; blk < 8; ++blk)
#pragma unroll
            for (int t = 0; t < 2; ++t) { f32x4 a = {0.f, 0.f, 0.f, 0.f};
                a = __builtin_amdgcn_mfma_f32_16x16x32_bf16(kf[blk][t][0], qf0, a, 0, 0, 0);
                a = __builtin_amdgcn_mfma_f32_16x16x32_bf16(kf[blk][t][1], qf1, a, 0, 0, 0);
#pragma unroll
                for (int j = 0; j < 4; ++j) sc[blk][4 * t + j] = a[j] * 0.125f; } }
        bf16x8 vfa[4][4];
#pragma unroll
        for (int blk = 0; blk < 4; ++blk)
#pragma unroll
            for (int dt = 0; dt < 4; ++dt) vfa[blk][dt] = ld_frag(vbase + (size_t)(16 * (qi >> 2) + 4 * dt + (qi & 3)) * vstride + blk * vblk + 8 * qd);
        __builtin_amdgcn_sched_barrier(0);
        if (!is_mem) {
            const int c = 16 * g + qi, cs = min(max(c - 8, 0), 48), kc0 = w0 + 8 * qd;
#pragma unroll
            for (int blk = 0; blk < 8; ++blk) { const LAS float* rp = rpl + (head * 15 + (rs + blk - r + 7)) * 31;
#pragma unroll
                for (int e = 0; e < 8; ++e) { const int kc = kc0 + e; const bool valid = kc >= cs && kc < cs + 16;
                    const float bias = rp[min(max(kc - c + 15, 0), 30)]; sc[blk][e] = valid ? sc[blk][e] + bias : -INFINITY; } }
        }
        float mx = -INFINITY;
#pragma unroll
        for (int blk = 0; blk < 8; ++blk)
#pragma unroll
            for (int e = 0; e < 8; ++e) mx = fmaxf(mx, sc[blk][e]);
        mx = qd_max(mx);
        float ls = 0.f; bf16x8 pf[8];
#pragma unroll
        for (int blk = 0; blk < 8; ++blk) { float p[8];
#pragma unroll
            for (int e = 0; e < 8; ++e) { p[e] = __expf(sc[blk][e] - mx); ls += p[e]; }
            u32x4 w; w.x = pk2(p[0], p[1]); w.y = pk2(p[2], p[3]); w.z = pk2(p[4], p[5]); w.w = pk2(p[6], p[7]);
            pf[blk] = __builtin_bit_cast(bf16x8, w); }
        ls = qd_sum(ls);
        f32x4 o[4]; bf16x8 vfb[4][4];
#pragma unroll
        for (int dt = 0; dt < 4; ++dt) o[dt] = (f32x4){0.f, 0.f, 0.f, 0.f};
#pragma unroll
        for (int blk = 0; blk < 4; ++blk)
#pragma unroll
            for (int dt = 0; dt < 4; ++dt) vfb[blk][dt] = ld_frag(vbase + (size_t)(16 * (qi >> 2) + 4 * dt + (qi & 3)) * vstride + (blk + 4) * vblk + 8 * qd);
        __builtin_amdgcn_sched_barrier(0);
#pragma unroll
        for (int blk = 0; blk < 4; ++blk)
#pragma unroll
            for (int dt = 0; dt < 4; ++dt) o[dt] = __builtin_amdgcn_mfma_f32_16x16x32_bf16(vfa[blk][dt], pf[blk], o[dt], 0, 0, 0);
#pragma unroll
        for (int blk = 0; blk < 4; ++blk)
#pragma unroll
            for (int dt = 0; dt < 4; ++dt) o[dt] = __builtin_amdgcn_mfma_f32_16x16x32_bf16(vfb[blk][dt], pf[blk + 4], o[dt], 0, 0, 0);
        const float inv = 1.0f / ls;
        bf16* op = MIXED + (size_t)(tq0 + qi) * D + head * 64 + 16 * qd;
        *(GAS u32x4*)op = (u32x4){pk2(o[0][0] * inv, o[0][1] * inv), pk2(o[0][2] * inv, o[0][3] * inv), pk2(o[1][0] * inv, o[1][1] * inv), pk2(o[1][2] * inv, o[1][3] * inv)};
        *(GAS u32x4*)(op + 8) = (u32x4){pk2(o[2][0] * inv, o[2][1] * inv), pk2(o[2][2] * inv, o[2][3] * inv), pk2(o[3][0] * inv, o[3][1] * inv), pk2(o[3][2] * inv, o[3][3] * inv)};
    }
}

__device__ __forceinline__ int att_fk(int tok) { return (((tok >> 3) & 3) << 1) | ((tok >> 1) & 1); }
__device__ __forceinline__ int att_fv(int d) { return (((d >> 4) & 3) << 1) | ((d >> 1) & 1); }
template <bool NA_LAYER>
__device__ __forceinline__ void attn_lds(const Frame& F, const bf16* PROJ, const bf16* VT, const bf16* MEMK, const bf16* MEMVT, const float* rpb  , bf16* MIXED) {
    constexpr int ldp = NA_LAYER ? NA_LDP : ML_LDP;
    const int tid = F.tid, lane = F.lane, wave = F.wave, qi = lane & 15, qd = lane >> 4, g = wave & 3;
    const int half = wave >> 2;
    LAS float* mrg = (LAS float*)(F.lds + LDSCTL_OFF + 8192) + ((wave & 3) * 64 + lane) * 18;
    LAS unsigned char* slots = F.lds;
    LAS float* rpl = (LAS float*)(F.lds + LDSCTL_OFF + 4096);
#define ATT_BAR() do { asm volatile("s_waitcnt lgkmcnt(0)" ::: "memory"); __builtin_amdgcn_s_barrier(); asm volatile("" ::: "memory"); } while (0)
    const int w0g = g == 0 ? 0 : (g == 1 ? 8 : (g == 2 ? 24 : 32));
    for (int uk = 0; uk < (NA_LAYER ? 4 : 1); ++uk) {
        const int u = F.vcu + 256 * uk;
        const bool is_mem = NA_LAYER ? (u >= 768) : true;
        const int v = is_mem ? (NA_LAYER ? u - 768 : u) : u, bh = v >> 3, seg = v & 7;
        const int b = is_mem ? (bh >> 2) : bh / 12, head = is_mem ? 12 + (bh & 3) : bh % 12, r0 = 8 * seg;
        const int qcol = is_mem ? (NA_LAYER ? 1536 : 2304) + (head - 12) * 64 : head * 64;
        const int w0 = is_mem ? 0 : w0g;
        const bf16 *ga, *gb; size_t stepa, stepb; int la, lb;
        if (is_mem) { const int hm = head - 12;
            if (tid < 256) { const int tok = tid >> 3, c = tid & 7; ga = MEMK + (size_t)(b * NMEM + tok) * 256 + hm * 64 + 8 * c; stepa = 32 * 256; la = tok * 128 + ((c ^ att_fk(tok)) << 4); }
            else { const int t2 = tid - 256, d = t2 >> 2, c = t2 & 3; ga = MEMVT + (size_t)(hm * 64 + d) * (BATCH * NMEM) + b * NMEM + 8 * c; stepa = 32; la = 8192 + d * 128 + ((c ^ att_fv(d)) << 4); }
            gb = ga; stepb = stepa; lb = la;
        } else { const int tok = tid >> 3, c = tid & 7;
            ga = PROJ + (size_t)(b * SEQ + tok) * ldp + 768 + head * 64 + 8 * c; stepa = (size_t)64 * ldp; la = tok * 128 + ((c ^ att_fk(tok)) << 4);
            gb = VT + (size_t)(head * 64 + tok) * M + b * SEQ + 8 * c; stepb = 64; lb = 8192 + tok * 128 + ((c ^ att_fv(tok)) << 4); }
        ATT_BAR();
        if (!is_mem) for (int i = tid; i < 15 * 48; i += NTHREADS) { const int ri = i / 48, cj = i % 48 - 8; rpl[i] = (cj >= 0 && cj < 31) ? rpb[head * 465 + ri * 31 + cj] : 0.f; }
        const int rs0 = is_mem ? 0 : min(max(r0 - 4, 0), 56);
        { v4u ra[8], rb[8];
#pragma unroll
          for (int i = 0; i < 8; ++i) { ra[i] = *(const GAS v4u*)(ga + (size_t)(rs0 + i) * stepa); if (!is_mem) rb[i] = *(const GAS v4u*)(gb + (size_t)(rs0 + i) * stepb); }
#pragma unroll
          for (int i = 0; i < 8; ++i) { *(LAS v4u*)(slots + ((rs0 + i) & 7) * 16384 + la) = ra[i]; if (!is_mem) *(LAS v4u*)(slots + ((rs0 + i) & 7) * 16384 + lb) = rb[i]; } }
        v4u pa0 = {0u, 0u, 0u, 0u}, pb0 = pa0, pa1 = pa0, pb1 = pa0;
#define ATT_RS(r) (is_mem ? 0 : min(max((r) - 4, 0), 56))
#define ATT_SLIDE(r) (!is_mem && (r) + 1 < r0 + 8 && ATT_RS((r) + 1) != ATT_RS(r))
        if (ATT_SLIDE(r0)) { pa0 = *(const GAS v4u*)(ga + (size_t)(ATT_RS(r0) + 8) * stepa); pb0 = *(const GAS v4u*)(gb + (size_t)(ATT_RS(r0) + 8) * stepb); }
        if (ATT_SLIDE(r0 + 1)) { pa1 = *(const GAS v4u*)(ga + (size_t)(ATT_RS(r0 + 1) + 8) * stepa); pb1 = *(const GAS v4u*)(gb + (size_t)(ATT_RS(r0 + 1) + 8) * stepb); }
        const bf16* qp = PROJ + (size_t)(b * SEQ + r0 * 64 + 16 * g + qi) * ldp + qcol + 8 * qd;
        bf16x8 qf0 = ld_frag(qp), qf1 = ld_frag(qp + 32);
        ATT_BAR();
#pragma unroll 2
        for (int rr8 = 0; rr8 < 8; ++rr8) {
            const int r = r0 + rr8, rs = ATT_RS(r);
            bf16x8 qn0 = qf0, qn1 = qf1;
            if (rr8 < 7) { qn0 = ld_frag(qp + (size_t)(rr8 + 1) * 64 * ldp); qn1 = ld_frag(qp + (size_t)(rr8 + 1) * 64 * ldp + 32); }
            float sc[4][8];
#pragma unroll
            for (int bl = 0; bl < 4; ++bl) { const LAS unsigned char* sl = slots + ((rs + 4 * half + bl) & 7) * 16384; bf16x8 kf[2][2];
#pragma unroll
                for (int t = 0; t < 2; ++t) { const int tok = w0 + 8 * (qi >> 2) + 4 * t + (qi & 3); const int fk = att_fk(tok);
                    kf[t][0] = *(const LAS bf16x8*)(sl + tok * 128 + ((qd ^ fk) << 4)); kf[t][1] = *(const LAS bf16x8*)(sl + tok * 128 + (((4 + qd) ^ fk) << 4)); }
#pragma unroll
                for (int t = 0; t < 2; ++t) { f32x4 a = {0.f, 0.f, 0.f, 0.f};
                    a = __builtin_amdgcn_mfma_f32_16x16x32_bf16(kf[t][0], qf0, a, 0, 0, 0);
                    a = __builtin_amdgcn_mfma_f32_16x16x32_bf16(kf[t][1], qf1, a, 0, 0, 0);
#pragma unroll
                    for (int j = 0; j < 4; ++j) sc[bl][4 * t + j] = a[j] * 0.125f; } }
            if (!is_mem) {
                const int c = 16 * g + qi, cs = min(max(c - 8, 0), 48), kc0 = w0 + 8 * qd, lo = cs - kc0, hi = lo + 16;
                const LAS float* rp = rpl + (rs + 4 * half - r + 7) * 48 + 8 + min(max(kc0 - c + 15, -8), 31);
                float bias[4][8];
#pragma unroll
                for (int bl = 0; bl < 4; ++bl)
#pragma unroll
                    for (int e = 0; e < 8; ++e) bias[bl][e] = rp[bl * 48 + e];
#pragma unroll
                for (int bl = 0; bl < 4; ++bl)
#pragma unroll
                    for (int e = 0; e < 8; ++e) sc[bl][e] = (e >= lo && e < hi) ? sc[bl][e] + bias[bl][e] : -INFINITY;
            }
            float mx = -INFINITY;
#pragma unroll
            for (int bl = 0; bl < 4; ++bl)
#pragma unroll
                for (int e = 0; e < 8; ++e) mx = fmaxf(mx, sc[bl][e]);
            mx = qd_max(mx);
            float ls = 0.f; bf16x8 pf[4];
#pragma unroll
            for (int bl = 0; bl < 4; ++bl) { float p[8];
#pragma unroll
                for (int e = 0; e < 8; ++e) { p[e] = __expf(sc[bl][e] - mx); ls += p[e]; }
                u32x4 w; w.x = pk2(p[0], p[1]); w.y = pk2(p[2], p[3]); w.z = pk2(p[4], p[5]); w.w = pk2(p[6], p[7]);
                pf[bl] = __builtin_bit_cast(bf16x8, w); }
            ls = qd_sum(ls);
            f32x4 o[4];
#pragma unroll
            for (int dt = 0; dt < 4; ++dt) o[dt] = (f32x4){0.f, 0.f, 0.f, 0.f};
            const int vc = (w0 >> 3) + qd;
#pragma unroll
            for (int bl = 0; bl < 4; ++bl) { const LAS unsigned char* sl = slots + ((rs + 4 * half + bl) & 7) * 16384 + 8192; bf16x8 vf[4];
#pragma unroll
                for (int dt = 0; dt < 4; ++dt) { const int d = 16 * (qi >> 2) + 4 * dt + (qi & 3); vf[dt] = *(const LAS bf16x8*)(sl + d * 128 + ((vc ^ att_fv(d)) << 4)); }
#pragma unroll
                for (int dt = 0; dt < 4; ++dt) o[dt] = __builtin_amdgcn_mfma_f32_16x16x32_bf16(vf[dt], pf[bl], o[dt], 0, 0, 0); }
            if (half == 1) { mrg[0] = mx; mrg[1] = ls;
#pragma unroll
                for (int dt = 0; dt < 4; ++dt)
#pragma unroll
                    for (int j = 0; j < 4; ++j) mrg[2 + 4 * dt + j] = o[dt][j]; }
            qf0 = qn0; qf1 = qn1;
            ATT_BAR();
            if (half == 0) {
                const float m1 = mrg[0], l1 = mrg[1], mm = fmaxf(mx, m1), f0 = __expf(mx - mm), f1 = __expf(m1 - mm), inv = 1.0f / (ls * f0 + l1 * f1), s0 = f0 * inv, s1 = f1 * inv;
                float ov[16];
#pragma unroll
                for (int dt = 0; dt < 4; ++dt)
#pragma unroll
                    for (int j = 0; j < 4; ++j) ov[4 * dt + j] = o[dt][j] * s0 + mrg[2 + 4 * dt + j] * s1;
                bf16* op = MIXED + (size_t)(b * SEQ + r * 64 + 16 * g + qi) * D + head * 64 + 16 * qd;
                *(GAS u32x4*)op = (u32x4){pk2(ov[0], ov[1]), pk2(ov[2], ov[3]), pk2(ov[4], ov[5]), pk2(ov[6], ov[7])};
                *(GAS u32x4*)(op + 8) = (u32x4){pk2(ov[8], ov[9]), pk2(ov[10], ov[11]), pk2(ov[12], ov[13]), pk2(ov[14], ov[15])};
            }
            if (ATT_SLIDE(r)) {
                const int sl = rs & 7;
                if ((rr8 & 1) == 0) { *(LAS v4u*)(slots + sl * 16384 + la) = pa0; *(LAS v4u*)(slots + sl * 16384 + lb) = pb0; }
                else                { *(LAS v4u*)(slots + sl * 16384 + la) = pa1; *(LAS v4u*)(slots + sl * 16384 + lb) = pb1; }
            }
            if (ATT_SLIDE(r + 2)) {
                if ((rr8 & 1) == 0) { pa0 = *(const GAS v4u*)(ga + (size_t)(ATT_RS(r + 2) + 8) * stepa); pb0 = *(const GAS v4u*)(gb + (size_t)(ATT_RS(r + 2) + 8) * stepb); }
                else                { pa1 = *(const GAS v4u*)(ga + (size_t)(ATT_RS(r + 2) + 8) * stepa); pb1 = *(const GAS v4u*)(gb + (size_t)(ATT_RS(r + 2) + 8) * stepb); }
            }
            ATT_BAR();
        }
    }
#undef ATT_RS
#undef ATT_SLIDE
#undef ATT_BAR
}

struct CvArgs { const float *w1, *w3, *w2; bf16 *W13, *W2; int item0; };
__device__ __forceinline__ void attn_lds_cv(const Frame& F, const bf16* PROJ, const bf16* VT, const bf16* MEMK, const bf16* MEMVT, const float* rpb  , bf16* MIXED, const CvArgs cv) {
    constexpr bool NA_LAYER = true;
    constexpr int ldp = NA_LAYER ? NA_LDP : ML_LDP;
    const int tid = F.tid, lane = F.lane, wave = F.wave, qi = lane & 15, qd = lane >> 4, g = wave & 3;
    const bool compute = wave < 4;
    LAS unsigned char* slots = F.lds;
    LAS float* rpl = (LAS float*)(F.lds + LDSCTL_OFF + 4096);
#define ATT_BAR() do { asm volatile("s_waitcnt lgkmcnt(0)" ::: "memory"); __builtin_amdgcn_s_barrier(); asm volatile("" ::: "memory"); } while (0)
    const int w0g = g == 0 ? 0 : (g == 1 ? 8 : (g == 2 ? 24 : 32));
    float tvA[32]; TrItem itA = {nullptr, nullptr, 0, 0, 0, 0}; bool pend = false;
    LAS unsigned* cscr = (LAS unsigned*)(F.lds + LDSCTL_OFF + 8192 + (wave & 3) * 4352);
    const int cbase = cv.item0 + (F.vcu * 4 + (wave & 3)) * 32;
    for (int uk = 0; uk < (NA_LAYER ? 4 : 1); ++uk) {
        const int u = F.vcu + 256 * uk;
        const bool is_mem = NA_LAYER ? (u >= 768) : true;
        const int v = is_mem ? (NA_LAYER ? u - 768 : u) : u, bh = v >> 3, seg = v & 7;
        const int b = is_mem ? (bh >> 2) : bh / 12, head = is_mem ? 12 + (bh & 3) : bh % 12, r0 = 8 * seg;
        const int qcol = is_mem ? (NA_LAYER ? 1536 : 2304) + (head - 12) * 64 : head * 64;
        const int w0 = is_mem ? 0 : w0g;
        const bf16 *ga, *gb; size_t stepa, stepb; int la, lb;
        if (is_mem) { const int hm = head - 12;
            if (tid < 256) { const int tok = tid >> 3, c = tid & 7; ga = MEMK + (size_t)(b * NMEM + tok) * 256 + hm * 64 + 8 * c; stepa = 32 * 256; la = tok * 128 + ((c ^ att_fk(tok)) << 4); }
            else { const int t2 = tid - 256, d = t2 >> 2, c = t2 & 3; ga = MEMVT + (size_t)(hm * 64 + d) * (BATCH * NMEM) + b * NMEM + 8 * c; stepa = 32; la = 8192 + d * 128 + ((c ^ att_fv(d)) << 4); }
            gb = ga; stepb = stepa; lb = la;
        } else { const int tok = tid >> 3, c = tid & 7;
            ga = PROJ + (size_t)(b * SEQ + tok) * ldp + 768 + head * 64 + 8 * c; stepa = (size_t)64 * ldp; la = tok * 128 + ((c ^ att_fk(tok)) << 4);
            gb = VT + (size_t)(head * 64 + tok) * M + b * SEQ + 8 * c; stepb = 64; lb = 8192 + tok * 128 + ((c ^ att_fv(tok)) << 4); }
        ATT_BAR();
        if (!is_mem) for (int i = tid; i < 15 * 48; i += NTHREADS) { const int ri = i / 48, cj = i % 48 - 8; rpl[i] = (cj >= 0 && cj < 31) ? rpb[head * 465 + ri * 31 + cj] : 0.f; }
        const int rs0 = is_mem ? 0 : min(max(r0 - 4, 0), 56);
        { v4u ra[8], rb[8];
#pragma unroll
          for (int i = 0; i < 8; ++i) { ra[i] = *(const GAS v4u*)(ga + (size_t)(rs0 + i) * stepa); if (!is_mem) rb[i] = *(const GAS v4u*)(gb + (size_t)(rs0 + i) * stepb); }
#pragma unroll
          for (int i = 0; i < 8; ++i) { *(LAS v4u*)(slots + ((rs0 + i) & 7) * 16384 + la) = ra[i]; if (!is_mem) *(LAS v4u*)(slots + ((rs0 + i) & 7) * 16384 + lb) = rb[i]; } }
        v4u pa0 = {0u, 0u, 0u, 0u}, pb0 = pa0, pa1 = pa0, pb1 = pa0;
#define ATT_RS(r) (is_mem ? 0 : min(max((r) - 4, 0), 56))
#define ATT_SLIDE(r) (!is_mem && (r) + 1 < r0 + 8 && ATT_RS((r) + 1) != ATT_RS(r))
        if (ATT_SLIDE(r0)) { pa0 = *(const GAS v4u*)(ga + (size_t)(ATT_RS(r0) + 8) * stepa); pb0 = *(const GAS v4u*)(gb + (size_t)(ATT_RS(r0) + 8) * stepb); }
        if (ATT_SLIDE(r0 + 1)) { pa1 = *(const GAS v4u*)(ga + (size_t)(ATT_RS(r0 + 1) + 8) * stepa); pb1 = *(const GAS v4u*)(gb + (size_t)(ATT_RS(r0 + 1) + 8) * stepb); }
        const bf16* qp = PROJ + (size_t)(b * SEQ + r0 * 64 + 16 * g + qi) * ldp + qcol + 8 * qd;
        bf16x8 qf0 = ld_frag(qp), qf1 = ld_frag(qp + 32);
        ATT_BAR();
#pragma unroll 2
        for (int rr8 = 0; rr8 < 8; ++rr8) {
            const int r = r0 + rr8, rs = ATT_RS(r);
            if (compute) {
                bf16x8 qn0 = qf0, qn1 = qf1;
                if (rr8 < 7) { qn0 = ld_frag(qp + (size_t)(rr8 + 1) * 64 * ldp); qn1 = ld_frag(qp + (size_t)(rr8 + 1) * 64 * ldp + 32); }
                float mx = -INFINITY, ls = 0.f; f32x4 o[4];
#pragma unroll
                for (int dt = 0; dt < 4; ++dt) o[dt] = (f32x4){0.f, 0.f, 0.f, 0.f};
                const int vc = (w0 >> 3) + qd;
#pragma unroll
                for (int half = 0; half < 2; ++half) {
                    float sc[4][8];
#pragma unroll
                    for (int bl = 0; bl < 4; ++bl) { const LAS unsigned char* sl = slots + ((rs + 4 * half + bl) & 7) * 16384; bf16x8 kf[2][2];
#pragma unroll
                        for (int t = 0; t < 2; ++t) { const int tok = w0 + 8 * (qi >> 2) + 4 * t + (qi & 3); const int fk = att_fk(tok);
                            kf[t][0] = *(const LAS bf16x8*)(sl + tok * 128 + ((qd ^ fk) << 4)); kf[t][1] = *(const LAS bf16x8*)(sl + tok * 128 + (((4 + qd) ^ fk) << 4)); }
#pragma unroll
                        for (int t = 0; t < 2; ++t) { f32x4 a = {0.f, 0.f, 0.f, 0.f};
                            a = __builtin_amdgcn_mfma_f32_16x16x32_bf16(kf[t][0], qf0, a, 0, 0, 0);
                            a = __builtin_amdgcn_mfma_f32_16x16x32_bf16(kf[t][1], qf1, a, 0, 0, 0);
#pragma unroll
                            for (int j = 0; j < 4; ++j) sc[bl][4 * t + j] = a[j] * 0.125f; } }
                    if (!is_mem) {
                        const int c = 16 * g + qi, cs = min(max(c - 8, 0), 48), kc0 = w0 + 8 * qd, lo = cs - kc0, hi = lo + 16;
                        const LAS float* rp = rpl + (rs + 4 * half - r + 7) * 48 + 8 + min(max(kc0 - c + 15, -8), 31);
                        float bias[4][8];
#pragma unroll
                        for (int bl = 0; bl < 4; ++bl)
#pragma unroll
                            for (int e = 0; e < 8; ++e) bias[bl][e] = rp[bl * 48 + e];
#pragma unroll
                        for (int bl = 0; bl < 4; ++bl)
#pragma unroll
                            for (int e = 0; e < 8; ++e) sc[bl][e] = (e >= lo && e < hi) ? sc[bl][e] + bias[bl][e] : -INFINITY;
                    }
                    float mh = -INFINITY;
#pragma unroll
                    for (int bl = 0; bl < 4; ++bl)
#pragma unroll
                        for (int e = 0; e < 8; ++e) mh = fmaxf(mh, sc[bl][e]);
                    mh = qd_max(mh);
                    const float mn = fmaxf(mx, mh), fo = __expf(mx - mn);
                    mx = mn; ls *= fo;
#pragma unroll
                    for (int dt = 0; dt < 4; ++dt) o[dt] = o[dt] * fo;
                    float lh = 0.f; bf16x8 pf[4];
#pragma unroll
                    for (int bl = 0; bl < 4; ++bl) { float p[8];
#pragma unroll
                        for (int e = 0; e < 8; ++e) { p[e] = __expf(sc[bl][e] - mn); lh += p[e]; }
                        u32x4 w; w.x = pk2(p[0], p[1]); w.y = pk2(p[2], p[3]); w.z = pk2(p[4], p[5]); w.w = pk2(p[6], p[7]);
                        pf[bl] = __builtin_bit_cast(bf16x8, w); }
                    lh = qd_sum(lh); ls += lh;
#pragma unroll
                    for (int bl = 0; bl < 4; ++bl) { const LAS unsigned char* sl = slots + ((rs + 4 * half + bl) & 7) * 16384 + 8192; bf16x8 vf[4];
#pragma unroll
                        for (int dt = 0; dt < 4; ++dt) { const int d = 16 * (qi >> 2) + 4 * dt + (qi & 3); vf[dt] = *(const LAS bf16x8*)(sl + d * 128 + ((vc ^ att_fv(d)) << 4)); }
#pragma unroll
                        for (int dt = 0; dt < 4; ++dt) o[dt] = __builtin_amdgcn_mfma_f32_16x16x32_bf16(vf[dt], pf[bl], o[dt], 0, 0, 0); }
                }
                const float inv = 1.0f / ls;
                bf16* op = MIXED + (size_t)(b * SEQ + r * 64 + 16 * g + qi) * D + head * 64 + 16 * qd;
                *(GAS u32x4*)op = (u32x4){pk2(o[0][0] * inv, o[0][1] * inv), pk2(o[0][2] * inv, o[0][3] * inv), pk2(o[1][0] * inv, o[1][1] * inv), pk2(o[1][2] * inv, o[1][3] * inv)};
                *(GAS u32x4*)(op + 8) = (u32x4){pk2(o[2][0] * inv, o[2][1] * inv), pk2(o[2][2] * inv, o[2][3] * inv), pk2(o[3][0] * inv, o[3][1] * inv), pk2(o[3][2] * inv, o[3][3] * inv)};
                qf0 = qn0; qf1 = qn1;
            }
            if (!compute) { const int ridx = uk * 8 + rr8;
                if (pend) tr_finish2(itA, lane, tvA, cscr);
                itA = moe_tritem(cbase + ridx, cv.w1, cv.w3, cv.w2, cv.W13, cv.W2); tr_load2(itA, lane, tvA); pend = true; }
            ATT_BAR();
            if (ATT_SLIDE(r)) {
                const int sl = rs & 7;
                if ((rr8 & 1) == 0) { *(LAS v4u*)(slots + sl * 16384 + la) = pa0; *(LAS v4u*)(slots + sl * 16384 + lb) = pb0; }
                else                { *(LAS v4u*)(slots + sl * 16384 + la) = pa1; *(LAS v4u*)(slots + sl * 16384 + lb) = pb1; }
            }
            if (ATT_SLIDE(r + 2)) {
                if ((rr8 & 1) == 0) { pa0 = *(const GAS v4u*)(ga + (size_t)(ATT_RS(r + 2) + 8) * stepa); pb0 = *(const GAS v4u*)(gb + (size_t)(ATT_RS(r + 2) + 8) * stepb); }
                else                { pa1 = *(const GAS v4u*)(ga + (size_t)(ATT_RS(r + 2) + 8) * stepa); pb1 = *(const GAS v4u*)(gb + (size_t)(ATT_RS(r + 2) + 8) * stepb); }
            }
            ATT_BAR();
        }
    }
    if (!compute && pend) tr_finish2(itA, lane, tvA, cscr);
#undef ATT_RS
#undef ATT_SLIDE
#undef ATT_BAR
}

__device__ __forceinline__ void ml_conv(const Frame& F, const bf16* PROJ, const float* cw  , const float* cb  , bf16* QKC) {
    const int gt = F.vcu * NTHREADS + F.tid, NT = F.G * NTHREADS;
    for (int it = gt; it < (M / 16) * 192; it += NT) {
        const int tb = it / 192, c0 = (it - tb * 192) * 8, tok0 = tb * 16, t0 = tok0 & (SEQ - 1);
        v4u rw[20];
#pragma unroll
        for (int k = 0; k < 20; ++k) { const int tt = t0 - 2 + k;
            rw[k] = (tt >= 0 && tt < SEQ) ? *(const GAS v4u*)(PROJ + (size_t)(tok0 - 2 + k) * ML_LDP + c0) : (v4u){0u, 0u, 0u, 0u}; }
        float w[5][8], bs[8];
#pragma unroll
        for (int jj = 0; jj < 5; ++jj) { const f32x4 wa = *(const GAS f32x4*)(cw + jj * 1536 + c0), wb = *(const GAS f32x4*)(cw + jj * 1536 + c0 + 4);
            w[jj][0] = wa.x; w[jj][1] = wa.y; w[jj][2] = wa.z; w[jj][3] = wa.w; w[jj][4] = wb.x; w[jj][5] = wb.y; w[jj][6] = wb.z; w[jj][7] = wb.w; }
        { const f32x4 ba = *(const GAS f32x4*)(cb + c0), bb = *(const GAS f32x4*)(cb + c0 + 4); bs[0] = ba.x; bs[1] = ba.y; bs[2] = ba.z; bs[3] = ba.w; bs[4] = bb.x; bs[5] = bb.y; bs[6] = bb.z; bs[7] = bb.w; }
        const float qs = c0 < TOKW ? 0.07216878364870322f : 1.0f;
#pragma unroll
        for (int i = 0; i < 16; ++i) { float acc[8];
#pragma unroll
            for (int j = 0; j < 8; ++j) acc[j] = bs[j];
#pragma unroll
            for (int jj = 0; jj < 5; ++jj) { const v4u r = rw[i + jj];
                acc[0] += bflo(r.x) * w[jj][0]; acc[1] += bfhi(r.x) * w[jj][1]; acc[2] += bflo(r.y) * w[jj][2]; acc[3] += bfhi(r.y) * w[jj][3];
                acc[4] += bflo(r.z) * w[jj][4]; acc[5] += bfhi(r.z) * w[jj][5]; acc[6] += bflo(r.w) * w[jj][6]; acc[7] += bfhi(r.w) * w[jj][7]; }
#pragma unroll
            for (int j = 0; j < 8; ++j) acc[j] = acc[j] * __builtin_amdgcn_rcpf(1.0f + __expf(-acc[j])) * qs;
            *(GAS v4u*)(QKC + (size_t)(tok0 + i) * 1536 + c0) = (v4u){pk2(acc[0], acc[1]), pk2(acc[2], acc[3]), pk2(acc[4], acc[5]), pk2(acc[6], acc[7])}; }
    }
}
constexpr int ML_QS = 200, ML_TS = 72;
constexpr int MLO_Q = 0, MLO_K = MLO_Q + 64 * ML_QS * 2, MLO_KT = MLO_K + 64 * ML_QS * 2, MLO_VT = MLO_KT + 192 * ML_TS * 2, MLO_S = MLO_VT + 64 * ML_TS * 2, MLO_PX = MLO_S + 64 * ML_TS * 2,
              MLO_SC = MLO_PX + 16 * 64 * 16, MLO_MK = MLO_SC + 2 * 6 * 256, MLO_H = MLO_MK + 1024, MLO_END = MLO_H + 2 * 64 * 48 * 2;
static_assert(MLO_END <= RING_BYTES, "mLSTM LDS map");
constexpr size_t SCAL_TAIL = (size_t)64 * 3 * SEQ;
__device__ __forceinline__ void ml_gate_prepass(const Frame& F, const float* GATES, const float* gate_b, float* SCAL) {
    const int gw = F.vcu * NWAVES + F.wave, NGW = F.G * NWAVES, lane = F.lane;
    for (int job = gw; job < 64 * 64; job += NGW) {
        const int sid = job >> 6, ck = job & 63, b = sid >> 3, h = (sid >> 1) & 3, dir = sid & 1;
        const size_t tok = (size_t)b * SEQ + (dir ? SEQ - 64 * (ck + 1) : 64 * ck) + (dir ? 63 - lane : lane);
        const float li = GATES[tok * 16 + dir * 4 + h] + gate_b[dir * 4 + h], gf = GATES[tok * 16 + (2 + dir) * 4 + h] + gate_b[(2 + dir) * 4 + h];
        float bs = fminf(gf, 0.f) - log1pf(__expf(-fabsf(gf)));
#pragma unroll
        for (int o = 1; o < 64; o <<= 1) { const float t = __shfl_up(bs, o); if (lane >= o) bs += t; }
        const float a = li - bs; float A = a;
#pragma unroll
        for (int o = 1; o < 64; o <<= 1) { const float t = __shfl_up(A, o); if (lane >= o) A = fmaxf(A, t); }
        float* base = SCAL + (size_t)sid * 3 * SEQ + ck * 64 + lane;
        base[0] = bs; base[SEQ] = a; base[2 * SEQ] = A;
        if (lane == 63) { SCAL[SCAL_TAIL + sid * 128 + ck] = bs; SCAL[SCAL_TAIL + sid * 128 + 64 + ck] = A; }
    }
}
__device__ __forceinline__ void ml_scan_mfma(const Frame& F, const bf16* QKC, const bf16* VTG  , const float* SCAL, bf16* HOUT  ) {
#define ML_BAR() do { asm volatile("s_waitcnt lgkmcnt(0)" ::: "memory"); __builtin_amdgcn_s_barrier(); asm volatile("" ::: "memory"); } while (0)
    const int x = F.bx & 7, jb = F.bx >> 3;
    const int sid = x * 8 + (jb >> 2), slice = jb & 3;
    const int b = sid >> 3, h = (sid >> 1) & 3, dir = sid & 1;
    const int tid = F.tid, lane = F.lane, wave = F.wave, fr = lane & 15, fq = lane >> 4, et = wave & 3, hf = wave >> 2;
    LAS bf16* Qs = (LAS bf16*)(F.lds + MLO_Q); LAS bf16* Ks = (LAS bf16*)(F.lds + MLO_K); LAS bf16* KTs = (LAS bf16*)(F.lds + MLO_KT);
    LAS bf16* VTs = (LAS bf16*)(F.lds + MLO_VT); LAS bf16* Ss = (LAS bf16*)(F.lds + MLO_S); LAS f32x4* PX = (LAS f32x4*)(F.lds + MLO_PX); LAS float* SC = (LAS float*)(F.lds + MLO_SC);
    for (int i = tid; i < 16 * ML_TS; i += NTHREADS) { const int rr = i / ML_TS, cc = i % ML_TS; VTs[(4 * rr + 3) * ML_TS + cc] = (bf16)0x3F80; }
    LAS float* MK = (LAS float*)(F.lds + MLO_MK); LAS float* B63 = MK + 80;
    if (tid < 64) { B63[tid] = SCAL[SCAL_TAIL + sid * 128 + tid]; B63[64 + tid] = SCAL[SCAL_TAIL + sid * 128 + 64 + tid]; }
    asm volatile("s_waitcnt vmcnt(0) lgkmcnt(0)" ::: "memory"); __builtin_amdgcn_s_barrier(); asm volatile("" ::: "memory");
    if (tid == 0) { float mm = 0.f; MK[0] = 0.f; for (int k = 0; k < 64; ++k) { mm = B63[k] + fmaxf(mm, B63[64 + k]); MK[k + 1] = mm; } }
    f32x4 C[3][2];
#pragma unroll
    for (int i = 0; i < 3; ++i) { C[i][0] = (f32x4){0.f, 0.f, 0.f, 0.f}; C[i][1] = (f32x4){0.f, 0.f, 0.f, 0.f}; }
    v4u qreg[3], kreg[3], vreg = (v4u){0u, 0u, 0u, 0u}; float g_bs = 0.f, g_a = 0.f, g_A = 0.f;
    LAS bf16* Hs = (LAS bf16*)(F.lds + MLO_H);
    size_t hbase1 = 0, hbase2 = 0;
    f32x4 num[4] = {{0.f, 0.f, 0.f, 0.f}, {0.f, 0.f, 0.f, 0.f}, {0.f, 0.f, 0.f, 0.f}, {0.f, 0.f, 0.f, 0.f}};
    const int prow[3] = {tid / 24, (tid + 512) / 24, (tid + 1024) / 24}; const int pc[3] = {tid % 24, (tid + 512) % 24, (tid + 1024) % 24};
    const int vrow = tid >> 3, vc = tid & 7;
#define ML_PREFETCH(kk) do { const size_t tb_ = (size_t)b * SEQ + (dir ? SEQ - 64 * ((kk) + 1) : 64 * (kk)); \
        _Pragma("unroll") for (int i_ = 0; i_ < 3; ++i_) { qreg[i_] = *(const GAS v4u*)(QKC + (tb_ + prow[i_]) * 1536 + h * 192 + 8 * pc[i_]); kreg[i_] = *(const GAS v4u*)(QKC + (tb_ + prow[i_]) * 1536 + 768 + h * 192 + 8 * pc[i_]); } \
        if (tid < 384) vreg = *(const GAS v4u*)(VTG + (size_t)(h * 192 + slice * 48 + vrow) * M + tb_ + 8 * vc); \
        if (wave == 0) { const float* sp_ = SCAL + (size_t)sid * 3 * SEQ + (kk) * 64 + lane; g_bs = sp_[0]; g_a = sp_[SEQ]; g_A = sp_[2 * SEQ]; } } while (0)
    ML_PREFETCH(0);
    ML_BAR();
    unsigned long long sp_t = 0, sp_acc = 0;
#define SP_MARK(r) do { if (MK_SUBPROBE != 0) { const unsigned long long n_ = __builtin_amdgcn_s_memrealtime(); if (MK_SUBPROBE == (r)) sp_acc += n_ - sp_t; sp_t = n_; } } while (0)
    if (MK_SUBPROBE != 0) sp_t = __builtin_amdgcn_s_memrealtime();
    for (int ck = 0; ck < SEQ / 64; ++ck) {
        const size_t tokbase = (size_t)b * SEQ + (dir ? SEQ - 64 * (ck + 1) : 64 * ck);
        LAS float* sc = SC + (ck & 1) * (6 * 64);
        if (wave == 0) {
            const float mk = MK[ck], mnew = MK[ck + 1], b63 = B63[ck], mt = g_bs + fmaxf(mk, g_A);
            const int p = dir ? 63 - lane : lane;
            sc[p] = g_bs - mt; sc[64 + p] = g_a; sc[128 + p] = __expf(g_bs + mk - mt); sc[192 + p] = __expf(b63 + g_a - mnew); sc[256 + p] = __expf(-mt);
            if (lane == 0) sc[320] = __expf(b63 + mk - mnew);
        }
#pragma unroll
        for (int i = 0; i < 3; ++i) { *(LAS v4u*)(Qs + prow[i] * ML_QS + 8 * pc[i]) = qreg[i]; *(LAS v4u*)(Ks + prow[i] * ML_QS + 8 * pc[i]) = kreg[i]; }
        if (tid < 384) *(LAS v4u*)(VTs + (16 * (vrow / 12) + 4 * ((vrow % 12) / 3) + (vrow % 12) % 3) * ML_TS + 8 * vc) = vreg;
        ML_BAR();
        { const int lt = wave >> 1, st0 = 2 * (wave & 1);
          bf16x8 qa[6], kb[2][6];
#pragma unroll
          for (int ks = 0; ks < 6; ++ks) { qa[ks] = *(const LAS bf16x8*)(Qs + (16 * lt + fr) * ML_QS + 32 * ks + 8 * fq);
              kb[0][ks] = *(const LAS bf16x8*)(Ks + (16 * st0 + fr) * ML_QS + 32 * ks + 8 * fq); kb[1][ks] = *(const LAS bf16x8*)(Ks + (16 * st0 + 16 + fr) * ML_QS + 32 * ks + 8 * fq); }
        if (ck > 0) {
            if (hf == 0) { LAS float* scp = SC + ((ck - 1) & 1) * (6 * 64); LAS bf16* Hw = Hs + ((ck - 1) & 1) * (64 * 48);
                f32x4 px[4];
#pragma unroll
                for (int lt = 0; lt < 4; ++lt) px[lt] = PX[(et * 4 + lt) * 64 + lane];
                const float em0 = scp[256 + fr], em1 = scp[256 + 16 + fr], em2 = scp[256 + 32 + fr], em3 = scp[256 + 48 + fr];
#pragma unroll
                for (int lt = 0; lt < 4; ++lt) { const f32x4 o = num[lt] + px[lt]; const float em = lt == 0 ? em0 : (lt == 1 ? em1 : (lt == 2 ? em2 : em3));
                    const float rden = __builtin_amdgcn_rcpf(fmaxf(fabsf(o[3]), em));
                    const unsigned w01 = pk2(o[0] * rden, o[1] * rden), w2 = pk2(o[2] * rden, 0.f); LAS bf16* hq = Hw + (16 * lt + fr) * 48 + 12 * et + 3 * fq;
                    hq[0] = (bf16)(w01 & 0xffffu); hq[1] = (bf16)(w01 >> 16); hq[2] = (bf16)(w2 & 0xffffu); } }
            if (ck > 1 && tid < 384) *(GAS v4u*)(HOUT + hbase2 + (size_t)(tid / 6) * TOKW + 8 * (tid % 6)) = *(const LAS v4u*)(Hs + (ck & 1) * (64 * 48) + (tid / 6) * 48 + 8 * (tid % 6));
        }
        { const float w = sc[192 + lane];
#pragma unroll
          for (int i = 0; i < 3; ++i) { const v4u kr = *(const LAS v4u*)(Ks + lane * ML_QS + 24 * wave + 8 * i); const unsigned kw[4] = {kr.x, kr.y, kr.z, kr.w};
#pragma unroll
            for (int e = 0; e < 4; ++e) { const unsigned pw = pk2(bflo(kw[e]) * w, bfhi(kw[e]) * w);
                KTs[(24 * wave + 8 * i + 2 * e) * ML_TS + lane] = (bf16)(pw & 0xffffu); KTs[(24 * wave + 8 * i + 2 * e + 1) * ML_TS + lane] = (bf16)(pw >> 16); } } }
        if (ck + 1 < SEQ / 64) ML_PREFETCH(ck + 1);
          __builtin_amdgcn_sched_barrier(0);
          f32x4 acc[2] = {{0.f, 0.f, 0.f, 0.f}, {0.f, 0.f, 0.f, 0.f}};
          __builtin_amdgcn_s_setprio(1);
#pragma unroll
          for (int ks = 0; ks < 6; ++ks) { acc[0] = __builtin_amdgcn_mfma_f32_16x16x32_bf16(qa[ks], kb[0][ks], acc[0], 0, 0, 0); acc[1] = __builtin_amdgcn_mfma_f32_16x16x32_bf16(qa[ks], kb[1][ks], acc[1], 0, 0, 0); }
          __builtin_amdgcn_s_setprio(0);
          const f32x4 rt = *(const LAS f32x4*)(sc + 16 * lt + 4 * fq); const float ct0 = sc[64 + 16 * st0 + fr], ct1 = sc[64 + 16 * st0 + 16 + fr];
#pragma unroll
          for (int u = 0; u < 2; ++u) { const int scol = 16 * (st0 + u) + fr; const float ct = u ? ct1 : ct0;
#pragma unroll
            for (int j = 0; j < 4; ++j) { const int l = 16 * lt + 4 * fq + j; const bool ok = dir ? (scol >= l) : (scol <= l);
                const float ev = acc[u][j] * __expf(fminf(rt[j] + ct, 0.f)); Ss[l * ML_TS + scol] = (bf16)f2bf(ok ? ev : 0.f); } } }
        ML_BAR();
        { bf16x8 qf[4][3], sf[2][2], vf[2], kt[3][2][2];
#pragma unroll
          for (int lt = 0; lt < 4; ++lt)
#pragma unroll
            for (int blk = 0; blk < 3; ++blk) qf[lt][blk] = *(const LAS bf16x8*)(Qs + (16 * lt + fr) * ML_QS + 96 * hf + 32 * blk + 8 * fq);
#pragma unroll
          for (int ks = 0; ks < 2; ++ks) { vf[ks] = *(const LAS bf16x8*)(VTs + (16 * et + fr) * ML_TS + 32 * ks + 8 * fq);
#pragma unroll
            for (int u = 0; u < 2; ++u) sf[u][ks] = *(const LAS bf16x8*)(Ss + (16 * (2 * hf + u) + fr) * ML_TS + 32 * ks + 8 * fq); }
#pragma unroll
          for (int blk = 0; blk < 3; ++blk)
#pragma unroll
            for (int t = 0; t < 2; ++t)
#pragma unroll
              for (int ks = 0; ks < 2; ++ks) kt[blk][t][ks] = *(const LAS bf16x8*)(KTs + (96 * hf + 32 * blk + 8 * (fr >> 2) + 4 * t + (fr & 3)) * ML_TS + 32 * ks + 8 * fq);
          float wi[4];
#pragma unroll
          for (int lt = 0; lt < 4; ++lt) wi[lt] = sc[128 + 16 * lt + fr];
          const float decay = sc[320];
          __builtin_amdgcn_sched_barrier(0);
          __builtin_amdgcn_s_setprio(1);
#pragma unroll
          for (int lt = 0; lt < 4; ++lt) num[lt] = (f32x4){0.f, 0.f, 0.f, 0.f};
#pragma unroll
          for (int blk = 0; blk < 3; ++blk) { const u32x4 cw = {pk2(C[blk][0][0], C[blk][0][1]), pk2(C[blk][0][2], C[blk][0][3]), pk2(C[blk][1][0], C[blk][1][1]), pk2(C[blk][1][2], C[blk][1][3])};
            const bf16x8 cf = __builtin_bit_cast(bf16x8, cw);
#pragma unroll
            for (int lt = 0; lt < 4; ++lt) num[lt] = __builtin_amdgcn_mfma_f32_16x16x32_bf16(cf, qf[lt][blk], num[lt], 0, 0, 0); }
#pragma unroll
          for (int blk = 0; blk < 3; ++blk)
#pragma unroll
            for (int t = 0; t < 2; ++t) { C[blk][t] = C[blk][t] * decay;
#pragma unroll
                for (int ks = 0; ks < 2; ++ks) C[blk][t] = __builtin_amdgcn_mfma_f32_16x16x32_bf16(kt[blk][t][ks], vf[ks], C[blk][t], 0, 0, 0); }
#pragma unroll
          for (int lt = 0; lt < 4; ++lt) num[lt] = num[lt] * wi[lt];
          if (hf == 0) {
#pragma unroll
            for (int u = 0; u < 2; ++u)
#pragma unroll
              for (int ks = 0; ks < 2; ++ks) num[u] = __builtin_amdgcn_mfma_f32_16x16x32_bf16(vf[ks], sf[u][ks], num[u], 0, 0, 0);
          } else {
#pragma unroll
            for (int u = 0; u < 2; ++u)
#pragma unroll
              for (int ks = 0; ks < 2; ++ks) num[2 + u] = __builtin_amdgcn_mfma_f32_16x16x32_bf16(vf[ks], sf[u][ks], num[2 + u], 0, 0, 0);
#pragma unroll
            for (int lt = 0; lt < 4; ++lt) PX[(et * 4 + lt) * 64 + lane] = num[lt];
          }
          __builtin_amdgcn_s_setprio(0); }
        ML_BAR();
        hbase2 = hbase1; hbase1 = (size_t)dir * M * TOKW + tokbase * TOKW + h * 192 + slice * 48;
    }
    if (MK_SUBPROBE != 0 && F.bx == 0 && tid == 0) *(LAS unsigned long long*)(F.lds + L_PROBE) += sp_acc;
    if (hf == 0) { LAS float* scp = SC + 1 * (6 * 64); LAS bf16* Hw = Hs + 1 * (64 * 48);
        f32x4 px[4];
#pragma unroll
        for (int lt = 0; lt < 4; ++lt) px[lt] = PX[(et * 4 + lt) * 64 + lane];
        const float em0 = scp[256 + fr], em1 = scp[256 + 16 + fr], em2 = scp[256 + 32 + fr], em3 = scp[256 + 48 + fr];
#pragma unroll
        for (int lt = 0; lt < 4; ++lt) { const f32x4 o = num[lt] + px[lt]; const float em = lt == 0 ? em0 : (lt == 1 ? em1 : (lt == 2 ? em2 : em3));
            const float rden = __builtin_amdgcn_rcpf(fmaxf(fabsf(o[3]), em));
            const unsigned w01 = pk2(o[0] * rden, o[1] * rden), w2 = pk2(o[2] * rden, 0.f); LAS bf16* hq = Hw + (16 * lt + fr) * 48 + 12 * et + 3 * fq;
            hq[0] = (bf16)(w01 & 0xffffu); hq[1] = (bf16)(w01 >> 16); hq[2] = (bf16)(w2 & 0xffffu); } }
    ML_BAR();
    if (tid < 384) { *(GAS v4u*)(HOUT + hbase2 + (size_t)(tid / 6) * TOKW + 8 * (tid % 6)) = *(const LAS v4u*)(Hs + (tid / 6) * 48 + 8 * (tid % 6));
                     *(GAS v4u*)(HOUT + hbase1 + (size_t)(tid / 6) * TOKW + 8 * (tid % 6)) = *(const LAS v4u*)(Hs + 64 * 48 + (tid / 6) * 48 + 8 * (tid % 6)); }
#undef SP_MARK
#undef ML_PREFETCH
#undef ML_BAR
}
__device__ __forceinline__ float row16_sum(float v) {
    v += dpp_mov<0xB1>(v); v += dpp_mov<0x4E>(v); v += dpp_mov<0x141>(v); v += dpp_mov<0x140>(v); return v;
}
__device__ __forceinline__ void ml_norm_gate(const Frame& F, const bf16* PROJ, const bf16* HOUT, const float* norm_g  , bf16* MIXED) {
    const int gw = F.vcu * NWAVES + F.wave, NGW = F.G * NWAVES, lane = F.lane;
    const int c0 = lane * 12;
    float ng[12];
#pragma unroll
    for (int i = 0; i < 3; ++i) { const f32x4 t = *(const GAS f32x4*)(norm_g + c0 + 4 * i); ng[4 * i] = t.x; ng[4 * i + 1] = t.y; ng[4 * i + 2] = t.z; ng[4 * i + 3] = t.w; }
    typedef unsigned u32x2v __attribute__((ext_vector_type(2)));
    u32x2v ca[3], cb[3], co[3];
    int tok = gw;
    if (tok < M) {
#pragma unroll
        for (int i = 0; i < 3; ++i) { ca[i] = *(const GAS u32x2v*)(HOUT + (size_t)tok * TOKW + c0 + 4 * i); cb[i] = *(const GAS u32x2v*)(HOUT + (size_t)M * TOKW + (size_t)tok * TOKW + c0 + 4 * i);
            co[i] = *(const GAS u32x2v*)(PROJ + (size_t)tok * ML_LDP + 1536 + c0 + 4 * i); } }
    while (tok < M) {
        const int ntok = tok + NGW; u32x2v na[3], nb[3], no[3];
        if (ntok < M) {
#pragma unroll
            for (int i = 0; i < 3; ++i) { na[i] = *(const GAS u32x2v*)(HOUT + (size_t)ntok * TOKW + c0 + 4 * i); nb[i] = *(const GAS u32x2v*)(HOUT + (size_t)M * TOKW + (size_t)ntok * TOKW + c0 + 4 * i);
                no[i] = *(const GAS u32x2v*)(PROJ + (size_t)ntok * ML_LDP + 1536 + c0 + 4 * i); } }
        float v[12], op[12]; float s = 0.f;
#pragma unroll
        for (int i = 0; i < 3; ++i) { const u32x2v a = ca[i], b = cb[i], o = co[i];
            v[4 * i] = bflo(a.x) + bflo(b.x); v[4 * i + 1] = bfhi(a.x) + bfhi(b.x); v[4 * i + 2] = bflo(a.y) + bflo(b.y); v[4 * i + 3] = bfhi(a.y) + bfhi(b.y);
            op[4 * i] = bflo(o.x); op[4 * i + 1] = bfhi(o.x); op[4 * i + 2] = bflo(o.y); op[4 * i + 3] = bfhi(o.y); }
#pragma unroll
        for (int i = 0; i < 12; ++i) s += v[i];
        const float mu = row16_sum(s) * (1.0f / 192.0f); float q = 0.f;
#pragma unroll
        for (int i = 0; i < 12; ++i) { v[i] -= mu; q += v[i] * v[i]; }
        const float rstd = 1.0f / sqrtf(row16_sum(q) * (1.0f / 192.0f) + LN_EPS);
        float r[12];
#pragma unroll
        for (int i = 0; i < 12; ++i) r[i] = v[i] * rstd * ng[i] * __builtin_amdgcn_rcpf(1.0f + __expf(-op[i]));
#pragma unroll
        for (int i = 0; i < 3; ++i) *(GAS u32x2v*)(MIXED + (size_t)tok * D + c0 + 4 * i) = (u32x2v){pk2(r[4 * i], r[4 * i + 1]), pk2(r[4 * i + 2], r[4 * i + 3])};
#pragma unroll
        for (int i = 0; i < 3; ++i) { ca[i] = na[i]; cb[i] = nb[i]; co[i] = no[i]; }
        tok = ntok;
    }
}

__device__ __forceinline__ void pd_loadx(u32x4 (&dst)[4], const bf16* xr, int blk) {
#pragma unroll
    for (int q = 0; q < 4; ++q) dst[q] = *(const GAS u32x4*)(xr + 32 * (4 * blk + q));
}
constexpr int PD_ROWB = 272, PD_SLICE = 96 * PD_ROWB;
__device__ __forceinline__ void pd_block(const u32x4 (&cur)[4], const LAS unsigned char* wsl, int fr, int fq, f32x4 (&acc)[3], float& s, float& s2) {
    bf16x8 wh[4][3], wl[4][3];
#pragma unroll
    for (int q = 0; q < 4; ++q)
#pragma unroll
        for (int nt = 0; nt < 3; ++nt) { wh[q][nt] = *(const LAS bf16x8*)(wsl + (16 * nt + fr) * PD_ROWB + 64 * q + 16 * fq); wl[q][nt] = *(const LAS bf16x8*)(wsl + (48 + 16 * nt + fr) * PD_ROWB + 64 * q + 16 * fq); }
    __builtin_amdgcn_sched_barrier(0);
#pragma unroll
    for (int q = 0; q < 4; ++q) { const u32x4 w = cur[q];
        const float x0 = bflo(w.x), x1 = bfhi(w.x), x2 = bflo(w.y), x3 = bfhi(w.y), x4 = bflo(w.z), x5 = bfhi(w.z), x6 = bflo(w.w), x7 = bfhi(w.w);
        s += ((x0 + x1) + (x2 + x3)) + ((x4 + x5) + (x6 + x7));
        s2 += ((x0 * x0 + x1 * x1) + (x2 * x2 + x3 * x3)) + ((x4 * x4 + x5 * x5) + (x6 * x6 + x7 * x7));
        const bf16x8 ah = __builtin_bit_cast(bf16x8, w);
#pragma unroll
        for (int nt = 0; nt < 3; ++nt) {
            acc[nt] = __builtin_amdgcn_mfma_f32_16x16x32_bf16(ah, wh[q][nt], acc[nt], 0, 0, 0);
            acc[nt] = __builtin_amdgcn_mfma_f32_16x16x32_bf16(ah, wl[q][nt], acc[nt], 0, 0, 0); } }
}
__device__ __forceinline__ void ln1_route(const Frame& F, const bf16* PRE, const bf16* WR  , const float* RGB  , float* STATS,
                                           int* TOKE, float* TOKG, int* TOKP, int* ROWSLOT, gu32* cnt, int* WGBASE) {
    const int gw = F.vcu * NWAVES + F.wave, NGW = F.G * NWAVES, lane = F.lane, fr = lane & 15, fq = lane >> 4;
    LAS int* HIST = (LAS int*)(F.lds + L_HIST);
    LAS float* lg = (LAS float*)(F.lds + 8192 + F.wave * 4096);
    if (F.tid < 32) HIST[F.tid] = 0;
    { const int gt = F.vcu * NTHREADS + F.tid, NT = F.G * NTHREADS; for (int i = gt; i < P_MAX; i += NT) ROWSLOT[i] = -1; }
    __syncthreads();
    LAS unsigned char* wbuf = F.lds + 49152;
    for (int jb = F.vcu; jb < M / 128; jb += F.G) {
        const int job = jb * 8 + F.wave, row0 = job * 16;
        const bf16* xr = PRE + (size_t)(row0 + fr) * D + 8 * fq;
        float s = 0.f, s2 = 0.f;
        f32x4 acc[3] = {{0.f, 0.f, 0.f, 0.f}, {0.f, 0.f, 0.f, 0.f}, {0.f, 0.f, 0.f, 0.f}};
        const bf16* wsrc[3]; int wdst[3];
#pragma unroll
        for (int i = 0; i < 3; ++i) { const int q = F.tid + 512 * i; wsrc[i] = WR + (size_t)(q >> 4) * D + 8 * (q & 15); wdst[i] = (q >> 4) * PD_ROWB + 16 * (q & 15); }
        v4u wr[3];
#pragma unroll
        for (int i = 0; i < 3; ++i) wr[i] = *(const GAS v4u*)(wsrc[i]);
        u32x4 xa[4], xb[4];
        pd_loadx(xa, xr, 0);
        __syncthreads();
#pragma unroll
        for (int i = 0; i < 3; ++i) *(LAS v4u*)(wbuf + wdst[i]) = wr[i];
#pragma unroll
        for (int i = 0; i < 3; ++i) wr[i] = *(const GAS v4u*)(wsrc[i] + 128);
        __syncthreads();
#pragma unroll 1
        for (int bp = 0; bp < 4; ++bp) {
            pd_loadx(xb, xr, 2 * bp + 1);
            pd_block(xa, wbuf, fr, fq, acc, s, s2);
#pragma unroll
            for (int i = 0; i < 3; ++i) *(LAS v4u*)(wbuf + PD_SLICE + wdst[i]) = wr[i];
            if (bp < 3) {
#pragma unroll
                for (int i = 0; i < 3; ++i) wr[i] = *(const GAS v4u*)(wsrc[i] + 128 * (2 * bp + 2)); }
            __syncthreads();
            if (bp < 3) pd_loadx(xa, xr, 2 * bp + 2);
            pd_block(xb, wbuf + PD_SLICE, fr, fq, acc, s, s2);
            if (bp < 3) {
#pragma unroll
                for (int i = 0; i < 3; ++i) *(LAS v4u*)(wbuf + wdst[i]) = wr[i];
#pragma unroll
                for (int i = 0; i < 3; ++i) wr[i] = *(const GAS v4u*)(wsrc[i] + 128 * (2 * bp + 3)); }
            __syncthreads();
        }
        s = qd_sum(s); s2 = qd_sum(s2);
        const float mean = s * (1.f / D), rstd = 1.f / sqrtf(fmaxf(s2 * (1.f / D) - mean * mean, 0.f) + LN_EPS);
#pragma unroll
        for (int nt = 0; nt < 3; ++nt)
#pragma unroll
            for (int j = 0; j < 4; ++j) lg[(4 * fq + j) * 52 + 16 * nt + fr] = acc[nt][j];
        asm volatile("s_waitcnt lgkmcnt(0)" ::: "memory");
        if (lane < 16) {
            const LAS float* lr = lg + lane * 52; const int row = row0 + lane;
            STATS[2 * row] = mean; STATS[2 * row + 1] = rstd;
            float gl[4];
#pragma unroll
            for (int g = 0; g < 4; ++g) gl[g] = rstd * (lr[g] - mean * RGB[g]) + RGB[48 + g];
            int gi = 0; float gm = gl[0];
#pragma unroll
            for (int g = 1; g < 4; ++g) if (gl[g] > gm) { gm = gl[g]; gi = g; }
            float gs = 0.f;
#pragma unroll
            for (int g = 0; g < 4; ++g) gs += __expf(gl[g] - gm);
            const float ggate = 1.0f / gs;
            float el[8];
#pragma unroll
            for (int i = 0; i < 8; ++i) el[i] = rstd * (lr[4 + gi * 8 + i] - mean * RGB[4 + gi * 8 + i]) + RGB[48 + 4 + gi * 8 + i];
            int i0 = 0; float l0 = el[0];
#pragma unroll
            for (int i = 1; i < 8; ++i) if (el[i] > l0) { l0 = el[i]; i0 = i; }
            int i1 = -1; float l1 = -INFINITY;
#pragma unroll
            for (int i = 0; i < 8; ++i) if (i != i0 && el[i] > l1) { l1 = el[i]; i1 = i; }
            const float p0 = 1.0f / (1.0f + __expf(l1 - l0)), p1 = 1.0f - p0;
            const int e0 = gi * 8 + i0, e1 = gi * 8 + i1;
            const int q0 = atomicAdd((int*)(HIST + e0), 1), q1 = atomicAdd((int*)(HIST + e1), 1);
            TOKE[2 * row] = e0; TOKE[2 * row + 1] = e1; TOKG[2 * row] = ggate * p0; TOKG[2 * row + 1] = ggate * p1; TOKP[2 * row] = q0; TOKP[2 * row + 1] = q1;
        }
    }
    __syncthreads();
    if (F.tid < 32) WGBASE[F.tid] = (int)__hip_atomic_fetch_add(cnt + F.tid, (unsigned)HIST[F.tid], __ATOMIC_RELAXED, __HIP_MEMORY_SCOPE_AGENT);
    __syncthreads();
}
__device__ __forceinline__ void moe_gather(const Frame& F, const bf16* PRE, const float* STATS, const float* g1, const float* b1, const int* TOKE, const float* TOKG, const int* TOKP, int* ROWSLOT, float* ROWGATE, bf16* XS, gu32* cnt, int* TILETAB, const int* WGBASE) {
    const int gw = F.vcu * NWAVES + F.wave, NGW = F.G * NWAVES, lane = F.lane;
    LAS int* PADSTART = (LAS int*)(F.lds + L_PADSTART); LAS int* CNT = (LAS int*)(F.lds + L_CNT);
    if (F.tid < 32) CNT[F.tid] = (int)__hip_atomic_load(cnt + F.tid, __ATOMIC_RELAXED, __HIP_MEMORY_SCOPE_AGENT);
    __syncthreads();
    if (F.tid == 0) { int t = 0;
        for (int e = 0; e < NEXP; ++e) { PADSTART[e] = t * 256; const int nt = (CNT[e] + 255) >> 8;
            if (F.bx == 0) for (int k = 0; k < nt; ++k) TILETAB[1 + t + k] = e;
            t += nt; }
        if (F.bx == 0) TILETAB[0] = t; }
    __syncthreads();
    f32x4 G1[4], B1[4];
#pragma unroll
    for (int j = 0; j < 4; ++j) { const int col = 4 * lane + 256 * j; G1[j] = *(const GAS f32x4*)(g1 + col); B1[j] = *(const GAS f32x4*)(b1 + col); }
    for (int job = gw; job < M / 16; job += NGW) {
        unsigned long long xc[4]; float mc, rc; int ec0, ec1, qc0, qc1; float gc0, gc1;
        { const int row = job * 16;
#pragma unroll
          for (int j = 0; j < 4; ++j) xc[j] = ((const GAS unsigned long long*)(PRE + (size_t)row * D) + lane)[64 * j];
          mc = STATS[2 * row]; rc = STATS[2 * row + 1]; ec0 = TOKE[2 * row]; ec1 = TOKE[2 * row + 1]; qc0 = TOKP[2 * row]; qc1 = TOKP[2 * row + 1]; gc0 = TOKG[2 * row]; gc1 = TOKG[2 * row + 1]; }
        for (int ri = 0; ri < 16; ++ri) { const int row = job * 16 + ri;
            unsigned long long xn[4]; float mn = 0.f, rn = 0.f; int en0 = 0, en1 = 0, qn0 = 0, qn1 = 0; float gn0 = 0.f, gn1 = 0.f;
            if (ri < 15) { const int nrow = row + 1;
#pragma unroll
                for (int j = 0; j < 4; ++j) xn[j] = ((const GAS unsigned long long*)(PRE + (size_t)nrow * D) + lane)[64 * j];
                mn = STATS[2 * nrow]; rn = STATS[2 * nrow + 1]; en0 = TOKE[2 * nrow]; en1 = TOKE[2 * nrow + 1]; qn0 = TOKP[2 * nrow]; qn1 = TOKP[2 * nrow + 1]; gn0 = TOKG[2 * nrow]; gn1 = TOKG[2 * nrow + 1]; }
            unsigned long long pk[4];
#pragma unroll
            for (int j = 0; j < 4; ++j) { const unsigned x0 = (unsigned)xc[j], x1 = (unsigned)(xc[j] >> 32); const f32x4 xf = {bflo(x0), bfhi(x0), bflo(x1), bfhi(x1)}; const f32x4 v = (xf - mc) * rc * G1[j] + B1[j]; pk[j] = (unsigned long long)pk2(v.x, v.y) | ((unsigned long long)pk2(v.z, v.w) << 32); }
#pragma unroll
            for (int k = 0; k < 2; ++k) { const int e = k ? ec1 : ec0, q = k ? qc1 : qc0; const int dest = PADSTART[e] + WGBASE[e] + q;
                if (lane == 0) { ROWSLOT[dest] = 2 * row + k; ROWGATE[dest] = k ? gc1 : gc0; }
                GAS unsigned long long* o8 = (GAS unsigned long long*)(XS + (size_t)dest * D) + lane;
#pragma unroll
                for (int j = 0; j < 4; ++j) o8[64 * j] = pk[j]; }
#pragma unroll
            for (int j = 0; j < 4; ++j) xc[j] = xn[j];
            mc = mn; rc = rn; ec0 = en0; ec1 = en1; qc0 = qn0; qc1 = qn1; gc0 = gn0; gc1 = gn1;
        }
    }
}
__device__ __forceinline__ void ln2_pass(const Frame& F, const bf16* PRE, const float* STATS, const float* g1, const float* b1, const bf16* Y, const float* g2, const float* b2, float* XOUT  , bf16* XB) {
    const int gw = F.vcu * NWAVES + F.wave, NGW = F.G * NWAVES, lane = F.lane;
    typedef unsigned long long u64;
    f32x4 G1[4], B1[4], G2[4], B2[4];
#pragma unroll
    for (int j = 0; j < 4; ++j) { const int col = 4 * lane + 256 * j; G1[j] = *(const GAS f32x4*)(g1 + col); B1[j] = *(const GAS f32x4*)(b1 + col); G2[j] = *(const GAS f32x4*)(g2 + col); B2[j] = *(const GAS f32x4*)(b2 + col); }
    u64 xc[4], y0c[4], y1c[4]; float m1c = 0.f, r1c = 0.f;
    int row = gw;
    if (row < M) {
#pragma unroll
        for (int j = 0; j < 4; ++j) { xc[j] = ((const GAS u64*)(PRE + (size_t)row * D) + lane)[64 * j]; y0c[j] = ((const GAS u64*)(Y + (size_t)(2 * row) * D) + lane)[64 * j]; y1c[j] = ((const GAS u64*)(Y + (size_t)(2 * row + 1) * D) + lane)[64 * j]; }
        m1c = STATS[2 * row]; r1c = STATS[2 * row + 1]; }
    while (row < M) {
        const int nrow = row + NGW; u64 xn[4], y0n[4], y1n[4]; float m1n = 0.f, r1n = 0.f;
        if (nrow < M) {
#pragma unroll
            for (int j = 0; j < 4; ++j) { xn[j] = ((const GAS u64*)(PRE + (size_t)nrow * D) + lane)[64 * j]; y0n[j] = ((const GAS u64*)(Y + (size_t)(2 * nrow) * D) + lane)[64 * j]; y1n[j] = ((const GAS u64*)(Y + (size_t)(2 * nrow + 1) * D) + lane)[64 * j]; }
            m1n = STATS[2 * nrow]; r1n = STATS[2 * nrow + 1]; }
        f32x4 v[4]; float s = 0.f;
#pragma unroll
        for (int j = 0; j < 4; ++j) { const unsigned p0 = (unsigned)xc[j], p1 = (unsigned)(xc[j] >> 32); const f32x4 xf = {bflo(p0), bfhi(p0), bflo(p1), bfhi(p1)};
            const f32x4 x = (xf - m1c) * r1c * G1[j] + B1[j];
            const unsigned a0 = (unsigned)y0c[j], a1 = (unsigned)(y0c[j] >> 32), c0 = (unsigned)y1c[j], c1 = (unsigned)(y1c[j] >> 32);
            v[j].x = ALPHA * x.x + (bflo(a0) + bflo(c0)); v[j].y = ALPHA * x.y + (bfhi(a0) + bfhi(c0)); v[j].z = ALPHA * x.z + (bflo(a1) + bflo(c1)); v[j].w = ALPHA * x.w + (bfhi(a1) + bfhi(c1));
            s += (v[j].x + v[j].y) + (v[j].z + v[j].w); }
        const float mean = wave_sum(s) * (1.f / D); float s2 = 0.f;
#pragma unroll
        for (int j = 0; j < 4; ++j) { v[j] = v[j] - mean; s2 += (v[j].x * v[j].x + v[j].y * v[j].y) + (v[j].z * v[j].z + v[j].w * v[j].w); }
        const float rstd = 1.f / sqrtf(wave_sum(s2) * (1.f / D) + LN_EPS);
        GAS f32x4* orow = (GAS f32x4*)(XOUT + (size_t)row * D) + lane; GAS u64* ob = (GAS u64*)(XB + (size_t)row * D) + lane;
#pragma unroll
        for (int j = 0; j < 4; ++j) { const f32x4 y = v[j] * rstd * G2[j] + B2[j]; if (XOUT != nullptr) orow[64 * j] = y; else ob[64 * j] = (u64)pk2(y.x, y.y) | ((u64)pk2(y.z, y.w) << 32); }
#pragma unroll
        for (int j = 0; j < 4; ++j) { xc[j] = xn[j]; y0c[j] = y0n[j]; y1c[j] = y1n[j]; }
        m1c = m1n; r1c = r1n; row = nrow;
    }
}

struct Args { const float* in[22]; float* out; unsigned char* ws; int ph_lo, ph_hi; };
static_assert(sizeof(Args) == 22 * 8 + 8 + 8 + 8, "Args has no padding");
enum PhaseKind { K_P0 = 0, K_P1, K_PA, K_PB, K_PB2, K_PB3, K_PC, K_PD, K_PE, K_PF, K_PG, K_PH };
constexpr int N_PHASES = 2 + 2 * 8 + 2 * 10;
__device__ __forceinline__ void decode_phase(int ph, int& layer, int& kind) {
    if (ph < 2) { layer = 0; kind = ph; return; }
    int r = ph - 2; const int pair = r / 18; r -= pair * 18;
    if (r < 8) { layer = 2 * pair; kind = r == 0 ? K_PA : (r == 1 ? K_PB : K_PC + (r - 2)); }
    else { r -= 8; layer = 2 * pair + 1; kind = K_PA + r; }
}
__host__ __device__ constexpr int phase_layer(int ph) { if (ph < 2) return 0; int r = ph - 2; const int pair = r / 18; r -= pair * 18; return r < 8 ? 2 * pair : 2 * pair + 1; }
__host__ __device__ constexpr int phase_kind(int ph) { if (ph < 2) return ph; int r = ph - 2; const int pair = r / 18; r -= pair * 18;
    if (r < 8) return r == 0 ? K_PA : (r == 1 ? K_PB : K_PC + (r - 2)); return K_PA + (r - 8); }
template <int PH>
__device__ __forceinline__ void run_phase(const Args& args, LAS unsigned char* lds) {
    constexpr int layer = phase_layer(PH), kind = phase_kind(PH), jj = layer >> 1; constexpr bool is_na = (layer & 1) == 0;
    int tid_ = threadIdx.x; asm volatile("" : "+v"(tid_));
    int bx_ = blockIdx.x; asm volatile("" : "+s"(bx_));
    Frame F;
    F.lds = lds;
    F.tid = tid_; F.lane = F.tid & 63; F.wave = __builtin_amdgcn_readfirstlane(F.tid >> 6);
    F.G = gridDim.x; F.bx = bx_; F.vcu = (F.G % 8 == 0) ? (bx_ % 8) * (F.G / 8) + bx_ / 8 : bx_;
    unsigned char* ws = args.ws; asm volatile("" : "+s"(ws)); F.ctl = (gu32*)(ws + WS_CTL);
    float* const outp = args.out;
#define IN_(k) (args.in[k])
        if constexpr (kind == K_P0) {
        P0Args a{IN_(0), IN_(1), IN_(2), IN_(3), IN_(5), IN_(10), IN_(19), IN_(20), IN_(21), IN_(15), IN_(17), IN_(11), IN_(12), IN_(16), IN_(18), ws};
        p0_prologue(F, a);
    }
    if constexpr (kind == K_P1) {
        { pg8::Gemm g{(const bf16*)(ws + WS_MEMB), (const bf16*)(ws + WS_WMEMKV), BATCH * NMEM, 256, D}; pg8::StaticOrder S; S.init(BATCH * NMEM, 256, F.G, F.bx);
          pg8::EpiProj E{(bf16*)(ws + WS_MEMK), 256, nullptr, 0};
          pg8::gemm_phase<pg8::EpiProj, pg8::StaticOrder, PG8_ALIGN, PG8_SP2>(F.lds, g, S, E); }
        { pg8::Gemm g{(const bf16*)(ws + WS_WMEMKV) + (size_t)256 * D, (const bf16*)(ws + WS_MEMB), 256, BATCH * NMEM, D}; pg8::StaticOrder S; S.init(256, BATCH * NMEM, F.G, (F.bx + 128) % F.G);
          pg8::EpiProj E{(bf16*)(ws + WS_MEMVT), BATCH * NMEM, nullptr, 0};
          pg8::gemm_phase<pg8::EpiProj, pg8::StaticOrder, PG8_ALIGN, PG8_SP2>(F.lds, g, S, E); }
    }
    if constexpr (kind == K_PA) {
        if constexpr (is_na) {
            const bf16* W = (const bf16*)(ws + WS_WINNA) + (size_t)jj * NA_IN * D;
            { pg8::Gemm g{(const bf16*)(ws + WS_XB), W, M, NA_LDP, D}; pg8::StaticOrder S; S.init(M, NA_LDP, F.G, F.bx);
              pg8::EpiProj E{(bf16*)(ws + WS_PROJ), NA_LDP, nullptr, 0};
              pg8::gemm_phase<pg8::EpiProj, pg8::StaticOrder, PG8_ALIGN, PG8_SP2>(F.lds, g, S, E); }
            { pg8::Gemm g{W + (size_t)NA_LDP * D, (const bf16*)(ws + WS_XB), TOKW, M, D}; pg8::StaticOrder S; S.init(TOKW, M, F.G, (F.bx + 128) % F.G);
              pg8::EpiProj E{(bf16*)(ws + WS_VT), M, nullptr, 0};
              pg8::gemm_phase<pg8::EpiProj, pg8::StaticOrder, PG8_ALIGN, PG8_SP2>(F.lds, g, S, E); }
        } else {
            const bf16* W = (const bf16*)(ws + WS_WINML) + (size_t)jj * ML_INP * D;
            { pg8::Gemm g{(const bf16*)(ws + WS_XB), W, M, ML_LDP, D}; pg8::StaticOrder S; S.init(M, ML_LDP, F.G, F.bx);
              pg8::EpiProj E{(bf16*)(ws + WS_PROJ), ML_LDP, (float*)(ws + WS_GATES), ML_GATE_PN};
              pg8::gemm_phase<pg8::EpiProj, pg8::StaticOrder, PG8_ALIGN, PG8_SP2>(F.lds, g, S, E); }
            { pg8::Gemm g{W + (size_t)ML_LDP * D, (const bf16*)(ws + WS_XB), TOKW, M, D}; pg8::StaticOrder S; S.init(TOKW, M, F.G, (F.bx + 128) % F.G);
              pg8::EpiProj E{(bf16*)(ws + WS_VTML), M, nullptr, 0};
              pg8::gemm_phase<pg8::EpiProj, pg8::StaticOrder, PG8_ALIGN, PG8_SP2>(F.lds, g, S, E); }
        }
    }
    if constexpr (kind == K_PB) {
        if constexpr (is_na) attn_lds_cv(F, (const bf16*)(ws + WS_PROJ), (const bf16*)(ws + WS_VT), (const bf16*)(ws + WS_MEMK), (const bf16*)(ws + WS_MEMVT), IN_(4) + (size_t)jj * NAH * 15 * 31, (bf16*)(ws + WS_MIXED),
                                         CvArgs{IN_(19), IN_(20), IN_(21), (bf16*)(ws + WS_W13), (bf16*)(ws + WS_W2), 32768 + jj * 32768});
        else { attn_lds<false>(F, (const bf16*)(ws + WS_PROJ), nullptr, (const bf16*)(ws + WS_MEMK), (const bf16*)(ws + WS_MEMVT), nullptr, (bf16*)(ws + WS_MIXED));
               ml_conv(F, (const bf16*)(ws + WS_PROJ), IN_(6) + (size_t)jj * 5 * 1536, IN_(7) + (size_t)jj * 1536, (bf16*)(ws + WS_QKC));
               ml_gate_prepass(F, (const float*)(ws + WS_GATES), IN_(8) + (size_t)jj * 16, (float*)(ws + WS_SCAL)); }
    }
    if constexpr (kind == K_PB2) {
        ml_scan_mfma(F, (const bf16*)(ws + WS_QKC), (const bf16*)(ws + WS_VTML), (const float*)(ws + WS_SCAL), (bf16*)(ws + WS_H));
    }
    if constexpr (kind == K_PB3) {
        ml_norm_gate(F, (const bf16*)(ws + WS_PROJ), (const bf16*)(ws + WS_H), IN_(9) + (size_t)jj * TOKW, (bf16*)(ws + WS_MIXED));
    }
    if constexpr (kind == K_PC) {
        pg8::Gemm g{(const bf16*)(ws + WS_MIXED), (const bf16*)(ws + WS_WOUT) + (size_t)layer * D * D, M, D, D}; pg8::StaticOrder S; S.init(M, D, F.G, F.bx);
        pg8::EpiResBf16 E{(const bf16*)(ws + WS_XB), (bf16*)(ws + WS_PRE), D, ALPHA};
        pg8::gemm_phase<pg8::EpiResBf16, pg8::StaticOrder, PG8_ALIGN, PG8_SP2>(F.lds, g, S, E);
    }
    if constexpr (kind == K_PD) {
        ln1_route(F, (const bf16*)(ws + WS_PRE), (const bf16*)(ws + WS_WR) + (size_t)layer * 2 * 48 * D, (const float*)(ws + WS_RGB) + layer * 96, (float*)(ws + WS_STATS),
                  (int*)(ws + WS_TOKE), (float*)(ws + WS_TOKG), (int*)(ws + WS_TOKP), (int*)(ws + WS_ROWSLOT),
                  F.ctl + CW_CNT + 64 * layer, (int*)(ws + WS_MISC) + 1024 + 32 * F.bx);
    }
    if constexpr (kind == K_PE) {
        moe_gather(F, (const bf16*)(ws + WS_PRE), (const float*)(ws + WS_STATS), IN_(11) + (size_t)layer * D, IN_(12) + (size_t)layer * D, (const int*)(ws + WS_TOKE), (const float*)(ws + WS_TOKG), (const int*)(ws + WS_TOKP), (int*)(ws + WS_ROWSLOT), (float*)(ws + WS_ROWGATE),
                   (bf16*)(ws + WS_XS), F.ctl + CW_CNT + 64 * layer, (int*)(ws + WS_MISC), (const int*)(ws + WS_MISC) + 1024 + 32 * F.bx);
    }
    if constexpr (kind == K_PF) {
        const int* TILETAB = (const int*)(ws + WS_MISC);
        const int nT = __builtin_amdgcn_readfirstlane((int)ld_agent(TILETAB));
        pg8::Gemm g{(const bf16*)(ws + WS_XS), (const bf16*)(ws + WS_W13) + (size_t)layer * NEXP * 1024 * 1024, nT * 256, 1024, D}; pg8::GroupedOrder S; S.init(nT, 1024, F.G, F.bx, TILETAB + 1);
        pg8::EpiSwiGLU E{(bf16*)(ws + WS_HID), DEXP};
        pg8::gemm_phase<pg8::EpiSwiGLU, pg8::GroupedOrder, PG8_ALIGN, PG8_SP2>(F.lds, g, S, E);
    }
    if constexpr (kind == K_PG) {
        const int* TILETAB = (const int*)(ws + WS_MISC);
        const int nT = __builtin_amdgcn_readfirstlane((int)ld_agent(TILETAB));
        pg8::Gemm g{(const bf16*)(ws + WS_HID), (const bf16*)(ws + WS_W2) + (size_t)layer * NEXP * 1024 * 512, nT * 256, 1024, DEXP}; pg8::GroupedOrder S; S.init(nT, 1024, F.G, F.bx, TILETAB + 1);
        pg8::EpiMoeDown E{(bf16*)(ws + WS_Y), D, (const int*)(ws + WS_ROWSLOT), (const float*)(ws + WS_ROWGATE)};
        pg8::gemm_phase<pg8::EpiMoeDown, pg8::GroupedOrder, PG8_ALIGN, PG8_SP2>(F.lds, g, S, E);
    }
    if constexpr (kind == K_PH) {
        ln2_pass(F, (const bf16*)(ws + WS_PRE), (const float*)(ws + WS_STATS), IN_(11) + (size_t)layer * D, IN_(12) + (size_t)layer * D, (const bf16*)(ws + WS_Y), IN_(13) + (size_t)layer * D, IN_(14) + (size_t)layer * D, layer == DEPTH - 1 ? outp : nullptr, (bf16*)(ws + WS_XB));
    }
}
#ifndef MK_PROBE_MASK
#define MK_PROBE_MASK 0ull
#endif
#define MK_PROBE_AMP 10ull
template <int PH>
__device__ __forceinline__ void run_all(const Args& args, LAS unsigned char* lds, int lo, int hi, const XcdBarrier& bar, unsigned long long& tacc) {
    if constexpr (PH < N_PHASES) {
        if (lo <= PH && PH < hi) {
            unsigned long long t0 = 0;
            if constexpr (((MK_PROBE_MASK >> PH) & 1ull) != 0ull) t0 = __builtin_amdgcn_s_memrealtime();
            run_phase<PH>(args, lds); if (PH + 1 < hi) xcd_barrier(bar);
            if constexpr (((MK_PROBE_MASK >> PH) & 1ull) != 0ull) tacc += __builtin_amdgcn_s_memrealtime() - t0;
        }
        run_all<PH + 1>(args, lds, lo, hi, bar, tacc);
    }
}
__global__ void __launch_bounds__(NTHREADS, 2) mk_fwd(Args args) {
    extern __shared__ __attribute__((aligned(16))) unsigned char lds[];
    for (int u = threadIdx.x; u < LDSCTL_BYTES / 4; u += NTHREADS) ((LAS unsigned*)((LAS unsigned char*)lds + LDSCTL_OFF))[u] = 0u;
    __syncthreads();
    const int lo = args.ph_lo, hi = args.ph_hi;
    XcdBarrier bar; bar.bar = (unsigned*)((gu32*)(args.ws + WS_CTL) + CW_BAR); bar.x = 0; bar.st = nullptr;
    if (hi - lo > 1) bar = xcd_barrier_post((unsigned*)((gu32*)(args.ws + WS_CTL) + CW_BAR), (volatile LAS unsigned*)((LAS unsigned char*)lds + L_MISC) + 8);
    unsigned long long tacc = 0;
    run_all<0>(args, (LAS unsigned char*)lds, lo, hi, bar, tacc);
    if ((MK_PROBE_MASK != 0ull || MK_SUBPROBE != 0) && blockIdx.x == 0 && threadIdx.x == 0) {
        if (MK_SUBPROBE != 0) tacc += *(LAS unsigned long long*)((LAS unsigned char*)lds + L_PROBE);
        const unsigned long long t_end = __builtin_amdgcn_s_memrealtime() + MK_PROBE_AMP * tacc;
        while (__builtin_amdgcn_s_memrealtime() < t_end) __builtin_amdgcn_s_sleep(32);
    }
}

#ifndef MK_PER_PHASE
#define MK_PER_PHASE 0
#endif
extern "C" void kernel_launch(void* const* d_in, const int* in_sizes, int n_in, void* d_out, int out_size, void* d_ws, size_t ws_size, hipStream_t stream) {
    static int grid = 0;
    if (grid == 0) {
        if (n_in != 22 || in_sizes[0] != M * D || out_size != M * D || ws_size < WS_END) { fprintf(stderr, "kernel_launch: unexpected shapes (n_in %d, in0 %d, out %d, ws %zu; need ws >= %zu); nothing launched\n", n_in, n_in > 0 ? in_sizes[0] : -1, out_size, ws_size, (size_t)WS_END); grid = -1; return; }
        int dev = 0, cus = 0, per_cu = 0;
        if (hipGetDevice(&dev) != hipSuccess || hipDeviceGetAttribute(&cus, hipDeviceAttributeMultiprocessorCount, dev) != hipSuccess) { fprintf(stderr, "kernel_launch: device query failed\n"); grid = -1; return; }
        if (hipFuncSetAttribute((const void*)mk_fwd, hipFuncAttributeMaxDynamicSharedMemorySize, LDS_BYTES) != hipSuccess) { fprintf(stderr, "kernel_launch: hipFuncSetAttribute failed\n"); grid = -1; return; }
        if (hipOccupancyMaxActiveBlocksPerMultiprocessor(&per_cu, (const void*)mk_fwd, NTHREADS, LDS_BYTES) != hipSuccess || per_cu < 1)
            fprintf(stderr, "kernel_launch: note: occupancy query reports %d workgroups per CU\n", per_cu);
        (void)hipGetLastError();
        grid = cus;
    }
    if (grid < 0) return;
    if (hipMemsetAsync((char*)d_ws + WS_CTL, 0, CTL_ZERO_BYTES, stream) != hipSuccess) { fprintf(stderr, "kernel_launch: memset failed\n"); return; }
    Args a{};
    for (int i = 0; i < 22; ++i) a.in[i] = (const float*)d_in[i];
    a.out = (float*)d_out; a.ws = (unsigned char*)d_ws;
#if MK_PER_PHASE
    for (int p = 0; p < N_PHASES; ++p) { a.ph_lo = p; a.ph_hi = p + 1; hipLaunchKernelGGL(mk_fwd, dim3(grid), dim3(NTHREADS), LDS_BYTES, stream, a); }
#else
    a.ph_lo = 0; a.ph_hi = N_PHASES;
    hipLaunchKernelGGL(mk_fwd, dim3(grid), dim3(NTHREADS), LDS_BYTES, stream, a);
#endif
    const hipError_t le = hipPeekAtLastError();
    if (le != hipSuccess) fprintf(stderr, "kernel_launch: launch failed: %s (grid %d)\n", hipGetErrorName(le), grid);
}
```

```cpp
#include <hip/hip_runtime.h>
#include <cstdio>
#include <cstdint>
#ifndef MK_SUBPROBE
#define MK_SUBPROBE 0
#endif
namespace pg8 {
#define PG8_LAS __attribute__((address_space(3)))
typedef unsigned short bf16_t;
typedef short bf16x8 __attribute__((ext_vector_type(8)));
typedef float f32x4 __attribute__((ext_vector_type(4)));
typedef unsigned u32x4 __attribute__((ext_vector_type(4)));
typedef unsigned u32x2 __attribute__((ext_vector_type(2)));
constexpr int BM = 256, BK = 64, HALF = 128, HTB = HALF * BK * 2  , STAGE_BYTES = 8 * HTB, NXCD = 8, WGM = 4;

__host__ __device__ __forceinline__ int lds_byte(int r, int c) { const int st = (r >> 4) * 2 + (c >> 5), rr = r & 15, cc = c & 31, ob = rr * 64 + cc * 2; return st * 1024 + (ob ^ (((ob >> 9) & 1) << 5)); }
__host__ __device__ __forceinline__ void stage_rc(int b, int& R, int& C) { const int st = b / 1024, sb = b % 1024, swz = sb ^ (((sb >> 9) & 1) << 5); R = (st >> 1) * 16 + swz / 64; C = (st & 1) * 32 + (swz % 64) / 2; }
__host__ __device__ __forceinline__ int perm32(int rho) { const int n = rho >> 4, i = rho & 15; return 8 * (i >> 2) + 4 * n + (i & 3); }

struct Unit { int pm, pn, brow; };
struct Gemm { const bf16_t* A; const bf16_t* Bt; int M, N, K; };

struct StaticOrder {
    int nM, nN, nwg, G, c;
    __host__ __device__ void init(int M, int N, int G_, int c_) { nM = M / BM; nN = N / BM; nwg = nM * nN; G = G_; c = c_; }
    __host__ __device__ bool next(int i, Unit& u) const {
        const long L = (long)i * G + c; if (L >= nwg) return false;
        int wgid = (int)L; { const int q = nwg / NXCD, r = nwg % NXCD, xcd = wgid % NXCD, off = wgid / NXCD; wgid = (xcd < r ? xcd * (q + 1) : r * (q + 1) + (xcd - r) * q) + off; }
        const int nig = WGM * nN, gid = wgid / nig, fm = gid * WGM, gsz = (nM - fm) < WGM ? (nM - fm) : WGM;
        u.pm = fm + ((wgid % nig) % gsz); u.pn = (wgid % nig) / gsz; u.brow = u.pn * BM; return true;
    }
    __device__ __forceinline__ void a_ready(const Unit&) const {}
    __device__ __forceinline__ void done(const Unit&) const {}
};
struct GroupedOrder {
    int nM, nN, nwg, G, c; const int* tile_exp;
    __device__ void init(int nT, int N, int G_, int c_, const int* te) { nM = nT; nN = N / BM; nwg = nM * nN; G = G_; c = c_; tile_exp = te; }
    __device__ bool next(int i, Unit& u) const {
        const long L = (long)i * G + c; if (L >= nwg) return false;
        int wgid = (int)L; { const int q = nwg / NXCD, r = nwg % NXCD, xcd = wgid % NXCD, off = wgid / NXCD; wgid = (xcd < r ? xcd * (q + 1) : r * (q + 1) + (xcd - r) * q) + off; }
        const int nig = WGM * nN, gid = wgid / nig, fm = gid * WGM, gsz = (nM - fm) < WGM ? (nM - fm) : WGM;
        u.pm = fm + ((wgid % nig) % gsz); u.pn = (wgid % nig) / gsz;
        const int e = __builtin_amdgcn_readfirstlane((int)__hip_atomic_load((const unsigned*)tile_exp + u.pm, __ATOMIC_RELAXED, __HIP_MEMORY_SCOPE_AGENT));
        u.brow = e * (nN * BM) + u.pn * BM; return true;
    }
    __device__ __forceinline__ void a_ready(const Unit&) const {}
    __device__ __forceinline__ void done(const Unit&) const {}
};

__device__ __forceinline__ unsigned cvt_pk_bf16(float lo, float hi) { unsigned r; asm volatile("v_cvt_pk_bf16_f32 %0, %1, %2" : "=v"(r) : "v"(lo), "v"(hi)); return r; }

struct EpiProj {
    static constexpr bool PERM = true, AFTER_DRAIN = false;
    bf16_t* O; int ldc; float* gates; int gate_pn;
    __device__ __forceinline__ void operator()(const f32x4 (&acc)[2][2][4][2], const Unit& u, int wr, int wc, int fr, int fq) const {
        const int row0 = u.pm * BM + wr * 64 + fr, col0 = u.pn * BM + wc * 32 + 8 * fq;
#pragma unroll
        for (int ai = 0; ai < 2; ++ai)
#pragma unroll
            for (int m = 0; m < 4; ++m) { bf16_t* rowp = O + (size_t)(row0 + ai * HALF + m * 16) * ldc + col0;
#pragma unroll
                for (int bj = 0; bj < 2; ++bj) { const f32x4 v0 = acc[ai][bj][m][0], v1 = acc[ai][bj][m][1];
                    u32x4 w; w.x = cvt_pk_bf16(v0[0], v0[1]); w.y = cvt_pk_bf16(v0[2], v0[3]); w.z = cvt_pk_bf16(v1[0], v1[1]); w.w = cvt_pk_bf16(v1[2], v1[3]);
                    *(u32x4*)(rowp + bj * HALF) = w; } }
        if (gates != nullptr && u.pn == gate_pn && wc == 0 && fq < 2) {
#pragma unroll
            for (int ai = 0; ai < 2; ++ai)
#pragma unroll
                for (int m = 0; m < 4; ++m) { float* gp = gates + (size_t)(row0 + ai * HALF + m * 16) * 16 + 8 * fq;
                    *(f32x4*)gp = acc[ai][0][m][0]; *(f32x4*)(gp + 4) = acc[ai][0][m][1]; }
        }
    }
};
struct EpiF32 {
    static constexpr bool PERM = false, AFTER_DRAIN = false;
    float* C; int ldc;
    __device__ __forceinline__ void operator()(const f32x4 (&acc)[2][2][4][2], const Unit& u, int wr, int wc, int fr, int fq) const {
        const int row0 = u.pm * BM + wr * 64 + fr, col0 = u.pn * BM + wc * 32 + 4 * fq;
#pragma unroll
        for (int ai = 0; ai < 2; ++ai)
#pragma unroll
            for (int m = 0; m < 4; ++m) { float* rowp = C + (size_t)(row0 + ai * HALF + m * 16) * ldc + col0;
#pragma unroll
                for (int bj = 0; bj < 2; ++bj)
#pragma unroll
                    for (int n = 0; n < 2; ++n) *(f32x4*)(rowp + bj * HALF + n * 16) = acc[ai][bj][m][n]; }
    }
};
struct EpiResBf16 {
    static constexpr bool PERM = true, AFTER_DRAIN = false;
    const bf16_t* base; bf16_t* out; int ldc; float alpha;
    __device__ __forceinline__ void operator()(const f32x4 (&acc)[2][2][4][2], const Unit& u, int wr, int wc, int fr, int fq) const {
        const int row0 = u.pm * BM + wr * 64 + fr, col0 = u.pn * BM + wc * 32 + 8 * fq;
#pragma unroll
        for (int ai = 0; ai < 2; ++ai)
#pragma unroll
            for (int m = 0; m < 4; ++m) { const size_t off = (size_t)(row0 + ai * HALF + m * 16) * ldc + col0;
#pragma unroll
                for (int bj = 0; bj < 2; ++bj) { const u32x4 bw = *(const u32x4*)(base + off + bj * HALF);
                    const f32x4 b0 = {__uint_as_float(bw.x << 16), __uint_as_float(bw.x & 0xffff0000u), __uint_as_float(bw.y << 16), __uint_as_float(bw.y & 0xffff0000u)};
                    const f32x4 b1 = {__uint_as_float(bw.z << 16), __uint_as_float(bw.z & 0xffff0000u), __uint_as_float(bw.w << 16), __uint_as_float(bw.w & 0xffff0000u)};
                    const f32x4 v0 = b0 * alpha + acc[ai][bj][m][0], v1 = b1 * alpha + acc[ai][bj][m][1];
                    u32x4 w; w.x = cvt_pk_bf16(v0[0], v0[1]); w.y = cvt_pk_bf16(v0[2], v0[3]); w.z = cvt_pk_bf16(v1[0], v1[1]); w.w = cvt_pk_bf16(v1[2], v1[3]);
                    *(u32x4*)(out + off + bj * HALF) = w; } }
    }
};
struct EpiSwiGLU {
    static constexpr bool PERM = false, AFTER_DRAIN = false;
    bf16_t* H; int ldh;
    __device__ __forceinline__ void operator()(const f32x4 (&acc)[2][2][4][2], const Unit& u, int wr, int wc, int fr, int fq) const {
        const int row0 = u.pm * BM + wr * 64 + fr + 16 * (fq & 1), col0 = u.pn * HALF + wc * 16 + 4 * (fq & 2);
#pragma unroll
        for (int ai = 0; ai < 2; ++ai)
#pragma unroll
            for (int mp = 0; mp < 2; ++mp) { bf16_t* rowp = H + (size_t)(row0 + ai * HALF + mp * 32) * ldh + col0;
#pragma unroll
                for (int bj = 0; bj < 2; ++bj) { unsigned e[2], o[2];
#pragma unroll
                    for (int q = 0; q < 2; ++q) { const f32x4 a = acc[ai][bj][2 * mp + q][0], b = acc[ai][bj][2 * mp + q][1]; float h[4];
#pragma unroll
                        for (int j = 0; j < 4; ++j) h[j] = a[j] * b[j] * __builtin_amdgcn_rcpf(1.0f + __expf(-a[j]));
                        if (q == 0) { e[0] = cvt_pk_bf16(h[0], h[1]); e[1] = cvt_pk_bf16(h[2], h[3]); } else { o[0] = cvt_pk_bf16(h[0], h[1]); o[1] = cvt_pk_bf16(h[2], h[3]); } }
                    asm volatile("v_nop\n\tv_nop\n\tv_permlane16_swap_b32 %0, %1" : "+v"(e[0]), "+v"(o[0]));
                    asm volatile("v_nop\n\tv_nop\n\tv_permlane16_swap_b32 %0, %1" : "+v"(e[1]), "+v"(o[1]));
                    u32x4 w; w.x = e[0]; w.y = e[1]; w.z = o[0]; w.w = o[1];
                    *(u32x4*)(rowp + bj * 64) = w; } }
    }
};
struct EpiMoeDown {
    static constexpr bool PERM = true, AFTER_DRAIN = false;
    bf16_t* Y; int ldc; const int* row_slot; const float* row_gate;
    __device__ __forceinline__ void operator()(const f32x4 (&acc)[2][2][4][2], const Unit& u, int wr, int wc, int fr, int fq) const {
        const int row0 = u.pm * BM + wr * 64 + fr, col0 = u.pn * BM + wc * 32 + 8 * fq;
#pragma unroll
        for (int ai = 0; ai < 2; ++ai)
#pragma unroll
            for (int m = 0; m < 4; ++m) { const int row = row0 + ai * HALF + m * 16;
                const int slot = (int)__hip_atomic_load((const unsigned*)row_slot + row, __ATOMIC_RELAXED, __HIP_MEMORY_SCOPE_AGENT);
                const float gt = __uint_as_float(__hip_atomic_load((const unsigned*)row_gate + row, __ATOMIC_RELAXED, __HIP_MEMORY_SCOPE_AGENT));
                if (slot >= 0) { bf16_t* rowp = Y + (size_t)slot * ldc + col0;
#pragma unroll
                    for (int bj = 0; bj < 2; ++bj) { const f32x4 v0 = acc[ai][bj][m][0] * gt, v1 = acc[ai][bj][m][1] * gt;
                        u32x4 w; w.x = cvt_pk_bf16(v0[0], v0[1]); w.y = cvt_pk_bf16(v0[2], v0[3]); w.z = cvt_pk_bf16(v1[0], v1[1]); w.w = cvt_pk_bf16(v1[2], v1[3]);
                        *(u32x4*)(rowp + bj * HALF) = w; } } }
    }
};

template <class Epi, class Sched, bool ALIGN_EPI = false, bool SP2 = false>
__device__ __forceinline__ void gemm_phase(PG8_LAS unsigned char* lds, const Gemm g, const Sched& S, const Epi& E) {
    int tid_l = threadIdx.x; asm volatile("" : "+v"(tid_l));
    const int tid = tid_l, wid = __builtin_amdgcn_readfirstlane(tid >> 6), lane = tid & 63, wr = wid >> 2, wc = wid & 3, fr = lane & 15, fq = lane >> 4;
    const int K = g.K, nt = K / BK;
    unsigned voffA[2], voffB[2];
#pragma unroll
    for (int i = 0; i < 2; ++i) { int R, C; stage_rc(tid * 16 + i * 8192, R, C); const int Rb = Epi::PERM ? ((R & ~31) + perm32(R & 31)) : R;
        voffA[i] = (unsigned)(R * K + C) * 2u; voffB[i] = (unsigned)(Rb * K + C) * 2u; }
    const size_t kstep = (size_t)(BK * 2);
    const size_t hstep = (size_t)HALF * K * 2;
    const size_t tstep = 2 * hstep;
    const unsigned ldsw = (unsigned)wid * 1024u;
    const int aoff = lds_byte(wr * 64 + fr, fq * 8), boff = lds_byte(wc * 32 + fr, fq * 8);
#define PG8_SA(b, h) (((b) * 2 + (h)) * HTB)
#define PG8_SB(b, h) ((4 + (b) * 2 + (h)) * HTB)
#define PG8_STAGE(bufoff, gbase, voff) do { _Pragma("unroll") for (int _i = 0; _i < 2; ++_i) \
        __builtin_amdgcn_global_load_lds((const unsigned*)((const char*)(gbase) + (voff)[_i]), (PG8_LAS unsigned*)(lds + (bufoff) + ldsw + _i * 8192), 16, 0, 0); } while (0)
#define PG8_LDA(dst, b, h) do { _Pragma("unroll") for (int m = 0; m < 4; ++m) _Pragma("unroll") for (int k = 0; k < 2; ++k) dst[m][k] = *(const PG8_LAS bf16x8*)(lds + PG8_SA(b, h) + aoff + m * 2048 + k * 1024); } while (0)
#define PG8_LDB(dst, b, h) do { _Pragma("unroll") for (int n = 0; n < 2; ++n) _Pragma("unroll") for (int k = 0; k < 2; ++k) dst[n][k] = *(const PG8_LAS bf16x8*)(lds + PG8_SB(b, h) + boff + n * 2048 + k * 1024); } while (0)
#define PG8_MMA(ai, bj, At, Bt) do { __builtin_amdgcn_s_setprio(1); _Pragma("unroll") for (int m = 0; m < 4; ++m) _Pragma("unroll") for (int n = 0; n < 2; ++n) _Pragma("unroll") for (int k = 0; k < 2; ++k) \
        acc[ai][bj][m][n] = __builtin_amdgcn_mfma_f32_16x16x32_bf16(Bt[n][k], At[m][k], acc[ai][bj][m][n], 0, 0, 0); __builtin_amdgcn_s_setprio(0); } while (0)
#define PG8_WAIT_V(n) asm volatile("s_waitcnt vmcnt(" #n ")" ::: "memory")
#define PG8_WAIT_L(n) asm volatile("s_waitcnt lgkmcnt(" #n ")" ::: "memory")
#define PG8_BAR __builtin_amdgcn_s_barrier()
#define PG8_SCHED __builtin_amdgcn_sched_barrier(0)
    Unit cur, nxt; int ui = 0;
    if (!S.next(0, cur)) return;
    f32x4 acc[2][2][4][2];
#pragma unroll
    for (int a = 0; a < 2; ++a)
#pragma unroll
        for (int b = 0; b < 2; ++b)
#pragma unroll
            for (int m = 0; m < 4; ++m)
#pragma unroll
                for (int n = 0; n < 2; ++n) acc[a][b][m][n] = (f32x4){0.f, 0.f, 0.f, 0.f};
    bf16x8 At[4][2], B0[2][2], B1[2][2];
    const char* cA = (const char*)g.A + (size_t)cur.pm * tstep; const char* cB = (const char*)g.Bt + (size_t)cur.brow * (size_t)K * 2;
    S.a_ready(cur);
    if constexpr (SP2) {
        PG8_STAGE(PG8_SB(0, 0), cB, voffB); PG8_STAGE(PG8_SB(0, 1), cB + hstep, voffB); PG8_STAGE(PG8_SA(0, 0), cA, voffA); PG8_STAGE(PG8_SA(0, 1), cA + hstep, voffA);
        if (wr == 1) PG8_BAR;
        PG8_WAIT_V(2); PG8_BAR;
        PG8_STAGE(PG8_SB(1, 0), cB + kstep, voffB); PG8_STAGE(PG8_SA(1, 0), cA + kstep, voffA); PG8_STAGE(PG8_SB(1, 1), cB + hstep + kstep, voffB);
        PG8_WAIT_V(6); PG8_BAR;
    } else {
        PG8_STAGE(PG8_SB(0, 0), cB, voffB); PG8_STAGE(PG8_SA(0, 0), cA, voffA); PG8_STAGE(PG8_SB(0, 1), cB + hstep, voffB); PG8_STAGE(PG8_SA(0, 1), cA + hstep, voffA);
        if (wr == 1) PG8_BAR;
        PG8_WAIT_V(4); PG8_BAR;
        PG8_STAGE(PG8_SB(1, 0), cB + kstep, voffB); PG8_STAGE(PG8_SA(1, 0), cA + kstep, voffA); PG8_STAGE(PG8_SB(1, 1), cB + hstep + kstep, voffB);
        PG8_WAIT_V(6); PG8_BAR;
    }
    for (;;) {
        const bool has_next = S.next(ui + 1, nxt);
        const char* nA = has_next ? (const char*)g.A + (size_t)nxt.pm * tstep : cA; const char* nB = has_next ? (const char*)g.Bt + (size_t)nxt.brow * (size_t)K * 2 : cB;
        for (int t = 0; t < nt; t += 2) {
            const bool last = (t == nt - 2);
            const char* a1 = cA + (size_t)(t + 1) * kstep;
            const char* a2 = last ? nA : cA + (size_t)(t + 2) * kstep; const char* b2 = last ? nB : cB + (size_t)(t + 2) * kstep;
            const char* a3 = a2 + kstep; const char* b3 = b2 + kstep;
            if (last && has_next) S.a_ready(nxt);
            if constexpr (SP2) {
            PG8_LDB(B0, 0, 0); PG8_LDB(B1, 0, 1); PG8_SCHED; PG8_LDA(At, 0, 0); PG8_STAGE(PG8_SA(1, 1), a1 + hstep, voffA);
            PG8_WAIT_V(8); PG8_WAIT_L(0); PG8_BAR; PG8_MMA(0, 0, At, B0); PG8_MMA(0, 1, At, B1); PG8_BAR; PG8_SCHED;
            PG8_LDA(At, 0, 1); PG8_STAGE(PG8_SB(0, 0), b2, voffB); PG8_STAGE(PG8_SB(0, 1), b2 + hstep, voffB); PG8_STAGE(PG8_SA(0, 0), a2, voffA);
            PG8_WAIT_V(8); PG8_WAIT_L(0); PG8_BAR; PG8_MMA(1, 0, At, B0); PG8_MMA(1, 1, At, B1); PG8_BAR; PG8_SCHED;
            PG8_LDB(B0, 1, 0); PG8_LDB(B1, 1, 1); PG8_SCHED; PG8_LDA(At, 1, 0); PG8_STAGE(PG8_SA(0, 1), a2 + hstep, voffA);
            PG8_WAIT_V(8); PG8_WAIT_L(0); PG8_BAR; PG8_MMA(0, 0, At, B0); PG8_MMA(0, 1, At, B1); PG8_BAR; PG8_SCHED;
            PG8_LDA(At, 1, 1); PG8_STAGE(PG8_SB(1, 0), b3, voffB); PG8_STAGE(PG8_SB(1, 1), b3 + hstep, voffB); PG8_STAGE(PG8_SA(1, 0), a3, voffA);
            PG8_WAIT_V(8); PG8_WAIT_L(0); PG8_BAR; PG8_MMA(1, 0, At, B0); PG8_MMA(1, 1, At, B1); PG8_BAR; PG8_SCHED;
            } else {
            PG8_LDB(B0, 0, 0); PG8_SCHED; PG8_LDA(At, 0, 0); PG8_STAGE(PG8_SA(1, 1), a1 + hstep, voffA);
            PG8_WAIT_L(8); PG8_BAR; PG8_WAIT_L(0); PG8_MMA(0, 0, At, B0); PG8_BAR; PG8_SCHED;
            PG8_LDB(B1, 0, 1); PG8_STAGE(PG8_SB(0, 0), b2, voffB);
            PG8_BAR; PG8_WAIT_L(0); PG8_MMA(0, 1, At, B1); PG8_BAR;
            PG8_LDA(At, 0, 1); PG8_STAGE(PG8_SA(0, 0), a2, voffA);
            PG8_BAR; PG8_WAIT_L(0); PG8_MMA(1, 0, At, B0); PG8_BAR; PG8_SCHED;
            PG8_STAGE(PG8_SB(0, 1), b2 + hstep, voffB);
            PG8_WAIT_V(6); PG8_BAR; PG8_MMA(1, 1, At, B1); PG8_BAR;
            PG8_LDB(B0, 1, 0); PG8_SCHED; PG8_LDA(At, 1, 0); PG8_STAGE(PG8_SA(0, 1), a2 + hstep, voffA);
            PG8_WAIT_L(8); PG8_BAR; PG8_WAIT_L(0); PG8_MMA(0, 0, At, B0); PG8_BAR; PG8_SCHED;
            PG8_LDB(B1, 1, 1); PG8_STAGE(PG8_SB(1, 0), b3, voffB);
            PG8_BAR; PG8_WAIT_L(0); PG8_MMA(0, 1, At, B1); PG8_BAR;
            PG8_LDA(At, 1, 1); PG8_STAGE(PG8_SA(1, 0), a3, voffA);
            PG8_BAR; PG8_WAIT_L(0); PG8_MMA(1, 0, At, B0); PG8_BAR; PG8_SCHED;
            PG8_STAGE(PG8_SB(1, 1), b3 + hstep, voffB);
            PG8_WAIT_V(6); PG8_BAR; PG8_MMA(1, 1, At, B1); PG8_BAR;
            }
        }
        if constexpr (ALIGN_EPI) { if (wr == 0) PG8_BAR; }
        if constexpr (!Epi::AFTER_DRAIN) { E(acc, cur, wr, wc, fr, fq); S.done(cur); }
        if (!has_next) break;
#pragma unroll
        for (int a = 0; a < 2; ++a)
#pragma unroll
            for (int b = 0; b < 2; ++b)
#pragma unroll
                for (int m = 0; m < 4; ++m)
#pragma unroll
                    for (int n = 0; n < 2; ++n) acc[a][b][m][n] = (f32x4){0.f, 0.f, 0.f, 0.f};
        cur = nxt; cA = nA; cB = nB; ++ui;
        if constexpr (ALIGN_EPI) { if (wr == 1) PG8_BAR; }
    }
    PG8_WAIT_V(0);
    if constexpr (!ALIGN_EPI) { if (wr == 0) PG8_BAR; }
    PG8_BAR;
    if constexpr (Epi::AFTER_DRAIN) { E.fused(acc, cur, wr, wc, fr, fq, lds, wid, lane); S.done(cur); }
#undef PG8_SA
#undef PG8_SB
#undef PG8_STAGE
#undef PG8_LDA
#undef PG8_LDB
#undef PG8_MMA
#undef PG8_WAIT_V
#undef PG8_WAIT_L
#undef PG8_BAR
#undef PG8_SCHED
}
}
#ifndef PG8_SP2
#define PG8_SP2 true
#endif
#ifndef PG8_ALIGN
#define PG8_ALIGN true
#endif

constexpr int NWAVES = 8, NTHREADS = NWAVES * 64;
constexpr int BATCH = 8, SEQ = 4096, D = 1024, M = BATCH * SEQ, DEPTH = 4;
constexpr int NMEM = 256, TOKW = 768, MEMW = 256, MEMH = 4, NAH = 12, MLH = 4, MLDH = 192;
constexpr int NA_IN = 2560, NA_LDP = 1792  , ML_IN = 3344, ML_INP = 3584, ML_LDP = 2816  , ML_GATE_PN = 10;
constexpr int NEXP = 32, EPG = 8, NGRP = 4, DEXP = 512;
constexpr int P_MAX = 288 * 256;
constexpr float LN_EPS = 1e-5f;
constexpr float ALPHA = 1.6817928305074290f;

constexpr size_t MiB = 1u << 20;
constexpr size_t WS_CTL = 0, CTL_ZERO_BYTES = 1 * MiB;
constexpr size_t WS_MISC = 1 * MiB;
constexpr size_t WS_RGB = WS_MISC + 128 * 1024;
constexpr size_t WS_STATS = 47 * MiB;
constexpr size_t WS_WR = WS_MISC + 256 * 1024;
constexpr size_t WS_WINNA = 2 * MiB, WS_WINML = 12 * MiB, WS_WOUT = 26 * MiB, WS_WMEMKV = 34 * MiB, WS_MEMB = 35 * MiB, WS_MEMKV = 39 * MiB, WS_GATES = 43 * MiB;
constexpr size_t WS_TOKE = 45 * MiB, WS_TOKG = WS_TOKE + 262144, WS_TOKP = WS_TOKG + 262144, WS_ROWSLOT = WS_TOKP + 262144, WS_ROWGATE = WS_ROWSLOT + 294912;
static_assert(WS_ROWGATE + 294912 <= 48 * MiB, "ws map");
constexpr size_t WS_W13 = 48 * MiB, WS_W2 = 304 * MiB, WS_PRE = 432 * MiB, WS_XB = 560 * MiB, WS_PROJ = 624 * MiB, WS_MIXED = 848 * MiB, WS_H = 912 * MiB, WS_END = 1012 * MiB;
constexpr size_t WS_VT = WS_PROJ + 112 * MiB;
constexpr size_t WS_VTML = WS_PROJ + 176 * MiB;
constexpr size_t WS_MEMK = WS_MEMKV, WS_MEMVT = WS_MEMKV + 2 * MiB;
constexpr size_t WS_SCAL = 1008 * MiB;
constexpr size_t WS_QKC = WS_PRE;
constexpr size_t WS_Y = WS_PROJ, WS_HID = WS_PROJ + 128 * MiB;
constexpr size_t WS_XS = WS_MIXED;
static_assert(WS_HID + (size_t)P_MAX * DEXP * 2 <= WS_MIXED && WS_XS + (size_t)P_MAX * D * 2 <= 1008 * MiB && WS_PROJ + (size_t)M * ML_INP * 2 <= WS_MIXED, "ws map");
static_assert(WS_H + (size_t)2 * M * TOKW * 2 <= 1008 * MiB && WS_QKC + (size_t)M * 1536 * 2 <= WS_XB, "ws map");
constexpr int CW_BAR = 4096;
constexpr int CW_CNT = 16384;
constexpr int RING_BYTES = 131072, LDSCTL_OFF = RING_BYTES, LDSCTL_BYTES = 32768, LDS_BYTES = RING_BYTES + LDSCTL_BYTES;
constexpr int L_PROBE = LDSCTL_OFF + 2048;
constexpr int L_MISC = LDSCTL_OFF + 320, L_HIST = LDSCTL_OFF + 512, L_WGBASE = LDSCTL_OFF + 768, L_PADSTART = LDSCTL_OFF + 1024, L_CNT = LDSCTL_OFF + 1280;

#define GAS __attribute__((address_space(1)))
#define LAS __attribute__((address_space(3)))
typedef unsigned short bf16;
typedef unsigned v4u __attribute__((ext_vector_type(4)));
typedef unsigned u32x4 __attribute__((ext_vector_type(4)));
typedef float f32x4 __attribute__((ext_vector_type(4)));
typedef short bf16x8 __attribute__((ext_vector_type(8)));
typedef GAS unsigned gu32;
typedef GAS unsigned long long gu64;
#define RLX_AGENT __ATOMIC_RELAXED, __HIP_MEMORY_SCOPE_AGENT
#define LDS_WAIT() asm volatile("s_waitcnt lgkmcnt(0)" ::: "memory")
#define VM_WAIT() asm volatile("s_waitcnt vmcnt(0)" ::: "memory")
__device__ __forceinline__ unsigned long long rt() { return __builtin_amdgcn_s_memrealtime(); }
__device__ __forceinline__ unsigned pk2(float lo, float hi) { unsigned r; asm("v_cvt_pk_bf16_f32 %0, %1, %2" : "=v"(r) : "v"(lo), "v"(hi)); return r; }
__device__ __forceinline__ unsigned f2bf(float f) { return pk2(f, 0.f) & 0xffffu; }

#define XB_TMO      128
#define XB_XCNT(j)  (256  + 64 * (j))
#define XB_XSUB(j)  (1280 + 64 * (j))
#define XB_XGEN(j)  (2304 + 64 * (j))
#define XB_TOP      3328
#define XB_TOPGEN   3392
#define XCD_BAR_WORDS 3456
#define XB_SPIN_CAP (1u << 24)

__device__ __forceinline__ unsigned xb_ld(unsigned* p)              { return __hip_atomic_load(p, __ATOMIC_RELAXED, __HIP_MEMORY_SCOPE_AGENT); }
__device__ __forceinline__ unsigned xb_add(unsigned* p, unsigned v) { return __hip_atomic_fetch_add(p, v, __ATOMIC_RELAXED, __HIP_MEMORY_SCOPE_AGENT); }
__device__ __forceinline__ unsigned xb_xcc_id() { return (unsigned)__builtin_amdgcn_s_getreg((3 << 11) | 20) & 0xFu; }
#define XB_SPIN(cond, bar) do { unsigned _sp = 0; while (cond) { __builtin_amdgcn_s_sleep(1); \
    if ((++_sp & 255u) == 0u) { if (xb_ld(&(bar)[XB_TMO])) break; if (_sp > XB_SPIN_CAP) { atomicAdd(&(bar)[XB_TMO], 1u); break; } } } } while (0)

struct XcdBarrier {
    unsigned* bar; unsigned x;
    volatile LAS unsigned* st;
};

__device__ __forceinline__ XcdBarrier xcd_barrier_post(unsigned* bar, volatile LAS unsigned* st) {
    XcdBarrier b; b.bar = bar; b.x = xb_xcc_id(); b.st = st;
    if (threadIdx.x == 0) (void)xb_add(&bar[XB_XCNT(b.x)], 1u);
    return b;
}
__device__ __forceinline__ void xcd_barrier_complete(unsigned* bar, unsigned x, unsigned& nloc, unsigned& nx) {
    const unsigned G = gridDim.x * gridDim.y * gridDim.z;
    unsigned sum, cnt, mine, sp = 0u;
    for (;;) {
        sum = 0u; cnt = 0u; mine = 0u;
#pragma unroll
        for (unsigned j = 0; j < 16; ++j) { const unsigned c = xb_ld(&bar[XB_XCNT(j)]); sum += c; cnt += (c > 0u) ? 1u : 0u; mine = (j == x) ? c : mine; }
        if (sum == G) break;
        __builtin_amdgcn_s_sleep(1);
        if ((++sp & 255u) == 0u) { if (xb_ld(&bar[XB_TMO])) break; if (sp > XB_SPIN_CAP) { atomicAdd(&bar[XB_TMO], 1u); break; } }
    }
    nloc = mine > 0u ? mine : 1u; nx = cnt > 0u ? cnt : 1u;
}

__device__ __forceinline__ void xcd_barrier(const XcdBarrier& b) {
    asm volatile("s_waitcnt vmcnt(0)" ::: "memory");
    __syncthreads();
    if (threadIdx.x == 0) {
        unsigned* bar = b.bar;
        __builtin_amdgcn_s_waitcnt(0);
        unsigned nloc = b.st[0], nx = b.st[1];
        if (nloc == 0u) { xcd_barrier_complete(bar, b.x, nloc, nx); b.st[0] = nloc; b.st[1] = nx; }
        const unsigned old = xb_add(&bar[XB_XSUB(b.x)], 1u);
        const unsigned gen = old / nloc;
        if (old + 1u == (gen + 1u) * nloc) {
            __builtin_amdgcn_fence(__ATOMIC_RELEASE, "agent");
            asm volatile("s_waitcnt vmcnt(0)" ::: "memory");
            const unsigned og = xb_add(&bar[XB_TOP], 1u);
            const unsigned tg = og / nx;
            if (og + 1u == (tg + 1u) * nx) xb_add(&bar[XB_TOPGEN], 1u);
            else XB_SPIN(xb_ld(&bar[XB_TOPGEN]) == tg, bar);
            __builtin_amdgcn_fence(__ATOMIC_ACQUIRE, "agent");
            xb_add(&bar[XB_XGEN(b.x)], 1u);
            asm volatile("s_waitcnt vmcnt(0)" ::: "memory");
        } else {
            XB_SPIN(xb_ld(&bar[XB_XGEN(b.x)]) == gen, bar);
            __builtin_amdgcn_fence(__ATOMIC_ACQUIRE, "agent");
            asm volatile("s_waitcnt vmcnt(0)" ::: "memory");
        }
    }
    __syncthreads();
}


struct Frame {
    LAS unsigned char* lds;
    gu32* ctl;
    int tid, lane, wave, vcu, G, bx;
};
template <int CTRL> __device__ __forceinline__ float dpp_mov(float v) { return __builtin_bit_cast(float, __builtin_amdgcn_update_dpp(0, __builtin_bit_cast(int, v), CTRL, 0xf, 0xf, true)); }
__device__ __forceinline__ float wave_sum(float v) {
    v += dpp_mov<0xB1>(v);
    v += dpp_mov<0x4E>(v);
    v += dpp_mov<0x141>(v);
    v += dpp_mov<0x140>(v);
    const int iv = __builtin_bit_cast(int, v);
    return (__builtin_bit_cast(float, __builtin_amdgcn_readlane(iv, 0)) + __builtin_bit_cast(float, __builtin_amdgcn_readlane(iv, 16))) +
           (__builtin_bit_cast(float, __builtin_amdgcn_readlane(iv, 32)) + __builtin_bit_cast(float, __builtin_amdgcn_readlane(iv, 48)));
}
__device__ __forceinline__ void qd_swap16(float v, float& x, float& y) { x = v; y = v; asm volatile("v_nop\n\tv_nop\n\tv_permlane16_swap_b32 %0, %1" : "+v"(x), "+v"(y)); }
__device__ __forceinline__ void qd_swap32(float v, float& x, float& y) { x = v; y = v; asm volatile("v_nop\n\tv_nop\n\tv_permlane32_swap_b32 %0, %1" : "+v"(x), "+v"(y)); }
__device__ __forceinline__ float qd_max(float v) { float x, y; qd_swap16(v, x, y); v = fmaxf(x, y); qd_swap32(v, x, y); return fmaxf(x, y); }
__device__ __forceinline__ float qd_sum(float v) { float x, y; qd_swap16(v, x, y); v = x + y; qd_swap32(v, x, y); return x + y; }
__device__ __forceinline__ float bf2f(unsigned short h) { return __uint_as_float((unsigned)h << 16); }
__device__ __forceinline__ float bflo(unsigned w) { return __uint_as_float(w << 16); }
__device__ __forceinline__ float bfhi(unsigned w) { return __uint_as_float(w & 0xffff0000u); }
__device__ __forceinline__ unsigned ld_agent(const void* p) { return __hip_atomic_load((const unsigned*)p, __ATOMIC_RELAXED, __HIP_MEMORY_SCOPE_AGENT); }

__device__ __forceinline__ int rowmap(int kind, int n) {
    if (kind == 0) return n;
    if (kind == 1) return n < 1536 ? n : (n < 2304 ? ML_LDP + (n - 1536) : (n < 3072 ? n - 768 : (n < 3088 ? 2560 + (n - 3072) : 2304 + (n - 3088))));
    if (kind == 4) return n < 1536 ? n : (n < 2304 ? n + 256 : n - 768);
    return 32 * (n >> 4) + (n & 15) + (kind == 3 ? 16 : 0);
}
__device__ __forceinline__ void transpose_item(const float* W, int K, int N, bf16* WT, int kind, LAS float* scr, int item, int lane) {
    const int nblk = (N + 31) / 32, kb = item / nblk, nb = item % nblk, k0 = 64 * kb, n0 = 32 * nb;
    const int nn = n0 + (lane & 31); const bool ok = nn < N;
    float tv[32];
#pragma unroll
    for (int i = 0; i < 32; ++i) { const int kk = 2 * i + (lane >> 5); tv[i] = ok ? W[(size_t)(k0 + kk) * N + nn] : 0.f; }
#pragma unroll
    for (int i = 0; i < 32; ++i) { const int kk = 2 * i + (lane >> 5); scr[kk * 33 + (lane & 31)] = tv[i]; }
    LDS_WAIT(); asm volatile("" ::: "memory");
    const int c = lane & 7;
#pragma unroll
    for (int j = 0; j < 4; ++j) { const int n = (lane >> 3) + 8 * j; const LAS float* s = scr + (8 * c) * 33 + n;
        v4u o; o.x = pk2(s[0 * 33], s[1 * 33]); o.y = pk2(s[2 * 33], s[3 * 33]); o.z = pk2(s[4 * 33], s[5 * 33]); o.w = pk2(s[6 * 33], s[7 * 33]);
        if (n0 + n < N) *(GAS v4u*)(WT + (size_t)rowmap(kind, n0 + n) * K + k0 + 8 * c) = o; }
    LDS_WAIT(); asm volatile("" ::: "memory");
}
struct TrItem { const float* W; bf16* WT; int K, N, kind, item; };
__device__ __forceinline__ void tr_load2(const TrItem& t, int lane, float (&tv)[32]) {
    const int nblk = (t.N + 31) / 32, kb = t.item / nblk, nb = t.item % nblk, k0 = 64 * kb, n0 = 32 * nb;
#pragma unroll
    for (int i = 0; i < 32; ++i) tv[i] = t.W[(size_t)(k0 + i + 32 * (lane >> 5)) * t.N + n0 + (lane & 31)];
}
__device__ __forceinline__ void tr_finish2(const TrItem& t, int lane, const float (&tv)[32], LAS unsigned* scr) {
    const int nblk = (t.N + 31) / 32, kb = t.item / nblk, nb = t.item % nblk, k0 = 64 * kb, n0 = 32 * nb;
#pragma unroll
    for (int j = 0; j < 16; ++j) scr[(16 * (lane >> 5) + j) * 33 + (lane & 31)] = pk2(tv[2 * j], tv[2 * j + 1]);
    LDS_WAIT(); asm volatile("" ::: "memory");
    const int c = lane & 7;
#pragma unroll
    for (int j = 0; j < 4; ++j) { const int n = (lane >> 3) + 8 * j; const LAS unsigned* sp = scr + (4 * c) * 33 + n;
        *(GAS v4u*)(t.WT + (size_t)rowmap(t.kind, n0 + n) * t.K + k0 + 8 * c) = (v4u){sp[0], sp[33], sp[66], sp[99]}; }
    LDS_WAIT(); asm volatile("" ::: "memory");
}
__device__ __forceinline__ TrItem moe_tritem(int it, const float* w1, const float* w3, const float* w2, bf16* W13, bf16* W2) {
    const int mat = it >> 8, sub = it & 255, le = mat / 3, which = mat - 3 * le;
    if (which == 0) return TrItem{w1 + (size_t)le * 1024 * 512, W13 + (size_t)le * 1024 * 1024, 1024, 512, 2, sub};
    if (which == 1) return TrItem{w3 + (size_t)le * 1024 * 512, W13 + (size_t)le * 1024 * 1024, 1024, 512, 3, sub};
    return TrItem{w2 + (size_t)le * 512 * 1024, W2 + (size_t)le * 1024 * 512, 512, 1024, 0, sub};
}
struct P0Args { const float *x, *mem, *wmemkv, *nawin, *mlwin, *wout, *w1, *w3, *w2, *wg, *we, *g1, *b1, *bg, *be; unsigned char* ws; };
__device__ __forceinline__ void p0_prologue(const Frame& F, const P0Args& a) {
    LAS float* scr = (LAS float*)(F.lds + F.wave * 16384);
    const int gw = F.vcu * NWAVES + F.wave, NGW = F.G * NWAVES;
    bf16* const W13 = (bf16*)(a.ws + WS_W13); bf16* const W2 = (bf16*)(a.ws + WS_W2);
    constexpr int I_MKV = 16 * 16, I_NA = 16 * 80, I_ML = 16 * 105, I_WO = 16 * 32;
    constexpr int I_MOE0 = 32768;
    constexpr int NITEMS = I_MOE0 + I_MKV + 2 * I_NA + 2 * I_ML + DEPTH * I_WO;
    for (int it = gw; it < NITEMS; it += NGW) {
        int r = it;
        if (r < I_MOE0) { const TrItem t = moe_tritem(r, a.w1, a.w3, a.w2, W13, W2); float tv[32]; tr_load2(t, F.lane, tv); tr_finish2(t, F.lane, tv, (LAS unsigned*)scr); continue; }
        r -= I_MOE0;
        if (r < I_MKV) { transpose_item(a.wmemkv, D, 512, (bf16*)(a.ws + WS_WMEMKV), 0, scr, r, F.lane); continue; } r -= I_MKV;
        if (r < 2 * I_NA) { const int j = r / I_NA; transpose_item(a.nawin + (size_t)j * D * NA_IN, D, NA_IN, (bf16*)(a.ws + WS_WINNA) + (size_t)j * NA_IN * D, 4, scr, r - j * I_NA, F.lane); continue; } r -= 2 * I_NA;
        if (r < 2 * I_ML) { const int j = r / I_ML; transpose_item(a.mlwin + (size_t)j * D * ML_IN, D, ML_IN, (bf16*)(a.ws + WS_WINML) + (size_t)j * ML_INP * D, 1, scr, r - j * I_ML, F.lane); continue; } r -= 2 * I_ML;
        { const int l = r / I_WO; transpose_item(a.wout + (size_t)l * D * D, D, D, (bf16*)(a.ws + WS_WOUT) + (size_t)l * D * D, 0, scr, r - l * I_WO, F.lane); }
    }
    const int gt = F.vcu * NTHREADS + F.tid, NT = F.G * NTHREADS;
    for (int i = gt; i < 2 * 240 * (D / 8); i += NT) { const int j = i / (240 * (D / 8)), rr = i - j * 240 * (D / 8);
        *(GAS v4u*)((bf16*)(a.ws + WS_WINML) + (size_t)j * ML_INP * D + (size_t)2576 * D + (size_t)rr * 8) = (v4u){0u, 0u, 0u, 0u}; }
    for (int i = gt; i < DEPTH * 48 * D; i += NT) { const int l = i / (48 * D), n = (i / D) % 48, k = i % D;
        const float wv = n < 4 ? a.wg[((size_t)l * D + k) * NGRP + n] : (n < 36 ? a.we[((size_t)l * D + k) * NEXP + (n - 4)] : 0.f);
        const float v = wv * a.g1[(size_t)l * D + k];
        const unsigned hi = f2bf(v); const float lo = v - bf2f((unsigned short)hi);
        bf16* wr = (bf16*)(a.ws + WS_WR) + (size_t)l * 2 * 48 * D; wr[(size_t)n * D + k] = (bf16)hi; wr[(size_t)(48 + n) * D + k] = (bf16)f2bf(lo); }
    for (int jn = gw; jn < DEPTH * 48; jn += NGW) { const int l = jn / 48, n = jn % 48; float sg = 0.f, sb = 0.f;
        if (n < 36) for (int k = F.lane; k < D; k += 64) { const float wv = n < 4 ? a.wg[((size_t)l * D + k) * NGRP + n] : a.we[((size_t)l * D + k) * NEXP + (n - 4)];
            sg += wv * a.g1[(size_t)l * D + k]; sb += wv * a.b1[(size_t)l * D + k]; }
        sg = wave_sum(sg); sb = wave_sum(sb);
        if (F.lane == 0) { float* rgb = (float*)(a.ws + WS_RGB) + l * 96; rgb[n] = sg; rgb[48 + n] = n < 4 ? sb + a.bg[l * NGRP + n] : (n < 36 ? sb + a.be[l * NEXP + (n - 4)] : 0.f); } }
    for (int i = gt; i < M * D / 8; i += NT) { const f32x4 v0 = *(const GAS f32x4*)(a.x + (size_t)i * 8), v1 = *(const GAS f32x4*)(a.x + (size_t)i * 8 + 4);
        *(GAS v4u*)((bf16*)(a.ws + WS_XB) + (size_t)i * 8) = (v4u){pk2(v0.x, v0.y), pk2(v0.z, v0.w), pk2(v1.x, v1.y), pk2(v1.z, v1.w)}; }
    for (int i = gt; i < BATCH * NMEM * D / 8; i += NT) { const f32x4 v0 = *(const GAS f32x4*)(a.mem + (size_t)i * 8), v1 = *(const GAS f32x4*)(a.mem + (size_t)i * 8 + 4);
        *(GAS v4u*)((bf16*)(a.ws + WS_MEMB) + (size_t)i * 8) = (v4u){pk2(v0.x, v0.y), pk2(v0.z, v0.w), pk2(v1.x, v1.y), pk2(v1.z, v1.w)}; }
}

__device__ __forceinline__ void load8(const bf16* p, float* f) { const v4u w = *(const GAS v4u*)p;
    f[0] = bflo(w.x); f[1] = bfhi(w.x); f[2] = bflo(w.y); f[3] = bfhi(w.y); f[4] = bflo(w.z); f[5] = bfhi(w.z); f[6] = bflo(w.w); f[7] = bfhi(w.w); }
__device__ __forceinline__ bf16x8 ld_frag(const bf16* p) { return *(const GAS bf16x8*)p; }
template <bool NA_LAYER>
__device__ __forceinline__ void attn_mfma(const Frame& F, const bf16* PROJ, const bf16* VT, const bf16* MEMK, const bf16* MEMVT, const float* rpb  , bf16* MIXED) {
    constexpr int ldp = NA_LAYER ? NA_LDP : ML_LDP;
    constexpr int nheads = NA_LAYER ? 16 : 4;
    const int gw = F.vcu * NWAVES + F.wave, NGW = F.G * NWAVES, lane = F.lane, qi = lane & 15, qd = lane >> 4;
    LAS float* rpl = (LAS float*)F.lds;
    if (NA_LAYER) { for (int i = F.tid; i < NAH * 15 * 31; i += NTHREADS) rpl[i] = rpb[i]; __syncthreads(); }
    for (int it = gw; it < BATCH * nheads * 64 * 4; it += NGW) {
        const int g = it & 3, r = (it >> 2) & 63, hb = it >> 8, hh = hb % nheads, b = hb / nheads;
        const int head = NA_LAYER ? hh : 12 + hh;
        const bool is_mem = head >= 12;
        const int tq0 = b * SEQ + r * 64 + 16 * g;
        const int qcol = is_mem ? (NA_LAYER ? 1536 : 2304) + (head - 12) * 64 : head * 64;
        const int rs = min(max(r - 4, 0), 56), w0 = g == 0 ? 0 : (g == 1 ? 8 : (g == 2 ? 24 : 32));
        const bf16* kbase; const bf16* vbase; size_t kblk, kstride, vblk, vstride;
        if (is_mem) { const int hm = head - 12; kbase = MEMK + (size_t)(b * NMEM) * 256 + hm * 64; kblk = 32 * 256; kstride = 256;
                      vbase = MEMVT + (size_t)(hm * 64) * (BATCH * NMEM) + b * NMEM; vblk = 32; vstride = BATCH * NMEM; }
        else { kbase = PROJ + (size_t)(b * SEQ + rs * 64 + w0) * ldp + 768 + head * 64; kblk = (size_t)64 * ldp; kstride = ldp;
               vbase = VT + (size_t)(head * 64) * M + (b * SEQ + rs * 64 + w0); vblk = 64; vstride = M; }
        const bf16* qp = PROJ + (size_t)(tq0 + qi) * ldp + qcol + 8 * qd;
        const bf16x8 qf0 = ld_frag(qp), qf1 = ld_frag(qp + 32);
        float sc[8][8];
        { bf16x8 kf[8][2][2];
#pragma unroll
          for (int blk = 0; blk < 8; ++blk)
#pragma unroll
            for (int t = 0; t < 2; ++t) { const bf16* kp = kbase + blk * kblk + (size_t)(8 * (qi >> 2) + 4 * t + (qi & 3)) * kstride + 8 * qd; kf[blk][t][0] = ld_frag(kp); kf[blk][t][1] = ld_frag(kp + 32); }
          __builtin_amdgcn_sched_barrier(0);
#pragma unroll
          for (int blk = 0; blk < 8; ++blk)
#pragma unroll
            for (int t = 0; t < 2; ++t) { f32x4 a = {0.f, 0.f, 0.f, 0.f};
                a = __builtin_amdgcn_mfma_f32_16x16x32_bf16(kf[blk][t][0], qf0, a, 0, 0, 0);
                a = __builtin_amdgcn_mfma_f32_16x16x32_bf16(kf[blk][t][1], qf1, a, 0, 0, 0);
#pragma unroll
                for (int j = 0; j < 4; ++j) sc[blk][4 * t + j] = a[j] * 0.125f; } }
        bf16x8 vfa[4][4];
#pragma unroll
        for (int blk = 0; blk < 4; ++blk)
#pragma unroll
            for (int dt = 0; dt < 4; ++dt) vfa[blk][dt] = ld_frag(vbase + (size_t)(16 * (qi >> 2) + 4 * dt + (qi & 3)) * vstride + blk * vblk + 8 * qd);
        __builtin_amdgcn_sched_barrier(0);
        if (!is_mem) {
            const int c = 16 * g + qi, cs = min(max(c - 8, 0), 48), kc0 = w0 + 8 * qd;
#pragma unroll
            for (int blk = 0; blk < 8; ++blk) { const LAS float* rp = rpl + (head * 15 + (rs + blk - r + 7)) * 31;
#pragma unroll
                for (int e = 0; e < 8; ++e) { const int kc = kc0 + e; const bool valid = kc >= cs && kc < cs + 16;
                    const float bias = rp[min(max(kc - c + 15, 0), 30)]; sc[blk][e] = valid ? sc[blk][e] + bias : -INFINITY; } }
        }
        float mx = -INFINITY;
#pragma unroll
        for (int blk = 0; blk < 8; ++blk)
#pragma unroll
            for (int e = 0; e < 8; ++e) mx = fmaxf(mx, sc[blk][e]);
        mx = qd_max(mx);
        float ls = 0.f; bf16x8 pf[8];
#pragma unroll
        for (int blk = 0; blk < 8; ++blk) { float p[8];
#pragma unroll
            for (int e = 0; e < 8; ++e) { p[e] = __expf(sc[blk][e] - mx); ls += p[e]; }
            u32x4 w; w.x = pk2(p[0], p[1]); w.y = pk2(p[2], p[3]); w.z = pk2(p[4], p[5]); w.w = pk2(p[6], p[7]);
            pf[blk] = __builtin_bit_cast(bf16x8, w); }
        ls = qd_sum(ls);
        f32x4 o[4]; bf16x8 vfb[4][4];
#pragma unroll
        for (int dt = 0; dt < 4; ++dt) o[dt] = (f32x4){0.f, 0.f, 0.f, 0.f};
#pragma unroll
        for (int blk = 0; blk < 4; ++blk)
#pragma unroll
            for (int dt = 0; dt < 4; ++dt) vfb[blk][dt] = ld_frag(vbase + (size_t)(16 * (qi >> 2) + 4 * dt + (qi & 3)) * vstride + (blk + 4) * vblk + 8 * qd);
        __builtin_amdgcn_sched_barrier(0);
#pragma unroll
        for (int blk = 0; blk < 4; ++blk)
#pragma unroll
            for (int dt = 0; dt < 4; ++dt) o[dt] = __builtin_amdgcn_mfma_f32_16x16x32_bf16(vfa[blk][dt], pf[blk], o[dt], 0, 0, 0);
#pragma unroll
        for (int blk = 0; blk < 4; ++blk)
#pragma unroll
            for (int dt = 0; dt < 4; ++dt) o[dt] = __builtin_amdgcn_mfma_f32_16x16x32_bf16(vfb[blk][dt], pf[blk + 4], o[dt], 0, 0, 0);
        const float inv = 1.0f / ls;
        bf16* op = MIXED + (size_t)(tq0 + qi) * D + head * 64 + 16 * qd;
        *(GAS u32x4*)op = (u32x4){pk2(o[0][0] * inv, o[0][1] * inv), pk2(o[0][2] * inv, o[0][3] * inv), pk2(o[1][0] * inv, o[1][1] * inv), pk2(o[1][2] * inv, o[1][3] * inv)};
        *(GAS u32x4*)(op + 8) = (u32x4){pk2(o[2][0] * inv, o[2][1] * inv), pk2(o[2][2] * inv, o[2][3] * inv), pk2(o[3][0] * inv, o[3][1] * inv), pk2(o[3][2] * inv, o[3][3] * inv)};
    }
}

__device__ __forceinline__ int att_fk(int tok) { return (((tok >> 3) & 3) << 1) | ((tok >> 1) & 1); }
__device__ __forceinline__ int att_fv(int d) { return (((d >> 4) & 3) << 1) | ((d >> 1) & 1); }
template <bool NA_LAYER>
__device__ __forceinline__ void attn_lds(const Frame& F, const bf16* PROJ, const bf16* VT, const bf16* MEMK, const bf16* MEMVT, const float* rpb  , bf16* MIXED) {
    constexpr int ldp = NA_LAYER ? NA_LDP : ML_LDP;
    const int tid = F.tid, lane = F.lane, wave = F.wave, qi = lane & 15, qd = lane >> 4, g = wave & 3;
    const int half = wave >> 2;
    LAS float* mrg = (LAS float*)(F.lds + LDSCTL_OFF + 8192) + ((wave & 3) * 64 + lane) * 18;
    LAS unsigned char* slots = F.lds;
    LAS float* rpl = (LAS float*)(F.lds + LDSCTL_OFF + 4096);
#define ATT_BAR() do { asm volatile("s_waitcnt lgkmcnt(0)" ::: "memory"); __builtin_amdgcn_s_barrier(); asm volatile("" ::: "memory"); } while (0)
    const int w0g = g == 0 ? 0 : (g == 1 ? 8 : (g == 2 ? 24 : 32));
    for (int uk = 0; uk < (NA_LAYER ? 4 : 1); ++uk) {
        const int u = F.vcu + 256 * uk;
        const bool is_mem = NA_LAYER ? (u >= 768) : true;
        const int v = is_mem ? (NA_LAYER ? u - 768 : u) : u, bh = v >> 3, seg = v & 7;
        const int b = is_mem ? (bh >> 2) : bh / 12, head = is_mem ? 12 + (bh & 3) : bh % 12, r0 = 8 * seg;
        const int qcol = is_mem ? (NA_LAYER ? 1536 : 2304) + (head - 12) * 64 : head * 64;
        const int w0 = is_mem ? 0 : w0g;
        const bf16 *ga, *gb; size_t stepa, stepb; int la, lb;
        if (is_mem) { const int hm = head - 12;
            if (tid < 256) { const int tok = tid >> 3, c = tid & 7; ga = MEMK + (size_t)(b * NMEM + tok) * 256 + hm * 64 + 8 * c; stepa = 32 * 256; la = tok * 128 + ((c ^ att_fk(tok)) << 4); }
            else { const int t2 = tid - 256, d = t2 >> 2, c = t2 & 3; ga = MEMVT + (size_t)(hm * 64 + d) * (BATCH * NMEM) + b * NMEM + 8 * c; stepa = 32; la = 8192 + d * 128 + ((c ^ att_fv(d)) << 4); }
            gb = ga; stepb = stepa; lb = la;
        } else { const int tok = tid >> 3, c = tid & 7;
            ga = PROJ + (size_t)(b * SEQ + tok) * ldp + 768 + head * 64 + 8 * c; stepa = (size_t)64 * ldp; la = tok * 128 + ((c ^ att_fk(tok)) << 4);
            gb = VT + (size_t)(head * 64 + tok) * M + b * SEQ + 8 * c; stepb = 64; lb = 8192 + tok * 128 + ((c ^ att_fv(tok)) << 4); }
        ATT_BAR();
        if (!is_mem) for (int i = tid; i < 15 * 48; i += NTHREADS) { const int ri = i / 48, cj = i % 48 - 8; rpl[i] = (cj >= 0 && cj < 31) ? rpb[head * 465 + ri * 31 + cj] : 0.f; }
        const int rs0 = is_mem ? 0 : min(max(r0 - 4, 0), 56);
        { v4u ra[8], rb[8];
#pragma unroll
          for (int i = 0; i < 8; ++i) { ra[i] = *(const GAS v4u*)(ga + (size_t)(rs0 + i) * stepa); if (!is_mem) rb[i] = *(const GAS v4u*)(gb + (size_t)(rs0 + i) * stepb); }
#pragma unroll
          for (int i = 0; i < 8; ++i) { *(LAS v4u*)(slots + ((rs0 + i) & 7) * 16384 + la) = ra[i]; if (!is_mem) *(LAS v4u*)(slots + ((rs0 + i) & 7) * 16384 + lb) = rb[i]; } }
        v4u pa0 = {0u, 0u, 0u, 0u}, pb0 = pa0, pa1 = pa0, pb1 = pa0;
#define ATT_RS(r) (is_mem ? 0 : min(max((r) - 4, 0), 56))
#define ATT_SLIDE(r) (!is_mem && (r) + 1 < r0 + 8 && ATT_RS((r) + 1) != ATT_RS(r))
        if (ATT_SLIDE(r0)) { pa0 = *(const GAS v4u*)(ga + (size_t)(ATT_RS(r0) + 8) * stepa); pb0 = *(const GAS v4u*)(gb + (size_t)(ATT_RS(r0) + 8) * stepb); }
        if (ATT_SLIDE(r0 + 1)) { pa1 = *(const GAS v4u*)(ga + (size_t)(ATT_RS(r0 + 1) + 8) * stepa); pb1 = *(const GAS v4u*)(gb + (size_t)(ATT_RS(r0 + 1) + 8) * stepb); }
        const bf16* qp = PROJ + (size_t)(b * SEQ + r0 * 64 + 16 * g + qi) * ldp + qcol + 8 * qd;
        bf16x8 qf0 = ld_frag(qp), qf1 = ld_frag(qp + 32);
        ATT_BAR();
#pragma unroll 2
        for (int rr8 = 0; rr8 < 8; ++rr8) {
            const int r = r0 + rr8, rs = ATT_RS(r);
            bf16x8 qn0 = qf0, qn1 = qf1;
            if (rr8 < 7) { qn0 = ld_frag(qp + (size_t)(rr8 + 1) * 64 * ldp); qn1 = ld_frag(qp + (size_t)(rr8 + 1) * 64 * ldp + 32); }
            float sc[4][8];
#pragma unroll
            for (int bl = 0; bl < 4; ++bl) { const LAS unsigned char* sl = slots + ((rs + 4 * half + bl) & 7) * 16384; bf16x8 kf[2][2];
#pragma unroll
                for (int t = 0; t < 2; ++t) { const int tok = w0 + 8 * (qi >> 2) + 4 * t + (qi & 3); const int fk = att_fk(tok);
                    kf[t][0] = *(const LAS bf16x8*)(sl + tok * 128 + ((qd ^ fk) << 4)); kf[t][1] = *(const LAS bf16x8*)(sl + tok * 128 + (((4 + qd) ^ fk) << 4)); }
#pragma unroll
                for (int t = 0; t < 2; ++t) { f32x4 a = {0.f, 0.f, 0.f, 0.f};
                    a = __builtin_amdgcn_mfma_f32_16x16x32_bf16(kf[t][0], qf0, a, 0, 0, 0);
                    a = __builtin_amdgcn_mfma_f32_16x16x32_bf16(kf[t][1], qf1, a, 0, 0, 0);
#pragma unroll
                    for (int j = 0; j < 4; ++j) sc[bl][4 * t + j] = a[j] * 0.125f; } }
            if (!is_mem) {
                const int c = 16 * g + qi, cs = min(max(c - 8, 0), 48), kc0 = w0 + 8 * qd, lo = cs - kc0, hi = lo + 16;
                const LAS float* rp = rpl + (rs + 4 * half - r + 7) * 48 + 8 + min(max(kc0 - c + 15, -8), 31);
                float bias[4][8];
#pragma unroll
                for (int bl = 0; bl < 4; ++bl)
#pragma unroll
                    for (int e = 0; e < 8; ++e) bias[bl][e] = rp[bl * 48 + e];
#pragma unroll
                for (int bl = 0; bl < 4; ++bl)
#pragma unroll
                    for (int e = 0; e < 8; ++e) sc[bl][e] = (e >= lo && e < hi) ? sc[bl][e] + bias[bl][e] : -INFINITY;
            }
            float mx = -INFINITY;
#pragma unroll
            for (int bl = 0; bl < 4; ++bl)
#pragma unroll
                for (int e = 0; e < 8; ++e) mx = fmaxf(mx, sc[bl][e]);
            mx = qd_max(mx);
            float ls = 0.f; bf16x8 pf[4];
#pragma unroll
            for (int bl = 0; bl < 4; ++bl) { float p[8];
#pragma unroll
                for (int e = 0; e < 8; ++e) { p[e] = __expf(sc[bl][e] - mx); ls += p[e]; }
                u32x4 w; w.x = pk2(p[0], p[1]); w.y = pk2(p[2], p[3]); w.z = pk2(p[4], p[5]); w.w = pk2(p[6], p[7]);
                pf[bl] = __builtin_bit_cast(bf16x8, w); }
            ls = qd_sum(ls);
            f32x4 o[4];
#pragma unroll
            for (int dt = 0; dt < 4; ++dt) o[dt] = (f32x4){0.f, 0.f, 0.f, 0.f};
            const int vc = (w0 >> 3) + qd;
#pragma unroll
            for (int bl = 0; bl < 4; ++bl) { const LAS unsigned char* sl = slots + ((rs + 4 * half + bl) & 7) * 16384 + 8192; bf16x8 vf[4];
#pragma unroll
                for (int dt = 0; dt < 4; ++dt) { const int d = 16 * (qi >> 2) + 4 * dt + (qi & 3); vf[dt] = *(const LAS bf16x8*)(sl + d * 128 + ((vc ^ att_fv(d)) << 4)); }
#pragma unroll
                for (int dt = 0; dt < 4; ++dt) o[dt] = __builtin_amdgcn_mfma_f32_16x16x32_bf16(vf[dt], pf[bl], o[dt], 0, 0, 0); }
            if (half == 1) { mrg[0] = mx; mrg[1] = ls;
#pragma unroll
                for (int dt = 0; dt < 4; ++dt)
#pragma unroll
                    for (int j = 0; j < 4; ++j) mrg[2 + 4 * dt + j] = o[dt][j]; }
            qf0 = qn0; qf1 = qn1;
            ATT_BAR();
            if (half == 0) {
                const float m1 = mrg[0], l1 = mrg[1], mm = fmaxf(mx, m1), f0 = __expf(mx - mm), f1 = __expf(m1 - mm), inv = 1.0f / (ls * f0 + l1 * f1), s0 = f0 * inv, s1 = f1 * inv;
                float ov[16];
#pragma unroll
                for (int dt = 0; dt < 4; ++dt)
#pragma unroll
                    for (int j = 0; j < 4; ++j) ov[4 * dt + j] = o[dt][j] * s0 + mrg[2 + 4 * dt + j] * s1;
                bf16* op = MIXED + (size_t)(b * SEQ + r * 64 + 16 * g + qi) * D + head * 64 + 16 * qd;
                *(GAS u32x4*)op = (u32x4){pk2(ov[0], ov[1]), pk2(ov[2], ov[3]), pk2(ov[4], ov[5]), pk2(ov[6], ov[7])};
                *(GAS u32x4*)(op + 8) = (u32x4){pk2(ov[8], ov[9]), pk2(ov[10], ov[11]), pk2(ov[12], ov[13]), pk2(ov[14], ov[15])};
            }
            if (ATT_SLIDE(r)) {
                const int sl = rs & 7;
                if ((rr8 & 1) == 0) { *(LAS v4u*)(slots + sl * 16384 + la) = pa0; *(LAS v4u*)(slots + sl * 16384 + lb) = pb0; }
                else                { *(LAS v4u*)(slots + sl * 16384 + la) = pa1; *(LAS v4u*)(slots + sl * 16384 + lb) = pb1; }
            }
            if (ATT_SLIDE(r + 2)) {
                if ((rr8 & 1) == 0) { pa0 = *(const GAS v4u*)(ga + (size_t)(ATT_RS(r + 2) + 8) * stepa); pb0 = *(const GAS v4u*)(gb + (size_t)(ATT_RS(r + 2) + 8) * stepb); }
                else                { pa1 = *(const GAS v4u*)(ga + (size_t)(ATT_RS(r + 2) + 8) * stepa); pb1 = *(const GAS v4u*)(gb + (size_t)(ATT_RS(r + 2) + 8) * stepb); }
            }
            ATT_BAR();
        }
    }
#undef ATT_RS
#undef ATT_SLIDE
#undef ATT_BAR
}

struct CvArgs { const float *w1, *w3, *w2; bf16 *W13, *W2; int item0; };
__device__ __forceinline__ void attn_lds_cv(const Frame& F, const bf16* PROJ, const bf16* VT, const bf16* MEMK, const bf16* MEMVT, const float* rpb  , bf16* MIXED, const CvArgs cv) {
    constexpr bool NA_LAYER = true;
    constexpr int ldp = NA_LAYER ? NA_LDP : ML_LDP;
    const int tid = F.tid, lane = F.lane, wave = F.wave, qi = lane & 15, qd = lane >> 4, g = wave & 3;
    const bool compute = wave < 4;
    LAS unsigned char* slots = F.lds;
    LAS float* rpl = (LAS float*)(F.lds + LDSCTL_OFF + 4096);
#define ATT_BAR() do { asm volatile("s_waitcnt lgkmcnt(0)" ::: "memory"); __builtin_amdgcn_s_barrier(); asm volatile("" ::: "memory"); } while (0)
    const int w0g = g == 0 ? 0 : (g == 1 ? 8 : (g == 2 ? 24 : 32));
    float tvA[32]; TrItem itA = {nullptr, nullptr, 0, 0, 0, 0}; bool pend = false;
    LAS unsigned* cscr = (LAS unsigned*)(F.lds + LDSCTL_OFF + 8192 + (wave & 3) * 4352);
    const int cbase = cv.item0 + (F.vcu * 4 + (wave & 3)) * 32;
    for (int uk = 0; uk < (NA_LAYER ? 4 : 1); ++uk) {
        const int u = F.vcu + 256 * uk;
        const bool is_mem = NA_LAYER ? (u >= 768) : true;
        const int v = is_mem ? (NA_LAYER ? u - 768 : u) : u, bh = v >> 3, seg = v & 7;
        const int b = is_mem ? (bh >> 2) : bh / 12, head = is_mem ? 12 + (bh & 3) : bh % 12, r0 = 8 * seg;
        const int qcol = is_mem ? (NA_LAYER ? 1536 : 2304) + (head - 12) * 64 : head * 64;
        const int w0 = is_mem ? 0 : w0g;
        const bf16 *ga, *gb; size_t stepa, stepb; int la, lb;
        if (is_mem) { const int hm = head - 12;
            if (tid < 256) { const int tok = tid >> 3, c = tid & 7; ga = MEMK + (size_t)(b * NMEM + tok) * 256 + hm * 64 + 8 * c; stepa = 32 * 256; la = tok * 128 + ((c ^ att_fk(tok)) << 4); }
            else { const int t2 = tid - 256, d = t2 >> 2, c = t2 & 3; ga = MEMVT + (size_t)(hm * 64 + d) * (BATCH * NMEM) + b * NMEM + 8 * c; stepa = 32; la = 8192 + d * 128 + ((c ^ att_fv(d)) << 4); }
            gb = ga; stepb = stepa; lb = la;
        } else { const int tok = tid >> 3, c = tid & 7;
            ga = PROJ + (size_t)(b * SEQ + tok) * ldp + 768 + head * 64 + 8 * c; stepa = (size_t)64 * ldp; la = tok * 128 + ((c ^ att_fk(tok)) << 4);
            gb = VT + (size_t)(head * 64 + tok) * M + b * SEQ + 8 * c; stepb = 64; lb = 8192 + tok * 128 + ((c ^ att_fv(tok)) << 4); }
        ATT_BAR();
        if (!is_mem) for (int i = tid; i < 15 * 48; i += NTHREADS) { const int ri = i / 48, cj = i % 48 - 8; rpl[i] = (cj >= 0 && cj < 31) ? rpb[head * 465 + ri * 31 + cj] : 0.f; }
        const int rs0 = is_mem ? 0 : min(max(r0 - 4, 0), 56);
        { v4u ra[8], rb[8];
#pragma unroll
          for (int i = 0; i < 8; ++i) { ra[i] = *(const GAS v4u*)(ga + (size_t)(rs0 + i) * stepa); if (!is_mem) rb[i] = *(const GAS v4u*)(gb + (size_t)(rs0 + i) * stepb); }
#pragma unroll
          for (int i = 0; i < 8; ++i) { *(LAS v4u*)(slots + ((rs0 + i) & 7) * 16384 + la) = ra[i]; if (!is_mem) *(LAS v4u*)(slots + ((rs0 + i) & 7) * 16384 + lb) = rb[i]; } }
        v4u pa0 = {0u, 0u, 0u, 0u}, pb0 = pa0, pa1 = pa0, pb1 = pa0;
#define ATT_RS(r) (is_mem ? 0 : min(max((r) - 4, 0), 56))
#define ATT_SLIDE(r) (!is_mem && (r) + 1 < r0 + 8 && ATT_RS((r) + 1) != ATT_RS(r))
        if (ATT_SLIDE(r0)) { pa0 = *(const GAS v4u*)(ga + (size_t)(ATT_RS(r0) + 8) * stepa); pb0 = *(const GAS v4u*)(gb + (size_t)(ATT_RS(r0) + 8) * stepb); }
        if (ATT_SLIDE(r0 + 1)) { pa1 = *(const GAS v4u*)(ga + (size_t)(ATT_RS(r0 + 1) + 8) * stepa); pb1 = *(const GAS v4u*)(gb + (size_t)(ATT_RS(r0 + 1) + 8) * stepb); }
        const bf16* qp = PROJ + (size_t)(b * SEQ + r0 * 64 + 16 * g + qi) * ldp + qcol + 8 * qd;
        bf16x8 qf0 = ld_frag(qp), qf1 = ld_frag(qp + 32);
        ATT_BAR();
#pragma unroll 2
        for (int rr8 = 0; rr8 < 8; ++rr8) {
            const int r = r0 + rr8, rs = ATT_RS(r);
            if (compute) {
                bf16x8 qn0 = qf0, qn1 = qf1;
                if (rr8 < 7) { qn0 = ld_frag(qp + (size_t)(rr8 + 1) * 64 * ldp); qn1 = ld_frag(qp + (size_t)(rr8 + 1) * 64 * ldp + 32); }
                float mx = -INFINITY, ls = 0.f; f32x4 o[4];
#pragma unroll
                for (int dt = 0; dt < 4; ++dt) o[dt] = (f32x4){0.f, 0.f, 0.f, 0.f};
                const int vc = (w0 >> 3) + qd;
#pragma unroll
                for (int half = 0; half < 2; ++half) {
                    float sc[4][8];
#pragma unroll
                    for (int bl = 0; bl < 4; ++bl) { const LAS unsigned char* sl = slots + ((rs + 4 * half + bl) & 7) * 16384; bf16x8 kf[2][2];
#pragma unroll
                        for (int t = 0; t < 2; ++t) { const int tok = w0 + 8 * (qi >> 2) + 4 * t + (qi & 3); const int fk = att_fk(tok);
                            kf[t][0] = *(const LAS bf16x8*)(sl + tok * 128 + ((qd ^ fk) << 4)); kf[t][1] = *(const LAS bf16x8*)(sl + tok * 128 + (((4 + qd) ^ fk) << 4)); }
#pragma unroll
                        for (int t = 0; t < 2; ++t) { f32x4 a = {0.f, 0.f, 0.f, 0.f};
                            a = __builtin_amdgcn_mfma_f32_16x16x32_bf16(kf[t][0], qf0, a, 0, 0, 0);
                            a = __builtin_amdgcn_mfma_f32_16x16x32_bf16(kf[t][1], qf1, a, 0, 0, 0);
#pragma unroll
                            for (int j = 0; j < 4; ++j) sc[bl][4 * t + j] = a[j] * 0.125f; } }
                    if (!is_mem) {
                        const int c = 16 * g + qi, cs = min(max(c - 8, 0), 48), kc0 = w0 + 8 * qd, lo = cs - kc0, hi = lo + 16;
                        const LAS float* rp = rpl + (rs + 4 * half - r + 7) * 48 + 8 + min(max(kc0 - c + 15, -8), 31);
                        float bias[4][8];
#pragma unroll
                        for (int bl = 0; bl < 4; ++bl)
#pragma unroll
                            for (int e = 0; e < 8; ++e) bias[bl][e] = rp[bl * 48 + e];
#pragma unroll
                        for (int bl = 0; bl < 4; ++bl)
#pragma unroll
                            for (int e = 0; e < 8; ++e) sc[bl][e] = (e >= lo && e < hi) ? sc[bl][e] + bias[bl][e] : -INFINITY;
                    }
                    float mh = -INFINITY;
#pragma unroll
                    for (int bl = 0; bl < 4; ++bl)
#pragma unroll
                        for (int e = 0; e < 8; ++e) mh = fmaxf(mh, sc[bl][e]);
                    mh = qd_max(mh);
                    const float mn = fmaxf(mx, mh), fo = __expf(mx - mn);
                    mx = mn; ls *= fo;
#pragma unroll
                    for (int dt = 0; dt < 4; ++dt) o[dt] = o[dt] * fo;
                    float lh = 0.f; bf16x8 pf[4];
#pragma unroll
                    for (int bl = 0; bl < 4; ++bl) { float p[8];
#pragma unroll
                        for (int e = 0; e < 8; ++e) { p[e] = __expf(sc[bl][e] - mn); lh += p[e]; }
                        u32x4 w; w.x = pk2(p[0], p[1]); w.y = pk2(p[2], p[3]); w.z = pk2(p[4], p[5]); w.w = pk2(p[6], p[7]);
                        pf[bl] = __builtin_bit_cast(bf16x8, w); }
                    lh = qd_sum(lh); ls += lh;
#pragma unroll
                    for (int bl = 0; bl < 4; ++bl) { const LAS unsigned char* sl = slots + ((rs + 4 * half + bl) & 7) * 16384 + 8192; bf16x8 vf[4];
#pragma unroll
                        for (int dt = 0; dt < 4; ++dt) { const int d = 16 * (qi >> 2) + 4 * dt + (qi & 3); vf[dt] = *(const LAS bf16x8*)(sl + d * 128 + ((vc ^ att_fv(d)) << 4)); }
#pragma unroll
                        for (int dt = 0; dt < 4; ++dt) o[dt] = __builtin_amdgcn_mfma_f32_16x16x32_bf16(vf[dt], pf[bl], o[dt], 0, 0, 0); }
                }
                const float inv = 1.0f / ls;
                bf16* op = MIXED + (size_t)(b * SEQ + r * 64 + 16 * g + qi) * D + head * 64 + 16 * qd;
                *(GAS u32x4*)op = (u32x4){pk2(o[0][0] * inv, o[0][1] * inv), pk2(o[0][2] * inv, o[0][3] * inv), pk2(o[1][0] * inv, o[1][1] * inv), pk2(o[1][2] * inv, o[1][3] * inv)};
                *(GAS u32x4*)(op + 8) = (u32x4){pk2(o[2][0] * inv, o[2][1] * inv), pk2(o[2][2] * inv, o[2][3] * inv), pk2(o[3][0] * inv, o[3][1] * inv), pk2(o[3][2] * inv, o[3][3] * inv)};
                qf0 = qn0; qf1 = qn1;
            }
            if (!compute) { const int ridx = uk * 8 + rr8;
                if (pend) tr_finish2(itA, lane, tvA, cscr);
                itA = moe_tritem(cbase + ridx, cv.w1, cv.w3, cv.w2, cv.W13, cv.W2); tr_load2(itA, lane, tvA); pend = true; }
            ATT_BAR();
            if (ATT_SLIDE(r)) {
                const int sl = rs & 7;
                if ((rr8 & 1) == 0) { *(LAS v4u*)(slots + sl * 16384 + la) = pa0; *(LAS v4u*)(slots + sl * 16384 + lb) = pb0; }
                else                { *(LAS v4u*)(slots + sl * 16384 + la) = pa1; *(LAS v4u*)(slots + sl * 16384 + lb) = pb1; }
            }
            if (ATT_SLIDE(r + 2)) {
                if ((rr8 & 1) == 0) { pa0 = *(const GAS v4u*)(ga + (size_t)(ATT_RS(r + 2) + 8) * stepa); pb0 = *(const GAS v4u*)(gb + (size_t)(ATT_RS(r + 2) + 8) * stepb); }
                else                { pa1 = *(const GAS v4u*)(ga + (size_t)(ATT_RS(r + 2) + 8) * stepa); pb1 = *(const GAS v4u*)(gb + (size_t)(ATT_RS(r + 2) + 8) * stepb); }
            }
            ATT_BAR();
        }
    }
    if (!compute && pend) tr_finish2(itA, lane, tvA, cscr);
#undef ATT_RS
#undef ATT_SLIDE
#undef ATT_BAR
}

__device__ __forceinline__ void ml_conv(const Frame& F, const bf16* PROJ, const float* cw  , const float* cb  , bf16* QKC) {
    const int gt = F.vcu * NTHREADS + F.tid, NT = F.G * NTHREADS;
    for (int it = gt; it < (M / 16) * 192; it += NT) {
        const int tb = it / 192, c0 = (it - tb * 192) * 8, tok0 = tb * 16, t0 = tok0 & (SEQ - 1);
        v4u rw[20];
#pragma unroll
        for (int k = 0; k < 20; ++k) { const int tt = t0 - 2 + k;
            rw[k] = (tt >= 0 && tt < SEQ) ? *(const GAS v4u*)(PROJ + (size_t)(tok0 - 2 + k) * ML_LDP + c0) : (v4u){0u, 0u, 0u, 0u}; }
        float w[5][8], bs[8];
#pragma unroll
        for (int jj = 0; jj < 5; ++jj) { const f32x4 wa = *(const GAS f32x4*)(cw + jj * 1536 + c0), wb = *(const GAS f32x4*)(cw + jj * 1536 + c0 + 4);
            w[jj][0] = wa.x; w[jj][1] = wa.y; w[jj][2] = wa.z; w[jj][3] = wa.w; w[jj][4] = wb.x; w[jj][5] = wb.y; w[jj][6] = wb.z; w[jj][7] = wb.w; }
        { const f32x4 ba = *(const GAS f32x4*)(cb + c0), bb = *(const GAS f32x4*)(cb + c0 + 4); bs[0] = ba.x; bs[1] = ba.y; bs[2] = ba.z; bs[3] = ba.w; bs[4] = bb.x; bs[5] = bb.y; bs[6] = bb.z; bs[7] = bb.w; }
        const float qs = c0 < TOKW ? 0.07216878364870322f : 1.0f;
#pragma unroll
        for (int i = 0; i < 16; ++i) { float acc[8];
#pragma unroll
            for (int j = 0; j < 8; ++j) acc[j] = bs[j];
#pragma unroll
            for (int jj = 0; jj < 5; ++jj) { const v4u r = rw[i + jj];
                acc[0] += bflo(r.x) * w[jj][0]; acc[1] += bfhi(r.x) * w[jj][1]; acc[2] += bflo(r.y) * w[jj][2]; acc[3] += bfhi(r.y) * w[jj][3];
                acc[4] += bflo(r.z) * w[jj][4]; acc[5] += bfhi(r.z) * w[jj][5]; acc[6] += bflo(r.w) * w[jj][6]; acc[7] += bfhi(r.w) * w[jj][7]; }
#pragma unroll
            for (int j = 0; j < 8; ++j) acc[j] = acc[j] * __builtin_amdgcn_rcpf(1.0f + __expf(-acc[j])) * qs;
            *(GAS v4u*)(QKC + (size_t)(tok0 + i) * 1536 + c0) = (v4u){pk2(acc[0], acc[1]), pk2(acc[2], acc[3]), pk2(acc[4], acc[5]), pk2(acc[6], acc[7])}; }
    }
}
constexpr int ML_QS = 200, ML_TS = 72;
constexpr int MLO_Q = 0, MLO_K = MLO_Q + 64 * ML_QS * 2, MLO_KT = MLO_K + 64 * ML_QS * 2, MLO_VT = MLO_KT + 192 * ML_TS * 2, MLO_S = MLO_VT + 64 * ML_TS * 2, MLO_PX = MLO_S + 64 * ML_TS * 2,
              MLO_SC = MLO_PX + 16 * 64 * 16, MLO_MK = MLO_SC + 2 * 6 * 256, MLO_H = MLO_MK + 1024, MLO_END = MLO_H + 2 * 64 * 48 * 2;
static_assert(MLO_END <= RING_BYTES, "mLSTM LDS map");
constexpr size_t SCAL_TAIL = (size_t)64 * 3 * SEQ;
__device__ __forceinline__ void ml_gate_prepass(const Frame& F, const float* GATES, const float* gate_b, float* SCAL) {
    const int gw = F.vcu * NWAVES + F.wave, NGW = F.G * NWAVES, lane = F.lane;
    for (int job = gw; job < 64 * 64; job += NGW) {
        const int sid = job >> 6, ck = job & 63, b = sid >> 3, h = (sid >> 1) & 3, dir = sid & 1;
        const size_t tok = (size_t)b * SEQ + (dir ? SEQ - 64 * (ck + 1) : 64 * ck) + (dir ? 63 - lane : lane);
        const float li = GATES[tok * 16 + dir * 4 + h] + gate_b[dir * 4 + h], gf = GATES[tok * 16 + (2 + dir) * 4 + h] + gate_b[(2 + dir) * 4 + h];
        float bs = fminf(gf, 0.f) - log1pf(__expf(-fabsf(gf)));
#pragma unroll
        for (int o = 1; o < 64; o <<= 1) { const float t = __shfl_up(bs, o); if (lane >= o) bs += t; }
        const float a = li - bs; float A = a;
#pragma unroll
        for (int o = 1; o < 64; o <<= 1) { const float t = __shfl_up(A, o); if (lane >= o) A = fmaxf(A, t); }
        float* base = SCAL + (size_t)sid * 3 * SEQ + ck * 64 + lane;
        base[0] = bs; base[SEQ] = a; base[2 * SEQ] = A;
        if (lane == 63) { SCAL[SCAL_TAIL + sid * 128 + ck] = bs; SCAL[SCAL_TAIL + sid * 128 + 64 + ck] = A; }
    }
}
__device__ __forceinline__ int ml_krow(int s) { return (s & 48) | ((s & 3) << 2) | ((s >> 2) & 3); }
__device__ __forceinline__ void ml_scan_mfma(const Frame& F, const bf16* QKC, const bf16* VTG  , const float* SCAL, bf16* HOUT  ) {
#define ML_BAR() do { asm volatile("s_waitcnt lgkmcnt(0)" ::: "memory"); __builtin_amdgcn_s_barrier(); asm volatile("" ::: "memory"); } while (0)
    const int x = F.bx & 7, jb = F.bx >> 3;
    const int sid = x * 8 + (jb >> 2), slice = jb & 3;
    const int b = sid >> 3, h = (sid >> 1) & 3, dir = sid & 1;
    const int tid = F.tid, lane = F.lane, wave = F.wave, fr = lane & 15, fq = lane >> 4, et = wave & 3, hf = wave >> 2;
    LAS bf16* Qs = (LAS bf16*)(F.lds + MLO_Q); LAS bf16* Ks = (LAS bf16*)(F.lds + MLO_K); LAS bf16* KTs = (LAS bf16*)(F.lds + MLO_KT);
    LAS bf16* VTs = (LAS bf16*)(F.lds + MLO_VT); LAS bf16* Ss = (LAS bf16*)(F.lds + MLO_S); LAS f32x4* PX = (LAS f32x4*)(F.lds + MLO_PX); LAS float* SC = (LAS float*)(F.lds + MLO_SC);
    for (int i = tid; i < 16 * ML_TS; i += NTHREADS) { const int rr = i / ML_TS, cc = i % ML_TS; VTs[(4 * rr + 3) * ML_TS + cc] = (bf16)0x3F80; }
    LAS float* MK = (LAS float*)(F.lds + MLO_MK); LAS float* B63 = MK + 80;
    if (tid < 64) { B63[tid] = SCAL[SCAL_TAIL + sid * 128 + tid]; B63[64 + tid] = SCAL[SCAL_TAIL + sid * 128 + 64 + tid]; }
    asm volatile("s_waitcnt vmcnt(0) lgkmcnt(0)" ::: "memory"); __builtin_amdgcn_s_barrier(); asm volatile("" ::: "memory");
    if (tid == 0) { float mm = 0.f; MK[0] = 0.f; for (int k = 0; k < 64; ++k) { mm = B63[k] + fmaxf(mm, B63[64 + k]); MK[k + 1] = mm; } }
    f32x4 C[3][2];
#pragma unroll
    for (int i = 0; i < 3; ++i) { C[i][0] = (f32x4){0.f, 0.f, 0.f, 0.f}; C[i][1] = (f32x4){0.f, 0.f, 0.f, 0.f}; }
    v4u qreg[3], kreg[3], vreg = (v4u){0u, 0u, 0u, 0u}; float g_bs = 0.f, g_a = 0.f, g_A = 0.f;
    LAS bf16* Hs = (LAS bf16*)(F.lds + MLO_H);
    size_t hbase1 = 0, hbase2 = 0;
    f32x4 num[4] = {{0.f, 0.f, 0.f, 0.f}, {0.f, 0.f, 0.f, 0.f}, {0.f, 0.f, 0.f, 0.f}, {0.f, 0.f, 0.f, 0.f}};
    const int prow[3] = {tid / 24, (tid + 512) / 24, (tid + 1024) / 24}; const int pc[3] = {tid % 24, (tid + 512) % 24, (tid + 1024) % 24};
    const int vrow = tid >> 3, vc = tid & 7;
#define ML_PREFETCH(kk) do { const size_t tb_ = (size_t)b * SEQ + (dir ? SEQ - 64 * ((kk) + 1) : 64 * (kk)); \
        _Pragma("unroll") for (int i_ = 0; i_ < 3; ++i_) { qreg[i_] = *(const GAS v4u*)(QKC + (tb_ + prow[i_]) * 1536 + h * 192 + 8 * pc[i_]); kreg[i_] = *(const GAS v4u*)(QKC + (tb_ + prow[i_]) * 1536 + 768 + h * 192 + 8 * pc[i_]); } \
        if (tid < 384) vreg = *(const GAS v4u*)(VTG + (size_t)(h * 192 + slice * 48 + vrow) * M + tb_ + 8 * vc); \
        if (wave == 0) { const float* sp_ = SCAL + (size_t)sid * 3 * SEQ + (kk) * 64 + lane; g_bs = sp_[0]; g_a = sp_[SEQ]; g_A = sp_[2 * SEQ]; } } while (0)
    ML_PREFETCH(0);
#define ML_GATES(kk) do { LAS float* sg_ = SC + ((kk) & 1) * (6 * 64); const float mk = MK[(kk)], mnew = MK[(kk) + 1], b63 = B63[(kk)], mt = g_bs + fmaxf(mk, g_A); \
        const int p = dir ? 63 - lane : lane; \
        sg_[p] = g_bs - mt; sg_[64 + p] = g_a; sg_[128 + p] = __expf(g_bs + mk - mt); sg_[192 + p] = __expf(b63 + g_a - mnew); sg_[256 + p] = __expf(-mt); \
        if (lane == 0) sg_[320] = __expf(b63 + mk - mnew); } while (0)
    if (wave == 0) ML_GATES(0);
    ML_BAR();
    unsigned long long sp_t = 0, sp_acc = 0;
#define SP_MARK(r) do { if (MK_SUBPROBE != 0) { const unsigned long long n_ = __builtin_amdgcn_s_memrealtime(); if (MK_SUBPROBE == (r)) sp_acc += n_ - sp_t; sp_t = n_; } } while (0)
    if (MK_SUBPROBE != 0) sp_t = __builtin_amdgcn_s_memrealtime();
    for (int ck = 0; ck < SEQ / 64; ++ck) {
        const size_t tokbase = (size_t)b * SEQ + (dir ? SEQ - 64 * (ck + 1) : 64 * ck);
        LAS float* sc = SC + (ck & 1) * (6 * 64);
#pragma unroll
        for (int i = 0; i < 3; ++i) { *(LAS v4u*)(Qs + prow[i] * ML_QS + 8 * pc[i]) = qreg[i]; *(LAS v4u*)(Ks + ml_krow(prow[i]) * ML_QS + 8 * pc[i]) = kreg[i]; }
        if (tid < 384) *(LAS v4u*)(VTs + (16 * (vrow / 12) + 4 * ((vrow % 12) / 3) + (vrow % 12) % 3) * ML_TS + 8 * vc) = vreg;
        ML_BAR();
        bf16x8 vfw[2];
        { const int lt = wave >> 1, st0 = 2 * (wave & 1);
          bf16x8 qa[6], kb[2][6];
#pragma unroll
          for (int ks = 0; ks < 6; ++ks) { qa[ks] = *(const LAS bf16x8*)(Qs + (16 * lt + fr) * ML_QS + 32 * ks + 8 * fq);
              kb[0][ks] = *(const LAS bf16x8*)(Ks + ml_krow(16 * st0 + fr) * ML_QS + 32 * ks + 8 * fq); kb[1][ks] = *(const LAS bf16x8*)(Ks + ml_krow(16 * st0 + 16 + fr) * ML_QS + 32 * ks + 8 * fq); }
        if (ck > 0) {
            if (hf == 0) { LAS float* scp = SC + ((ck - 1) & 1) * (6 * 64); LAS bf16* Hw = Hs + ((ck - 1) & 1) * (64 * 48);
                f32x4 px[4];
#pragma unroll
                for (int lt = 0; lt < 4; ++lt) px[lt] = PX[(et * 4 + lt) * 64 + lane];
                const float em0 = scp[256 + fr], em1 = scp[256 + 16 + fr], em2 = scp[256 + 32 + fr], em3 = scp[256 + 48 + fr];
#pragma unroll
                for (int lt = 0; lt < 4; ++lt) { const f32x4 o = num[lt] + px[lt]; const float em = lt == 0 ? em0 : (lt == 1 ? em1 : (lt == 2 ? em2 : em3));
                    const float rden = __builtin_amdgcn_rcpf(fmaxf(fabsf(o[3]), em));
                    const unsigned w01 = pk2(o[0] * rden, o[1] * rden), w2 = pk2(o[2] * rden, 0.f); LAS bf16* hq = Hw + (16 * lt + fr) * 48 + 12 * et + 3 * fq;
                    hq[0] = (bf16)(w01 & 0xffffu); hq[1] = (bf16)(w01 >> 16); hq[2] = (bf16)(w2 & 0xffffu); } }
            if (ck > 1 && tid < 384) *(GAS v4u*)(HOUT + hbase2 + (size_t)(tid / 6) * TOKW + 8 * (tid % 6)) = *(const LAS v4u*)(Hs + (ck & 1) * (64 * 48) + (tid / 6) * 48 + 8 * (tid % 6));
        }
#pragma unroll
        for (int ks = 0; ks < 2; ++ks) { const v4u vv = *(const LAS v4u*)(VTs + (16 * et + fr) * ML_TS + 32 * ks + 8 * fq);
            const f32x4 w0 = *(const LAS f32x4*)(sc + 192 + 32 * ks + 8 * fq), w1 = *(const LAS f32x4*)(sc + 192 + 32 * ks + 8 * fq + 4); v4u o;
            o.x = pk2(bflo(vv.x) * w0[0], bfhi(vv.x) * w0[1]); o.y = pk2(bflo(vv.y) * w0[2], bfhi(vv.y) * w0[3]); o.z = pk2(bflo(vv.z) * w1[0], bfhi(vv.z) * w1[1]); o.w = pk2(bflo(vv.w) * w1[2], bfhi(vv.w) * w1[3]);
            vfw[ks] = __builtin_bit_cast(bf16x8, o); }
        if (ck + 1 < SEQ / 64) ML_PREFETCH(ck + 1);
          __builtin_amdgcn_sched_barrier(0);
          f32x4 acc[2] = {{0.f, 0.f, 0.f, 0.f}, {0.f, 0.f, 0.f, 0.f}};
          __builtin_amdgcn_s_setprio(1);
#pragma unroll
          for (int ks = 0; ks < 6; ++ks) { acc[0] = __builtin_amdgcn_mfma_f32_16x16x32_bf16(qa[ks], kb[0][ks], acc[0], 0, 0, 0); acc[1] = __builtin_amdgcn_mfma_f32_16x16x32_bf16(qa[ks], kb[1][ks], acc[1], 0, 0, 0); }
          __builtin_amdgcn_s_setprio(0);
          const f32x4 rt = *(const LAS f32x4*)(sc + 16 * lt + 4 * fq); const float ct0 = sc[64 + 16 * st0 + fr], ct1 = sc[64 + 16 * st0 + 16 + fr];
#pragma unroll
          for (int u = 0; u < 2; ++u) { const int scol = 16 * (st0 + u) + fr; const float ct = u ? ct1 : ct0;
#pragma unroll
            for (int j = 0; j < 4; ++j) { const int l = 16 * lt + 4 * fq + j; const bool ok = dir ? (scol >= l) : (scol <= l);
                const float ev = acc[u][j] * __expf(fminf(rt[j] + ct, 0.f)); Ss[l * ML_TS + scol] = (bf16)f2bf(ok ? ev : 0.f); } } }
        ML_BAR();
        { bf16x8 qf[4][3], sf[2][2], vf[2], kt[3][2][2];
          typedef short s4v __attribute__((ext_vector_type(4)));
          const LAS short* ktbase = (const LAS short*)Ks + (16 * (fq >> 1) + 4 * ((lane & 15) >> 2) + 2 * (fq & 1)) * ML_QS + 96 * hf + 8 * (lane & 3);
#pragma unroll
          for (int lt = 0; lt < 4; ++lt)
#pragma unroll
            for (int blk = 0; blk < 3; ++blk) qf[lt][blk] = *(const LAS bf16x8*)(Qs + (16 * lt + fr) * ML_QS + 96 * hf + 32 * blk + 8 * fq);
#pragma unroll
          for (int ks = 0; ks < 2; ++ks) { vf[ks] = *(const LAS bf16x8*)(VTs + (16 * et + fr) * ML_TS + 32 * ks + 8 * fq);
#pragma unroll
            for (int u = 0; u < 2; ++u) sf[u][ks] = *(const LAS bf16x8*)(Ss + (16 * (2 * hf + u) + fr) * ML_TS + 32 * ks + 8 * fq); }
#pragma unroll
          for (int blk = 0; blk < 3; ++blk)
#pragma unroll
            for (int t = 0; t < 2; ++t)
#pragma unroll
              for (int ks = 0; ks < 2; ++ks) {
                  const s4v lo = __builtin_amdgcn_ds_read_tr16_b64_v4i16((LAS s4v*)(ktbase + (32 * ks) * ML_QS + 32 * blk + 4 * t));
                  const s4v hi = __builtin_amdgcn_ds_read_tr16_b64_v4i16((LAS s4v*)(ktbase + (32 * ks + 1) * ML_QS + 32 * blk + 4 * t));
                  kt[blk][t][ks] = (bf16x8){lo[0], lo[1], lo[2], lo[3], hi[0], hi[1], hi[2], hi[3]}; }
          float wi[4];
#pragma unroll
          for (int lt = 0; lt < 4; ++lt) wi[lt] = sc[128 + 16 * lt + fr];
          const float decay = sc[320];
          __builtin_amdgcn_sched_barrier(0);
          __builtin_amdgcn_s_setprio(1);
#pragma unroll
          for (int lt = 0; lt < 4; ++lt) num[lt] = (f32x4){0.f, 0.f, 0.f, 0.f};
#pragma unroll
          for (int blk = 0; blk < 3; ++blk) { const u32x4 cw = {pk2(C[blk][0][0], C[blk][0][1]), pk2(C[blk][0][2], C[blk][0][3]), pk2(C[blk][1][0], C[blk][1][1]), pk2(C[blk][1][2], C[blk][1][3])};
            const bf16x8 cf = __builtin_bit_cast(bf16x8, cw);
#pragma unroll
            for (int lt = 0; lt < 4; ++lt) num[lt] = __builtin_amdgcn_mfma_f32_16x16x32_bf16(cf, qf[lt][blk], num[lt], 0, 0, 0); }
#pragma unroll
          for (int blk = 0; blk < 3; ++blk)
#pragma unroll
            for (int t = 0; t < 2; ++t) { C[blk][t] = C[blk][t] * decay;
#pragma unroll
                for (int ks = 0; ks < 2; ++ks) C[blk][t] = __builtin_amdgcn_mfma_f32_16x16x32_bf16(kt[blk][t][ks], vfw[ks], C[blk][t], 0, 0, 0); }
#pragma unroll
          for (int lt = 0; lt < 4; ++lt) num[lt] = num[lt] * wi[lt];
          if (hf == 0) {
#pragma unroll
            for (int u = 0; u < 2; ++u)
#pragma unroll
              for (int ks = 0; ks < 2; ++ks) num[u] = __builtin_amdgcn_mfma_f32_16x16x32_bf16(vf[ks], sf[u][ks], num[u], 0, 0, 0);
          } else {
#pragma unroll
            for (int u = 0; u < 2; ++u)
#pragma unroll
              for (int ks = 0; ks < 2; ++ks) num[2 + u] = __builtin_amdgcn_mfma_f32_16x16x32_bf16(vf[ks], sf[u][ks], num[2 + u], 0, 0, 0);
#pragma unroll
            for (int lt = 0; lt < 4; ++lt) PX[(et * 4 + lt) * 64 + lane] = num[lt];
          }
          __builtin_amdgcn_s_setprio(0); }
        if (wave == 0 && ck + 1 < SEQ / 64) ML_GATES(ck + 1);
        ML_BAR();
        hbase2 = hbase1; hbase1 = (size_t)dir * M * TOKW + tokbase * TOKW + h * 192 + slice * 48;
    }
    if (MK_SUBPROBE != 0 && F.bx == 0 && tid == 0) *(LAS unsigned long long*)(F.lds + L_PROBE) += sp_acc;
    if (hf == 0) { LAS float* scp = SC + 1 * (6 * 64); LAS bf16* Hw = Hs + 1 * (64 * 48);
        f32x4 px[4];
#pragma unroll
        for (int lt = 0; lt < 4; ++lt) px[lt] = PX[(et * 4 + lt) * 64 + lane];
        const float em0 = scp[256 + fr], em1 = scp[256 + 16 + fr], em2 = scp[256 + 32 + fr], em3 = scp[256 + 48 + fr];
#pragma unroll
        for (int lt = 0; lt < 4; ++lt) { const f32x4 o = num[lt] + px[lt]; const float em = lt == 0 ? em0 : (lt == 1 ? em1 : (lt == 2 ? em2 : em3));
            const float rden = __builtin_amdgcn_rcpf(fmaxf(fabsf(o[3]), em));
            const unsigned w01 = pk2(o[0] * rden, o[1] * rden), w2 = pk2(o[2] * rden, 0.f); LAS bf16* hq = Hw + (16 * lt + fr) * 48 + 12 * et + 3 * fq;
            hq[0] = (bf16)(w01 & 0xffffu); hq[1] = (bf16)(w01 >> 16); hq[2] = (bf16)(w2 & 0xffffu); } }
    ML_BAR();
    if (tid < 384) { *(GAS v4u*)(HOUT + hbase2 + (size_t)(tid / 6) * TOKW + 8 * (tid % 6)) = *(const LAS v4u*)(Hs + (tid / 6) * 48 + 8 * (tid % 6));
                     *(GAS v4u*)(HOUT + hbase1 + (size_t)(tid / 6) * TOKW + 8 * (tid % 6)) = *(const LAS v4u*)(Hs + 64 * 48 + (tid / 6) * 48 + 8 * (tid % 6)); }
#undef SP_MARK
#undef ML_PREFETCH
#undef ML_BAR
}
__device__ __forceinline__ float row16_sum(float v) {
    v += dpp_mov<0xB1>(v); v += dpp_mov<0x4E>(v); v += dpp_mov<0x141>(v); v += dpp_mov<0x140>(v); return v;
}
__device__ __forceinline__ void ml_norm_gate(const Frame& F, const bf16* PROJ, const bf16* HOUT, const float* norm_g  , bf16* MIXED) {
    const int gw = F.vcu * NWAVES + F.wave, NGW = F.G * NWAVES, lane = F.lane;
    const int c0 = lane * 12;
    float ng[12];
#pragma unroll
    for (int i = 0; i < 3; ++i) { const f32x4 t = *(const GAS f32x4*)(norm_g + c0 + 4 * i); ng[4 * i] = t.x; ng[4 * i + 1] = t.y; ng[4 * i + 2] = t.z; ng[4 * i + 3] = t.w; }
    typedef unsigned u32x2v __attribute__((ext_vector_type(2)));
    u32x2v ca[3], cb[3], co[3];
    int tok = gw;
    if (tok < M) {
#pragma unroll
        for (int i = 0; i < 3; ++i) { ca[i] = *(const GAS u32x2v*)(HOUT + (size_t)tok * TOKW + c0 + 4 * i); cb[i] = *(const GAS u32x2v*)(HOUT + (size_t)M * TOKW + (size_t)tok * TOKW + c0 + 4 * i);
            co[i] = *(const GAS u32x2v*)(PROJ + (size_t)tok * ML_LDP + 1536 + c0 + 4 * i); } }
    while (tok < M) {
        const int ntok = tok + NGW; u32x2v na[3], nb[3], no[3];
        if (ntok < M) {
#pragma unroll
            for (int i = 0; i < 3; ++i) { na[i] = *(const GAS u32x2v*)(HOUT + (size_t)ntok * TOKW + c0 + 4 * i); nb[i] = *(const GAS u32x2v*)(HOUT + (size_t)M * TOKW + (size_t)ntok * TOKW + c0 + 4 * i);
                no[i] = *(const GAS u32x2v*)(PROJ + (size_t)ntok * ML_LDP + 1536 + c0 + 4 * i); } }
        float v[12], op[12]; float s = 0.f;
#pragma unroll
        for (int i = 0; i < 3; ++i) { const u32x2v a = ca[i], b = cb[i], o = co[i];
            v[4 * i] = bflo(a.x) + bflo(b.x); v[4 * i + 1] = bfhi(a.x) + bfhi(b.x); v[4 * i + 2] = bflo(a.y) + bflo(b.y); v[4 * i + 3] = bfhi(a.y) + bfhi(b.y);
            op[4 * i] = bflo(o.x); op[4 * i + 1] = bfhi(o.x); op[4 * i + 2] = bflo(o.y); op[4 * i + 3] = bfhi(o.y); }
#pragma unroll
        for (int i = 0; i < 12; ++i) s += v[i];
        const float mu = row16_sum(s) * (1.0f / 192.0f); float q = 0.f;
#pragma unroll
        for (int i = 0; i < 12; ++i) { v[i] -= mu; q += v[i] * v[i]; }
        const float rstd = 1.0f / sqrtf(row16_sum(q) * (1.0f / 192.0f) + LN_EPS);
        float r[12];
#pragma unroll
        for (int i = 0; i < 12; ++i) r[i] = v[i] * rstd * ng[i] * __builtin_amdgcn_rcpf(1.0f + __expf(-op[i]));
#pragma unroll
        for (int i = 0; i < 3; ++i) *(GAS u32x2v*)(MIXED + (size_t)tok * D + c0 + 4 * i) = (u32x2v){pk2(r[4 * i], r[4 * i + 1]), pk2(r[4 * i + 2], r[4 * i + 3])};
#pragma unroll
        for (int i = 0; i < 3; ++i) { ca[i] = na[i]; cb[i] = nb[i]; co[i] = no[i]; }
        tok = ntok;
    }
}

__device__ __forceinline__ void pd_loadx(u32x4 (&dst)[4], const bf16* xr, int blk) {
#pragma unroll
    for (int q = 0; q < 4; ++q) dst[q] = *(const GAS u32x4*)(xr + 32 * (4 * blk + q));
}
constexpr int PD_ROWB = 272, PD_SLICE = 96 * PD_ROWB;
__device__ __forceinline__ void pd_block(const u32x4 (&cur)[4], const LAS unsigned char* wsl, int fr, int fq, f32x4 (&acc)[3], float& s, float& s2) {
    bf16x8 wh[4][3], wl[4][3];
#pragma unroll
    for (int q = 0; q < 4; ++q)
#pragma unroll
        for (int nt = 0; nt < 3; ++nt) { wh[q][nt] = *(const LAS bf16x8*)(wsl + (16 * nt + fr) * PD_ROWB + 64 * q + 16 * fq); wl[q][nt] = *(const LAS bf16x8*)(wsl + (48 + 16 * nt + fr) * PD_ROWB + 64 * q + 16 * fq); }
    __builtin_amdgcn_sched_barrier(0);
#pragma unroll
    for (int q = 0; q < 4; ++q) { const u32x4 w = cur[q];
        const float x0 = bflo(w.x), x1 = bfhi(w.x), x2 = bflo(w.y), x3 = bfhi(w.y), x4 = bflo(w.z), x5 = bfhi(w.z), x6 = bflo(w.w), x7 = bfhi(w.w);
        s += ((x0 + x1) + (x2 + x3)) + ((x4 + x5) + (x6 + x7));
        s2 += ((x0 * x0 + x1 * x1) + (x2 * x2 + x3 * x3)) + ((x4 * x4 + x5 * x5) + (x6 * x6 + x7 * x7));
        const bf16x8 ah = __builtin_bit_cast(bf16x8, w);
#pragma unroll
        for (int nt = 0; nt < 3; ++nt) {
            acc[nt] = __builtin_amdgcn_mfma_f32_16x16x32_bf16(ah, wh[q][nt], acc[nt], 0, 0, 0);
            acc[nt] = __builtin_amdgcn_mfma_f32_16x16x32_bf16(ah, wl[q][nt], acc[nt], 0, 0, 0); } }
}
__device__ __forceinline__ void ln1_route(const Frame& F, const bf16* PRE, const bf16* WR  , const float* RGB  , float* STATS,
                                           int* TOKE, float* TOKG, int* TOKP, int* ROWSLOT, gu32* cnt, int* WGBASE) {
    const int gw = F.vcu * NWAVES + F.wave, NGW = F.G * NWAVES, lane = F.lane, fr = lane & 15, fq = lane >> 4;
    LAS int* HIST = (LAS int*)(F.lds + L_HIST);
    LAS float* lg = (LAS float*)(F.lds + 8192 + F.wave * 4096);
    if (F.tid < 32) HIST[F.tid] = 0;
    { const int gt = F.vcu * NTHREADS + F.tid, NT = F.G * NTHREADS; for (int i = gt; i < P_MAX; i += NT) ROWSLOT[i] = -1; }
    __syncthreads();
    LAS unsigned char* wbuf = F.lds + 49152;
    for (int jb = F.vcu; jb < M / 128; jb += F.G) {
        const int job = jb * 8 + F.wave, row0 = job * 16;
        const bf16* xr = PRE + (size_t)(row0 + fr) * D + 8 * fq;
        float s = 0.f, s2 = 0.f;
        f32x4 acc[3] = {{0.f, 0.f, 0.f, 0.f}, {0.f, 0.f, 0.f, 0.f}, {0.f, 0.f, 0.f, 0.f}};
        const bf16* wsrc[3]; int wdst[3];
#pragma unroll
        for (int i = 0; i < 3; ++i) { const int q = F.tid + 512 * i; wsrc[i] = WR + (size_t)(q >> 4) * D + 8 * (q & 15); wdst[i] = (q >> 4) * PD_ROWB + 16 * (q & 15); }
        v4u wr[3];
#pragma unroll
        for (int i = 0; i < 3; ++i) wr[i] = *(const GAS v4u*)(wsrc[i]);
        u32x4 xa[4], xb[4];
        pd_loadx(xa, xr, 0);
        __syncthreads();
#pragma unroll
        for (int i = 0; i < 3; ++i) *(LAS v4u*)(wbuf + wdst[i]) = wr[i];
#pragma unroll
        for (int i = 0; i < 3; ++i) wr[i] = *(const GAS v4u*)(wsrc[i] + 128);
        __syncthreads();
#pragma unroll 1
        for (int bp = 0; bp < 4; ++bp) {
            pd_loadx(xb, xr, 2 * bp + 1);
            pd_block(xa, wbuf, fr, fq, acc, s, s2);
#pragma unroll
            for (int i = 0; i < 3; ++i) *(LAS v4u*)(wbuf + PD_SLICE + wdst[i]) = wr[i];
            if (bp < 3) {
#pragma unroll
                for (int i = 0; i < 3; ++i) wr[i] = *(const GAS v4u*)(wsrc[i] + 128 * (2 * bp + 2)); }
            __syncthreads();
            if (bp < 3) pd_loadx(xa, xr, 2 * bp + 2);
            pd_block(xb, wbuf + PD_SLICE, fr, fq, acc, s, s2);
            if (bp < 3) {
#pragma unroll
                for (int i = 0; i < 3; ++i) *(LAS v4u*)(wbuf + wdst[i]) = wr[i];
#pragma unroll
                for (int i = 0; i < 3; ++i) wr[i] = *(const GAS v4u*)(wsrc[i] + 128 * (2 * bp + 3)); }
            __syncthreads();
        }
        s = qd_sum(s); s2 = qd_sum(s2);
        const float mean = s * (1.f / D), rstd = 1.f / sqrtf(fmaxf(s2 * (1.f / D) - mean * mean, 0.f) + LN_EPS);
#pragma unroll
        for (int nt = 0; nt < 3; ++nt)
#pragma unroll
            for (int j = 0; j < 4; ++j) lg[(4 * fq + j) * 52 + 16 * nt + fr] = acc[nt][j];
        asm volatile("s_waitcnt lgkmcnt(0)" ::: "memory");
        if (lane < 16) {
            const LAS float* lr = lg + lane * 52; const int row = row0 + lane;
            STATS[2 * row] = mean; STATS[2 * row + 1] = rstd;
            float gl[4];
#pragma unroll
            for (int g = 0; g < 4; ++g) gl[g] = rstd * (lr[g] - mean * RGB[g]) + RGB[48 + g];
            int gi = 0; float gm = gl[0];
#pragma unroll
            for (int g = 1; g < 4; ++g) if (gl[g] > gm) { gm = gl[g]; gi = g; }
            float gs = 0.f;
#pragma unroll
            for (int g = 0; g < 4; ++g) gs += __expf(gl[g] - gm);
            const float ggate = 1.0f / gs;
            float el[8];
#pragma unroll
            for (int i = 0; i < 8; ++i) el[i] = rstd * (lr[4 + gi * 8 + i] - mean * RGB[4 + gi * 8 + i]) + RGB[48 + 4 + gi * 8 + i];
            int i0 = 0; float l0 = el[0];
#pragma unroll
            for (int i = 1; i < 8; ++i) if (el[i] > l0) { l0 = el[i]; i0 = i; }
            int i1 = -1; float l1 = -INFINITY;
#pragma unroll
            for (int i = 0; i < 8; ++i) if (i != i0 && el[i] > l1) { l1 = el[i]; i1 = i; }
            const float p0 = 1.0f / (1.0f + __expf(l1 - l0)), p1 = 1.0f - p0;
            const int e0 = gi * 8 + i0, e1 = gi * 8 + i1;
            const int q0 = atomicAdd((int*)(HIST + e0), 1), q1 = atomicAdd((int*)(HIST + e1), 1);
            TOKE[2 * row] = e0; TOKE[2 * row + 1] = e1; TOKG[2 * row] = ggate * p0; TOKG[2 * row + 1] = ggate * p1; TOKP[2 * row] = q0; TOKP[2 * row + 1] = q1;
        }
    }
    __syncthreads();
    if (F.tid < 32) WGBASE[F.tid] = (int)__hip_atomic_fetch_add(cnt + F.tid, (unsigned)HIST[F.tid], __ATOMIC_RELAXED, __HIP_MEMORY_SCOPE_AGENT);
    __syncthreads();
}
__device__ __forceinline__ void moe_gather(const Frame& F, const bf16* PRE, const float* STATS, const float* g1, const float* b1, const int* TOKE, const float* TOKG, const int* TOKP, int* ROWSLOT, float* ROWGATE, bf16* XS, gu32* cnt, int* TILETAB, const int* WGBASE) {
    const int gw = F.vcu * NWAVES + F.wave, NGW = F.G * NWAVES, lane = F.lane;
    LAS int* PADSTART = (LAS int*)(F.lds + L_PADSTART); LAS int* CNT = (LAS int*)(F.lds + L_CNT);
    if (F.tid < 32) CNT[F.tid] = (int)__hip_atomic_load(cnt + F.tid, __ATOMIC_RELAXED, __HIP_MEMORY_SCOPE_AGENT);
    __syncthreads();
    if (F.tid == 0) { int t = 0;
        for (int e = 0; e < NEXP; ++e) { PADSTART[e] = t * 256; const int nt = (CNT[e] + 255) >> 8;
            if (F.bx == 0) for (int k = 0; k < nt; ++k) TILETAB[1 + t + k] = e;
            t += nt; }
        if (F.bx == 0) TILETAB[0] = t; }
    __syncthreads();
    f32x4 G1[4], B1[4];
#pragma unroll
    for (int j = 0; j < 4; ++j) { const int col = 4 * lane + 256 * j; G1[j] = *(const GAS f32x4*)(g1 + col); B1[j] = *(const GAS f32x4*)(b1 + col); }
    for (int job = gw; job < M / 16; job += NGW) {
        unsigned long long xc[4]; float mc, rc; int ec0, ec1, qc0, qc1; float gc0, gc1;
        { const int row = job * 16;
#pragma unroll
          for (int j = 0; j < 4; ++j) xc[j] = ((const GAS unsigned long long*)(PRE + (size_t)row * D) + lane)[64 * j];
          mc = STATS[2 * row]; rc = STATS[2 * row + 1]; ec0 = TOKE[2 * row]; ec1 = TOKE[2 * row + 1]; qc0 = TOKP[2 * row]; qc1 = TOKP[2 * row + 1]; gc0 = TOKG[2 * row]; gc1 = TOKG[2 * row + 1]; }
        for (int ri = 0; ri < 16; ++ri) { const int row = job * 16 + ri;
            unsigned long long xn[4]; float mn = 0.f, rn = 0.f; int en0 = 0, en1 = 0, qn0 = 0, qn1 = 0; float gn0 = 0.f, gn1 = 0.f;
            if (ri < 15) { const int nrow = row + 1;
#pragma unroll
                for (int j = 0; j < 4; ++j) xn[j] = ((const GAS unsigned long long*)(PRE + (size_t)nrow * D) + lane)[64 * j];
                mn = STATS[2 * nrow]; rn = STATS[2 * nrow + 1]; en0 = TOKE[2 * nrow]; en1 = TOKE[2 * nrow + 1]; qn0 = TOKP[2 * nrow]; qn1 = TOKP[2 * nrow + 1]; gn0 = TOKG[2 * nrow]; gn1 = TOKG[2 * nrow + 1]; }
            unsigned long long pk[4];
#pragma unroll
            for (int j = 0; j < 4; ++j) { const unsigned x0 = (unsigned)xc[j], x1 = (unsigned)(xc[j] >> 32); const f32x4 xf = {bflo(x0), bfhi(x0), bflo(x1), bfhi(x1)}; const f32x4 v = (xf - mc) * rc * G1[j] + B1[j]; pk[j] = (unsigned long long)pk2(v.x, v.y) | ((unsigned long long)pk2(v.z, v.w) << 32); }
#pragma unroll
            for (int k = 0; k < 2; ++k) { const int e = k ? ec1 : ec0, q = k ? qc1 : qc0; const int dest = PADSTART[e] + WGBASE[e] + q;
                if (lane == 0) { ROWSLOT[dest] = 2 * row + k; ROWGATE[dest] = k ? gc1 : gc0; }
                GAS unsigned long long* o8 = (GAS unsigned long long*)(XS + (size_t)dest * D) + lane;
#pragma unroll
                for (int j = 0; j < 4; ++j) o8[64 * j] = pk[j]; }
#pragma unroll
            for (int j = 0; j < 4; ++j) xc[j] = xn[j];
            mc = mn; rc = rn; ec0 = en0; ec1 = en1; qc0 = qn0; qc1 = qn1; gc0 = gn0; gc1 = gn1;
        }
    }
}
__device__ __forceinline__ void ln2_pass(const Frame& F, const bf16* PRE, const float* STATS, const float* g1, const float* b1, const bf16* Y, const float* g2, const float* b2, float* XOUT  , bf16* XB) {
    const int gw = F.vcu * NWAVES + F.wave, NGW = F.G * NWAVES, lane = F.lane;
    typedef unsigned long long u64;
    f32x4 G1[4], B1[4], G2[4], B2[4];
#pragma unroll
    for (int j = 0; j < 4; ++j) { const int col = 4 * lane + 256 * j; G1[j] = *(const GAS f32x4*)(g1 + col); B1[j] = *(const GAS f32x4*)(b1 + col); G2[j] = *(const GAS f32x4*)(g2 + col); B2[j] = *(const GAS f32x4*)(b2 + col); }
    u64 xc[4], y0c[4], y1c[4]; float m1c = 0.f, r1c = 0.f;
    int row = gw;
    if (row < M) {
#pragma unroll
        for (int j = 0; j < 4; ++j) { xc[j] = ((const GAS u64*)(PRE + (size_t)row * D) + lane)[64 * j]; y0c[j] = ((const GAS u64*)(Y + (size_t)(2 * row) * D) + lane)[64 * j]; y1c[j] = ((const GAS u64*)(Y + (size_t)(2 * row + 1) * D) + lane)[64 * j]; }
        m1c = STATS[2 * row]; r1c = STATS[2 * row + 1]; }
    while (row < M) {
        const int nrow = row + NGW; u64 xn[4], y0n[4], y1n[4]; float m1n = 0.f, r1n = 0.f;
        if (nrow < M) {
#pragma unroll
            for (int j = 0; j < 4; ++j) { xn[j] = ((const GAS u64*)(PRE + (size_t)nrow * D) + lane)[64 * j]; y0n[j] = ((const GAS u64*)(Y + (size_t)(2 * nrow) * D) + lane)[64 * j]; y1n[j] = ((const GAS u64*)(Y + (size_t)(2 * nrow + 1) * D) + lane)[64 * j]; }
            m1n = STATS[2 * nrow]; r1n = STATS[2 * nrow + 1]; }
        f32x4 v[4]; float s = 0.f;
#pragma unroll
        for (int j = 0; j < 4; ++j) { const unsigned p0 = (unsigned)xc[j], p1 = (unsigned)(xc[j] >> 32); const f32x4 xf = {bflo(p0), bfhi(p0), bflo(p1), bfhi(p1)};
            const f32x4 x = (xf - m1c) * r1c * G1[j] + B1[j];
            const unsigned a0 = (unsigned)y0c[j], a1 = (unsigned)(y0c[j] >> 32), c0 = (unsigned)y1c[j], c1 = (unsigned)(y1c[j] >> 32);
            v[j].x = ALPHA * x.x + (bflo(a0) + bflo(c0)); v[j].y = ALPHA * x.y + (bfhi(a0) + bfhi(c0)); v[j].z = ALPHA * x.z + (bflo(a1) + bflo(c1)); v[j].w = ALPHA * x.w + (bfhi(a1) + bfhi(c1));
            s += (v[j].x + v[j].y) + (v[j].z + v[j].w); }
        const float mean = wave_sum(s) * (1.f / D); float s2 = 0.f;
#pragma unroll
        for (int j = 0; j < 4; ++j) { v[j] = v[j] - mean; s2 += (v[j].x * v[j].x + v[j].y * v[j].y) + (v[j].z * v[j].z + v[j].w * v[j].w); }
        const float rstd = 1.f / sqrtf(wave_sum(s2) * (1.f / D) + LN_EPS);
        GAS f32x4* orow = (GAS f32x4*)(XOUT + (size_t)row * D) + lane; GAS u64* ob = (GAS u64*)(XB + (size_t)row * D) + lane;
#pragma unroll
        for (int j = 0; j < 4; ++j) { const f32x4 y = v[j] * rstd * G2[j] + B2[j]; if (XOUT != nullptr) orow[64 * j] = y; else ob[64 * j] = (u64)pk2(y.x, y.y) | ((u64)pk2(y.z, y.w) << 32); }
#pragma unroll
        for (int j = 0; j < 4; ++j) { xc[j] = xn[j]; y0c[j] = y0n[j]; y1c[j] = y1n[j]; }
        m1c = m1n; r1c = r1n; row = nrow;
    }
}

struct Args { const float* in[22]; float* out; unsigned char* ws; int ph_lo, ph_hi; };
static_assert(sizeof(Args) == 22 * 8 + 8 + 8 + 8, "Args has no padding");
enum PhaseKind { K_P0 = 0, K_P1, K_PA, K_PB, K_PB2, K_PB3, K_PC, K_PD, K_PE, K_PF, K_PG, K_PH };
constexpr int N_PHASES = 2 + 2 * 8 + 2 * 10;
__device__ __forceinline__ void decode_phase(int ph, int& layer, int& kind) {
    if (ph < 2) { layer = 0; kind = ph; return; }
    int r = ph - 2; const int pair = r / 18; r -= pair * 18;
    if (r < 8) { layer = 2 * pair; kind = r == 0 ? K_PA : (r == 1 ? K_PB : K_PC + (r - 2)); }
    else { r -= 8; layer = 2 * pair + 1; kind = K_PA + r; }
}
__host__ __device__ constexpr int phase_layer(int ph) { if (ph < 2) return 0; int r = ph - 2; const int pair = r / 18; r -= pair * 18; return r < 8 ? 2 * pair : 2 * pair + 1; }
__host__ __device__ constexpr int phase_kind(int ph) { if (ph < 2) return ph; int r = ph - 2; const int pair = r / 18; r -= pair * 18;
    if (r < 8) return r == 0 ? K_PA : (r == 1 ? K_PB : K_PC + (r - 2)); return K_PA + (r - 8); }
template <int PH>
__device__ __forceinline__ void run_phase(const Args& args, LAS unsigned char* lds) {
    constexpr int layer = phase_layer(PH), kind = phase_kind(PH), jj = layer >> 1; constexpr bool is_na = (layer & 1) == 0;
    int tid_ = threadIdx.x; asm volatile("" : "+v"(tid_));
    int bx_ = blockIdx.x; asm volatile("" : "+s"(bx_));
    Frame F;
    F.lds = lds;
    F.tid = tid_; F.lane = F.tid & 63; F.wave = __builtin_amdgcn_readfirstlane(F.tid >> 6);
    F.G = gridDim.x; F.bx = bx_; F.vcu = (F.G % 8 == 0) ? (bx_ % 8) * (F.G / 8) + bx_ / 8 : bx_;
    unsigned char* ws = args.ws; asm volatile("" : "+s"(ws)); F.ctl = (gu32*)(ws + WS_CTL);
    float* const outp = args.out;
#define IN_(k) (args.in[k])
        if constexpr (kind == K_P0) {
        P0Args a{IN_(0), IN_(1), IN_(2), IN_(3), IN_(5), IN_(10), IN_(19), IN_(20), IN_(21), IN_(15), IN_(17), IN_(11), IN_(12), IN_(16), IN_(18), ws};
        p0_prologue(F, a);
    }
    if constexpr (kind == K_P1) {
        { pg8::Gemm g{(const bf16*)(ws + WS_MEMB), (const bf16*)(ws + WS_WMEMKV), BATCH * NMEM, 256, D}; pg8::StaticOrder S; S.init(BATCH * NMEM, 256, F.G, F.bx);
          pg8::EpiProj E{(bf16*)(ws + WS_MEMK), 256, nullptr, 0};
          pg8::gemm_phase<pg8::EpiProj, pg8::StaticOrder, PG8_ALIGN, PG8_SP2>(F.lds, g, S, E); }
        { pg8::Gemm g{(const bf16*)(ws + WS_WMEMKV) + (size_t)256 * D, (const bf16*)(ws + WS_MEMB), 256, BATCH * NMEM, D}; pg8::StaticOrder S; S.init(256, BATCH * NMEM, F.G, (F.bx + 128) % F.G);
          pg8::EpiProj E{(bf16*)(ws + WS_MEMVT), BATCH * NMEM, nullptr, 0};
          pg8::gemm_phase<pg8::EpiProj, pg8::StaticOrder, PG8_ALIGN, PG8_SP2>(F.lds, g, S, E); }
    }
    if constexpr (kind == K_PA) {
        if constexpr (is_na) {
            const bf16* W = (const bf16*)(ws + WS_WINNA) + (size_t)jj * NA_IN * D;
            { pg8::Gemm g{(const bf16*)(ws + WS_XB), W, M, NA_LDP, D}; pg8::StaticOrder S; S.init(M, NA_LDP, F.G, F.bx);
              pg8::EpiProj E{(bf16*)(ws + WS_PROJ), NA_LDP, nullptr, 0};
              pg8::gemm_phase<pg8::EpiProj, pg8::StaticOrder, PG8_ALIGN, PG8_SP2>(F.lds, g, S, E); }
            { pg8::Gemm g{W + (size_t)NA_LDP * D, (const bf16*)(ws + WS_XB), TOKW, M, D}; pg8::StaticOrder S; S.init(TOKW, M, F.G, (F.bx + 128) % F.G);
              pg8::EpiProj E{(bf16*)(ws + WS_VT), M, nullptr, 0};
              pg8::gemm_phase<pg8::EpiProj, pg8::StaticOrder, PG8_ALIGN, PG8_SP2>(F.lds, g, S, E); }
        } else {
            const bf16* W = (const bf16*)(ws + WS_WINML) + (size_t)jj * ML_INP * D;
            { pg8::Gemm g{(const bf16*)(ws + WS_XB), W, M, ML_LDP, D}; pg8::StaticOrder S; S.init(M, ML_LDP, F.G, F.bx);
              pg8::EpiProj E{(bf16*)(ws + WS_PROJ), ML_LDP, (float*)(ws + WS_GATES), ML_GATE_PN};
              pg8::gemm_phase<pg8::EpiProj, pg8::StaticOrder, PG8_ALIGN, PG8_SP2>(F.lds, g, S, E); }
            { pg8::Gemm g{W + (size_t)ML_LDP * D, (const bf16*)(ws + WS_XB), TOKW, M, D}; pg8::StaticOrder S; S.init(TOKW, M, F.G, (F.bx + 128) % F.G);
              pg8::EpiProj E{(bf16*)(ws + WS_VTML), M, nullptr, 0};
              pg8::gemm_phase<pg8::EpiProj, pg8::StaticOrder, PG8_ALIGN, PG8_SP2>(F.lds, g, S, E); }
        }
    }
    if constexpr (kind == K_PB) {
        if constexpr (is_na) attn_lds_cv(F, (const bf16*)(ws + WS_PROJ), (const bf16*)(ws + WS_VT), (const bf16*)(ws + WS_MEMK), (const bf16*)(ws + WS_MEMVT), IN_(4) + (size_t)jj * NAH * 15 * 31, (bf16*)(ws + WS_MIXED),
                                         CvArgs{IN_(19), IN_(20), IN_(21), (bf16*)(ws + WS_W13), (bf16*)(ws + WS_W2), 32768 + jj * 32768});
        else { attn_lds<false>(F, (const bf16*)(ws + WS_PROJ), nullptr, (const bf16*)(ws + WS_MEMK), (const bf16*)(ws + WS_MEMVT), nullptr, (bf16*)(ws + WS_MIXED));
               ml_conv(F, (const bf16*)(ws + WS_PROJ), IN_(6) + (size_t)jj * 5 * 1536, IN_(7) + (size_t)jj * 1536, (bf16*)(ws + WS_QKC));
               ml_gate_prepass(F, (const float*)(ws + WS_GATES), IN_(8) + (size_t)jj * 16, (float*)(ws + WS_SCAL)); }
    }
    if constexpr (kind == K_PB2) {
        ml_scan_mfma(F, (const bf16*)(ws + WS_QKC), (const bf16*)(ws + WS_VTML), (const float*)(ws + WS_SCAL), (bf16*)(ws + WS_H));
    }
    if constexpr (kind == K_PB3) {
        ml_norm_gate(F, (const bf16*)(ws + WS_PROJ), (const bf16*)(ws + WS_H), IN_(9) + (size_t)jj * TOKW, (bf16*)(ws + WS_MIXED));
    }
    if constexpr (kind == K_PC) {
        pg8::Gemm g{(const bf16*)(ws + WS_MIXED), (const bf16*)(ws + WS_WOUT) + (size_t)layer * D * D, M, D, D}; pg8::StaticOrder S; S.init(M, D, F.G, F.bx);
        pg8::EpiResBf16 E{(const bf16*)(ws + WS_XB), (bf16*)(ws + WS_PRE), D, ALPHA};
        pg8::gemm_phase<pg8::EpiResBf16, pg8::StaticOrder, PG8_ALIGN, PG8_SP2>(F.lds, g, S, E);
    }
    if constexpr (kind == K_PD) {
        ln1_route(F, (const bf16*)(ws + WS_PRE), (const bf16*)(ws + WS_WR) + (size_t)layer * 2 * 48 * D, (const float*)(ws + WS_RGB) + layer * 96, (float*)(ws + WS_STATS),
                  (int*)(ws + WS_TOKE), (float*)(ws + WS_TOKG), (int*)(ws + WS_TOKP), (int*)(ws + WS_ROWSLOT),
                  F.ctl + CW_CNT + 64 * layer, (int*)(ws + WS_MISC) + 1024 + 32 * F.bx);
    }
    if constexpr (kind == K_PE) {
        moe_gather(F, (const bf16*)(ws + WS_PRE), (const float*)(ws + WS_STATS), IN_(11) + (size_t)layer * D, IN_(12) + (size_t)layer * D, (const int*)(ws + WS_TOKE), (const float*)(ws + WS_TOKG), (const int*)(ws + WS_TOKP), (int*)(ws + WS_ROWSLOT), (float*)(ws + WS_ROWGATE),
                   (bf16*)(ws + WS_XS), F.ctl + CW_CNT + 64 * layer, (int*)(ws + WS_MISC), (const int*)(ws + WS_MISC) + 1024 + 32 * F.bx);
    }
    if constexpr (kind == K_PF) {
        const int* TILETAB = (const int*)(ws + WS_MISC);
        const int nT = __builtin_amdgcn_readfirstlane((int)ld_agent(TILETAB));
        pg8::Gemm g{(const bf16*)(ws + WS_XS), (const bf16*)(ws + WS_W13) + (size_t)layer * NEXP * 1024 * 1024, nT * 256, 1024, D}; pg8::GroupedOrder S; S.init(nT, 1024, F.G, F.bx, TILETAB + 1);
        pg8::EpiSwiGLU E{(bf16*)(ws + WS_HID), DEXP};
        pg8::gemm_phase<pg8::EpiSwiGLU, pg8::GroupedOrder, PG8_ALIGN, PG8_SP2>(F.lds, g, S, E);
    }
    if constexpr (kind == K_PG) {
        const int* TILETAB = (const int*)(ws + WS_MISC);
        const int nT = __builtin_amdgcn_readfirstlane((int)ld_agent(TILETAB));
        pg8::Gemm g{(const bf16*)(ws + WS_HID), (const bf16*)(ws + WS_W2) + (size_t)layer * NEXP * 1024 * 512, nT * 256, 1024, DEXP}; pg8::GroupedOrder S; S.init(nT, 1024, F.G, F.bx, TILETAB + 1);
        pg8::EpiMoeDown E{(bf16*)(ws + WS_Y), D, (const int*)(ws + WS_ROWSLOT), (const float*)(ws + WS_ROWGATE)};
        pg8::gemm_phase<pg8::EpiMoeDown, pg8::GroupedOrder, PG8_ALIGN, PG8_SP2>(F.lds, g, S, E);
    }
    if constexpr (kind == K_PH) {
        ln2_pass(F, (const bf16*)(ws + WS_PRE), (const float*)(ws + WS_STATS), IN_(11) + (size_t)layer * D, IN_(12) + (size_t)layer * D, (const bf16*)(ws + WS_Y), IN_(13) + (size_t)layer * D, IN_(14) + (size_t)layer * D, layer == DEPTH - 1 ? outp : nullptr, (bf16*)(ws + WS_XB));
    }
}
#ifndef MK_PROBE_MASK
#define MK_PROBE_MASK 0ull
#endif
#define MK_PROBE_AMP 10ull
template <int PH>
__device__ __forceinline__ void run_all(const Args& args, LAS unsigned char* lds, int lo, int hi, const XcdBarrier& bar, unsigned long long& tacc) {
    if constexpr (PH < N_PHASES) {
        if (lo <= PH && PH < hi) {
            unsigned long long t0 = 0;
            if constexpr (((MK_PROBE_MASK >> PH) & 1ull) != 0ull) t0 = __builtin_amdgcn_s_memrealtime();
            run_phase<PH>(args, lds); if (PH + 1 < hi) xcd_barrier(bar);
            if constexpr (((MK_PROBE_MASK >> PH) & 1ull) != 0ull) tacc += __builtin_amdgcn_s_memrealtime() - t0;
        }
        run_all<PH + 1>(args, lds, lo, hi, bar, tacc);
    }
}
__global__ void __launch_bounds__(NTHREADS, 2) mk_fwd(Args args) {
    extern __shared__ __attribute__((aligned(16))) unsigned char lds[];
    for (int u = threadIdx.x; u < LDSCTL_BYTES / 4; u += NTHREADS) ((LAS unsigned*)((LAS unsigned char*)lds + LDSCTL_OFF))[u] = 0u;
    __syncthreads();
    const int lo = args.ph_lo, hi = args.ph_hi;
    XcdBarrier bar; bar.bar = (unsigned*)((gu32*)(args.ws + WS_CTL) + CW_BAR); bar.x = 0; bar.st = nullptr;
    if (hi - lo > 1) bar = xcd_barrier_post((unsigned*)((gu32*)(args.ws + WS_CTL) + CW_BAR), (volatile LAS unsigned*)((LAS unsigned char*)lds + L_MISC) + 8);
    unsigned long long tacc = 0;
    run_all<0>(args, (LAS unsigned char*)lds, lo, hi, bar, tacc);
    if ((MK_PROBE_MASK != 0ull || MK_SUBPROBE != 0) && blockIdx.x == 0 && threadIdx.x == 0) {
        if (MK_SUBPROBE != 0) tacc += *(LAS unsigned long long*)((LAS unsigned char*)lds + L_PROBE);
        const unsigned long long t_end = __builtin_amdgcn_s_memrealtime() + MK_PROBE_AMP * tacc;
        while (__builtin_amdgcn_s_memrealtime() < t_end) __builtin_amdgcn_s_sleep(32);
    }
}

#ifndef MK_PER_PHASE
#define MK_PER_PHASE 0
#endif
extern "C" void kernel_launch(void* const* d_in, const int* in_sizes, int n_in, void* d_out, int out_size, void* d_ws, size_t ws_size, hipStream_t stream) {
    static int grid = 0;
    if (grid == 0) {
        if (n_in != 22 || in_sizes[0] != M * D || out_size != M * D || ws_size < WS_END) { fprintf(stderr, "kernel_launch: unexpected shapes (n_in %d, in0 %d, out %d, ws %zu; need ws >= %zu); nothing launched\n", n_in, n_in > 0 ? in_sizes[0] : -1, out_size, ws_size, (size_t)WS_END); grid = -1; return; }
        int dev = 0, cus = 0, per_cu = 0;
        if (hipGetDevice(&dev) != hipSuccess || hipDeviceGetAttribute(&cus, hipDeviceAttributeMultiprocessorCount, dev) != hipSuccess) { fprintf(stderr, "kernel_launch: device query failed\n"); grid = -1; return; }
        if (hipFuncSetAttribute((const void*)mk_fwd, hipFuncAttributeMaxDynamicSharedMemorySize, LDS_BYTES) != hipSuccess) { fprintf(stderr, "kernel_launch: hipFuncSetAttribute failed\n"); grid = -1; return; }
        if (hipOccupancyMaxActiveBlocksPerMultiprocessor(&per_cu, (const void*)mk_fwd, NTHREADS, LDS_BYTES) != hipSuccess || per_cu < 1)
            fprintf(stderr, "kernel_launch: note: occupancy query reports %d workgroups per CU\n", per_cu);
        (void)hipGetLastError();
        grid = cus;
    }
    if (grid < 0) return;
    if (hipMemsetAsync((char*)d_ws + WS_CTL, 0, CTL_ZERO_BYTES, stream) != hipSuccess) { fprintf(stderr, "kernel_launch: memset failed\n"); return; }
    Args a{};
    for (int i = 0; i < 22; ++i) a.in[i] = (const float*)d_in[i];
    a.out = (float*)d_out; a.ws = (unsigned char*)d_ws;
#if MK_PER_PHASE
    for (int p = 0; p < N_PHASES; ++p) { a.ph_lo = p; a.ph_hi = p + 1; hipLaunchKernelGGL(mk_fwd, dim3(grid), dim3(NTHREADS), LDS_BYTES, stream, a); }
#else
    a.ph_lo = 0; a.ph_hi = N_PHASES;
    hipLaunchKernelGGL(mk_fwd, dim3(grid), dim3(NTHREADS), LDS_BYTES, stream, a);
#endif
    const hipError_t le = hipPeekAtLastError();
    if (le != hipSuccess) fprintf(stderr, "kernel_launch: launch failed: %s (grid %d)\n", hipGetErrorName(le), grid);
}
```
